# Optimizing an MI355X kernel written in HIP

```python
import math
import jax, jax.numpy as jnp
from jax import lax
import numpy as np

D_MODEL = 1024
BATCH = 8
SEQ = 4096
DEPTH = 1
DEC_BATCH = 8
DEC_SEQ = 16
PAST_LEN = 1024

CHUNK = 64
HEAD_DIM = 64
N_HEADS_A = D_MODEL // HEAD_DIM
WIDTH_A = N_HEADS_A * HEAD_DIM
DECAY_LORA = 64
ICLR_LORA = 64
WIDTH_B = D_MODEL
CONV_W = 3
PLE_DIM = 256
EPS = 1e-6
GN_EPS = 64e-5
DECAY_SCALE = math.exp(-0.5)
SHIFT_COLS = 3 * WIDTH_A + DECAY_LORA + ICLR_LORA + WIDTH_A
CONV_COLS = 4 * WIDTH_B
GATE_COLS = 2 * D_MODEL
IN_COLS = SHIFT_COLS + CONV_COLS + GATE_COLS

kernel_name = "rwkv7_shortconv_gated_merge_stream_step"


def rmsnorm(x, g):
    xf = x.astype(jnp.float32)
    y = xf * lax.rsqrt(jnp.mean(xf * xf, axis=-1, keepdims=True) + EPS)
    return (y * g.astype(jnp.float32)).astype(x.dtype)


def wkv7_scan(S0, r, w, kh, a, v, kt):
    def step(S, inp):
        r_t, w_t, kh_t, a_t, v_t, kt_t = inp
        sa = jnp.einsum('bhvk,bhk->bhv', S, kh_t)
        S = (S * w_t[:, :, None, :]
             - sa[..., None] * (a_t * kh_t)[:, :, None, :]
             + v_t[..., None] * kt_t[:, :, None, :])
        y_t = jnp.einsum('bhvk,bhk->bhv', S, r_t)
        return S, y_t
    xs = (jnp.moveaxis(r, 1, 0), jnp.moveaxis(w, 1, 0), jnp.moveaxis(kh, 1, 0),
          jnp.moveaxis(a, 1, 0), jnp.moveaxis(v, 1, 0), jnp.moveaxis(kt, 1, 0))
    S, ys = lax.scan(step, S0, xs)
    return jnp.moveaxis(ys, 0, 1), S


def hybrid_layer(x, p, wkv0, shift0, conv0, g_norm, w_in, mu_shift, w_decay0, w_decay2,
                 w_iclr0, w_iclr2, k_removal, k_replace, r_bonus, gn_w, gn_b, conv_w,
                 w_o_a, w_o_b, w_out, g_ple, w_ple_gate, w_ple):
    B_, T, _ = x.shape
    f32 = jnp.float32
    h = rmsnorm(x, g_norm)
    proj = h @ w_in
    pa = proj[..., :SHIFT_COLS]
    pb = proj[..., SHIFT_COLS:SHIFT_COLS + CONV_COLS]
    pg = proj[..., SHIFT_COLS + CONV_COLS:]

    pa_prev = jnp.concatenate([shift0[:, None, :].astype(pa.dtype), pa[:, :-1]], axis=1)
    pa_mix = pa + mu_shift * (pa_prev - pa)
    new_shift = pa[:, -1]
    r, k, v, w_lr, a_lr, z_a = jnp.split(
        pa_mix, [WIDTH_A, 2 * WIDTH_A, 3 * WIDTH_A, 3 * WIDTH_A + DECAY_LORA,
                 3 * WIDTH_A + DECAY_LORA + ICLR_LORA], axis=-1)
    r, k, v = r.astype(f32), k.astype(f32), v.astype(f32)
    d = w_decay0.astype(f32) + jnp.tanh(w_lr.astype(f32)) @ w_decay2.astype(f32)
    w = jnp.exp(-DECAY_SCALE * jax.nn.sigmoid(d))
    a = jax.nn.sigmoid(w_iclr0.astype(f32) + a_lr.astype(f32) @ w_iclr2.astype(f32))
    kappa = k * k_removal.astype(f32)
    kt = k * (1.0 + (a - 1.0) * k_replace.astype(f32))
    hs = (B_, T, N_HEADS_A, HEAD_DIM)
    r_h, w_h, a_h, v_h, kt_h = (t.reshape(hs) for t in (r, w, a, v, kt))
    kap_h = kappa.reshape(hs)
    kh_h = kap_h / jnp.maximum(jnp.linalg.norm(kap_h, axis=-1, keepdims=True), 1e-12)
    y, S = wkv7_scan(wkv0.astype(f32), r_h, w_h, kh_h, a_h, v_h, kt_h)
    mu = jnp.mean(y, axis=-1, keepdims=True)
    var = jnp.mean(jnp.square(y - mu), axis=-1, keepdims=True)
    yn = ((y - mu) * lax.rsqrt(var + GN_EPS)).reshape(B_, T, WIDTH_A)
    yn = yn * gn_w.astype(f32) + gn_b.astype(f32)
    bonus = jnp.sum(r_h * kt_h * r_bonus.astype(f32), axis=-1, keepdims=True) * v_h
    o_a = (yn + bonus.reshape(B_, T, WIDTH_A)).astype(x.dtype) * jax.nn.silu(z_a)
    out_a = o_a @ w_o_a

    gb, gc, xb, z_b = jnp.split(pb, 4, axis=-1)
    u = gc * xb
    u_pad = jnp.concatenate([conv0.astype(u.dtype), u], axis=1)
    cv = sum(conv_w[j] * u_pad[:, j:j + T] for j in range(CONV_W))
    new_conv = u_pad[:, -(CONV_W - 1):]
    out_b = (gb * cv * jax.nn.silu(z_b)) @ w_o_b

    g_a, g_b = jnp.split(jax.nn.sigmoid(pg), 2, axis=-1)
    x = x + (g_a * out_a + g_b * out_b) @ w_out

    x = x + jax.nn.sigmoid(rmsnorm(x, g_ple) @ w_ple_gate) * (p @ w_ple)
    return x, S.astype(x.dtype), new_shift, new_conv


def setup_inputs(seed: int = 0) -> dict:
    key = jax.random.key(seed)
    ks = jax.random.split(key, 32)
    nrm = lambda k, s, sc=1.0: jax.random.normal(k, s, jnp.float32) * sc
    L = DEPTH
    return {
        "x_prompt": nrm(ks[0], (BATCH, SEQ, D_MODEL)),
        "x_sample": nrm(ks[1], (DEC_BATCH, DEC_SEQ, D_MODEL)),
        "state_wkv": nrm(ks[2], (L, DEC_BATCH, N_HEADS_A, HEAD_DIM, HEAD_DIM), 0.5),
        "state_shift": nrm(ks[3], (L, DEC_BATCH, SHIFT_COLS)),
        "state_conv": nrm(ks[4], (L, DEC_BATCH, CONV_W - 1, WIDTH_B)),
        "p_prompt": nrm(ks[5], (L, BATCH, SEQ, PLE_DIM)),
        "p_sample": nrm(ks[6], (L, DEC_BATCH, DEC_SEQ, PLE_DIM)),
        "g_norm": 1.0 + nrm(ks[7], (L, D_MODEL), 0.02),
        "w_in": nrm(ks[8], (L, D_MODEL, IN_COLS), D_MODEL ** -0.5),
        "mu_shift": jax.random.uniform(ks[9], (L, SHIFT_COLS), jnp.float32),
        "w_decay0": jax.random.uniform(ks[10], (L, WIDTH_A), jnp.float32, -2.0, 2.0),
        "w_decay2": nrm(ks[11], (L, DECAY_LORA, WIDTH_A), 0.3 * DECAY_LORA ** -0.5),
        "w_iclr0": nrm(ks[12], (L, WIDTH_A), 0.1),
        "w_iclr2": nrm(ks[13], (L, ICLR_LORA, WIDTH_A), 0.3 * ICLR_LORA ** -0.5),
        "k_removal": 0.85 + nrm(ks[14], (L, WIDTH_A), 0.02),
        "k_replace": 1.0 + nrm(ks[15], (L, WIDTH_A), 0.02),
        "r_bonus": nrm(ks[16], (L, N_HEADS_A, HEAD_DIM), 0.1),
        "gn_w": 1.0 + nrm(ks[17], (L, WIDTH_A), 0.02),
        "gn_b": nrm(ks[18], (L, WIDTH_A), 0.01),
        "conv_w": nrm(ks[19], (L, CONV_W, WIDTH_B), CONV_W ** -0.5),
        "w_o_a": nrm(ks[20], (L, WIDTH_A, D_MODEL), WIDTH_A ** -0.5),
        "w_o_b": nrm(ks[21], (L, WIDTH_B, D_MODEL), WIDTH_B ** -0.5),
        "w_out": nrm(ks[22], (L, D_MODEL, D_MODEL), D_MODEL ** -0.5),
        "g_ple": 1.0 + nrm(ks[23], (L, D_MODEL), 0.02),
        "w_ple_gate": nrm(ks[24], (L, D_MODEL, D_MODEL), D_MODEL ** -0.5),
        "w_ple": nrm(ks[25], (L, PLE_DIM, D_MODEL), PLE_DIM ** -0.5),
        "g_final": 1.0 + nrm(ks[26], (D_MODEL,), 0.02),
    }


def reference(x_prompt, x_sample, state_wkv, state_shift, state_conv, p_prompt, p_sample,
              g_norm, w_in, mu_shift, w_decay0, w_decay2, w_iclr0, w_iclr2, k_removal,
              k_replace, r_bonus, gn_w, gn_b, conv_w, w_o_a, w_o_b, w_out, g_ple,
              w_ple_gate, w_ple, g_final):
    Bp = x_prompt.shape[0]
    xp, xs = x_prompt, x_sample
    wkv_p, shift_p, conv_p, wkv_s, shift_s, conv_s = [], [], [], [], [], []
    for i in range(DEPTH):
        params = (g_norm[i], w_in[i], mu_shift[i], w_decay0[i], w_decay2[i], w_iclr0[i],
                  w_iclr2[i], k_removal[i], k_replace[i], r_bonus[i], gn_w[i], gn_b[i],
                  conv_w[i], w_o_a[i], w_o_b[i], w_out[i], g_ple[i], w_ple_gate[i], w_ple[i])
        wkv0 = jnp.zeros((Bp, N_HEADS_A, HEAD_DIM, HEAD_DIM), jnp.float32)
        shift0 = jnp.zeros((Bp, SHIFT_COLS), xp.dtype)
        conv0 = jnp.zeros((Bp, CONV_W - 1, WIDTH_B), xp.dtype)
        xp, s1, s2, s3 = hybrid_layer(xp, p_prompt[i], wkv0, shift0, conv0, *params)
        wkv_p.append(s1); shift_p.append(s2); conv_p.append(s3)
        xs, t1, t2, t3 = hybrid_layer(xs, p_sample[i], state_wkv[i], state_shift[i],
                                      state_conv[i], *params)
        wkv_s.append(t1); shift_s.append(t2); conv_s.append(t3)
    y_prompt = rmsnorm(xp, g_final)
    y_sample = rmsnorm(xs, g_final)
    return (y_prompt, y_sample,
            jnp.stack(wkv_p), jnp.stack(shift_p), jnp.stack(conv_p),
            jnp.stack(wkv_s), jnp.stack(shift_s), jnp.stack(conv_s))
```

```cpp
#include <hip/hip_runtime.h>
#include <cstdio>
#include <cstdint>

#ifndef MK_N_LAUNCHES
#define MK_N_LAUNCHES 1
#endif

#ifndef PROBE_PHASE
#define PROBE_PHASE -1
#endif
#define LAS __attribute__((address_space(3)))
#define GAS __attribute__((address_space(1)))
typedef _Float16 h16;
typedef _Float16 h16x8 __attribute__((ext_vector_type(8)));
typedef _Float16 h16x4 __attribute__((ext_vector_type(4)));
typedef float f32x4 __attribute__((ext_vector_type(4)));
typedef float f32x2 __attribute__((ext_vector_type(2)));
typedef unsigned u32x4 __attribute__((ext_vector_type(4)));
typedef GAS unsigned gu32;

constexpr int D = 1024, NP = 32768, NS = 128, MREAL = NP + NS, MP = 33024, NMT = MP / 256;
constexpr int SEQ = 4096, DSEQ = 16, NH = 16, HD = 64, PLE = 256;
constexpr int SHIFT_COLS = 4224, IN_COLS = 10368;
constexpr int W1_ROWS = 8448 + 2048;
constexpr float EPS = 1e-6f, GN_EPS = 64e-5f, DECAY_SCALE = 0.60653065971f;
constexpr size_t OFF_Y = 0, OFF_WKV_P = (size_t)MREAL * D, OFF_SHIFT_P = OFF_WKV_P + 8 * 16 * 64 * 64, OFF_CONV_P = OFF_SHIFT_P + 8 * SHIFT_COLS,
                 OFF_WKV_S = OFF_CONV_P + 8 * 2 * D, OFF_SHIFT_S = OFF_WKV_S + 8 * 16 * 64 * 64, OFF_CONV_S = OFF_SHIFT_S + 8 * SHIFT_COLS;
constexpr size_t MiB = 1u << 20;
constexpr size_t WS_CTL = 0, CTL_ZERO_BYTES = 131072;
static_assert((16384 + 128 * 64) * 4 <= 131072, "control words inside the per-call memset");
constexpr size_t WS_W1T = 1 * MiB, WS_WOA = 22 * MiB, WS_WOB = 24 * MiB, WS_WOUT = 26 * MiB, WS_WGATE = 28 * MiB, WS_WPLE = 30 * MiB;
constexpr size_t WS_W2T = 30 * MiB + 512 * 1024, WS_I2T = WS_W2T + 128 * 1024;
constexpr size_t WS_RSTD0 = 31 * MiB, WS_SIDE = 32 * MiB, WS_SSQ1 = 34 * MiB, WS_XCH = 37 * MiB;
constexpr size_t WS_XH = 40 * MiB, WS_PH = 105 * MiB, WS_R = 122 * MiB, WS_K = 187 * MiB, WS_V = 252 * MiB, WS_Z = 317 * MiB, WS_WA = 382 * MiB, WS_ACTB = 391 * MiB, WS_SIDEU = 456 * MiB, WS_SIDEP = 457 * MiB, WS_SIDEG = 458 * MiB, WS_END = 459 * MiB;
constexpr size_t SIDE_STRIDE = 256 * 1024;
constexpr int CW_BAR = 1024, CW_SUB = 512, CW_PANEL = 5120, CW_RDY = 16384, CW_MQ = 640;

constexpr int NWAVES = 8;
constexpr int RING_BYTES = 131072, SCAN_LDS_BYTES = 163072, LDSCTL_OFF = SCAN_LDS_BYTES, MISC_OFF = LDSCTL_OFF + 320, LDS_BYTES = 163840;

__device__ __forceinline__ int fresh_tid_w(int wave_s) { int lane; asm volatile("v_mbcnt_lo_u32_b32 %0, -1, 0\n\tv_mbcnt_hi_u32_b32 %0, -1, %0" : "=v"(lane)); return (wave_s << 6) | lane; }
__device__ __forceinline__ float fsigmoid(float x) { return __builtin_amdgcn_rcpf(1.0f + __expf(-x)); }
__device__ __forceinline__ float fsilu(float x) { return x * fsigmoid(x); }
__device__ __forceinline__ float ftanh(float x) { return 1.0f - 2.0f * __builtin_amdgcn_rcpf(__expf(2.0f * x) + 1.0f); }
__device__ __forceinline__ h16x4 cvt4(f32x4 v) { return __builtin_convertvector(v, h16x4); }
__device__ __forceinline__ h16x8 cvt8(f32x4 a, f32x4 b) { h16x4 x = cvt4(a), y = cvt4(b); return __builtin_shufflevector(x, y, 0, 1, 2, 3, 4, 5, 6, 7); }
__device__ __forceinline__ f32x4 up4(h16x4 v) { return __builtin_convertvector(v, f32x4); }

namespace pg {
constexpr int BM = 256, BK = 64, HALF = 128, HTB = HALF * BK * 2, NXCD = 8, WGM = 8;
__host__ __device__ __forceinline__ int lds_byte(int r, int c) { const int st = (r >> 4) * 2 + (c >> 5), rr = r & 15, cc = c & 31, ob = rr * 64 + cc * 2; return st * 1024 + (ob ^ (((ob >> 9) & 1) << 5)); }
__host__ __device__ __forceinline__ void stage_rc(int b, int& R, int& C) { const int st = b / 1024, sb = b % 1024, swz = sb ^ (((sb >> 9) & 1) << 5); R = (st >> 1) * 16 + swz / 64; C = (st & 1) * 32 + (swz % 64) / 2; }
__host__ __device__ __forceinline__ int perm32(int rho) { const int n = rho >> 4, i = rho & 15; return 8 * (i >> 2) + 4 * n + (i & 3); }

struct Unit { int pm, pn, kind; const char* A; const char* B; };

struct TileOrder {
    int nM, nN, nwg, G, c;
    __device__ void init(int nM_, int nN_, int G_, int c_) { nM = nM_; nN = nN_; nwg = nM * nN; G = G_; c = c_; }
    __device__ bool get(int i, int& pm, int& pn) const { return get_linear((long)i * G + c, pm, pn); }
    __device__ bool get_linear(long L, int& pm, int& pn) const {
        if (L >= nwg) return false;
        int wgid = (int)L; { const int q = nwg / NXCD, r = nwg % NXCD, xcd = wgid % NXCD, off = wgid / NXCD; wgid = (xcd < r ? xcd * (q + 1) : r * (q + 1) + (xcd - r) * q) + off; }
        const int nig = WGM * nN, gid = wgid / nig, fm = gid * WGM, gsz = (nM - fm) < WGM ? (nM - fm) : WGM;
        pm = fm + ((wgid % nig) % gsz); pn = (wgid % nig) / gsz; return true;
    }
};

template <class Sched, class Epi, bool APERM = false>
__device__ __forceinline__ void gemm_phase(LAS unsigned char* lds, const int wave_s, const int K, const Sched& S, const Epi& E) {
    const int tid = fresh_tid_w(wave_s), wid = wave_s, lane = tid & 63, wr = wid >> 2, wc = wid & 3, fr = lane & 15, fq = lane >> 4;
    const int nt = K / BK;
    unsigned voffA[2], voffB[2];
#pragma unroll
    for (int i = 0; i < 2; ++i) { int R, C; stage_rc(tid * 16 + i * 8192, R, C); const int Rb = (R & ~31) + perm32(R & 31);
        const int Ra = APERM ? (R & ~63) + 4 * (R & 15) + ((R & 63) >> 4) : R;
        voffA[i] = (unsigned)(Ra * K + C) * 2u; voffB[i] = (unsigned)(Rb * K + C) * 2u; }
    const size_t kstep = (size_t)(BK * 2);
    const size_t hstep = (size_t)HALF * K * 2;
    const unsigned ldsw = (unsigned)wid * 1024u;
    const int aoff = lds_byte(wr * 64 + fr, fq * 8), boff = lds_byte(wc * 32 + fr, fq * 8);
#define PG_SA(b, h) (((b) * 2 + (h)) * HTB)
#define PG_SB(b, h) ((4 + (b) * 2 + (h)) * HTB)
#define PG_STAGE(bufoff, gbase, voff) do { _Pragma("unroll") for (int _i = 0; _i < 2; ++_i) \
        __builtin_amdgcn_global_load_lds((const unsigned*)((const char*)(gbase) + (voff)[_i]), (LAS unsigned*)(lds + (bufoff) + ldsw + _i * 8192), 16, 0, 0); } while (0)
#define PG_LDA(dst, b, h) do { _Pragma("unroll") for (int m = 0; m < 4; ++m) _Pragma("unroll") for (int k = 0; k < 2; ++k) dst[m][k] = *(const LAS h16x8*)(lds + PG_SA(b, h) + aoff + m * 2048 + k * 1024); } while (0)
#define PG_LDB(dst, b, h) do { _Pragma("unroll") for (int n = 0; n < 2; ++n) _Pragma("unroll") for (int k = 0; k < 2; ++k) dst[n][k] = *(const LAS h16x8*)(lds + PG_SB(b, h) + boff + n * 2048 + k * 1024); } while (0)
#define PG_MMA(ai, bj, At, Bt) do { __builtin_amdgcn_s_setprio(1); _Pragma("unroll") for (int m = 0; m < 4; ++m) _Pragma("unroll") for (int n = 0; n < 2; ++n) _Pragma("unroll") for (int k = 0; k < 2; ++k) \
        acc[ai][bj][m][n] = __builtin_amdgcn_mfma_f32_16x16x32_f16(Bt[n][k], At[m][k], acc[ai][bj][m][n], 0, 0, 0); __builtin_amdgcn_s_setprio(0); } while (0)
#define PG_WAIT_V(n) asm volatile("s_waitcnt vmcnt(" #n ")" ::: "memory")
#define PG_WAIT_L(n) asm volatile("s_waitcnt lgkmcnt(" #n ")" ::: "memory")
#define PG_BAR __builtin_amdgcn_s_barrier()
#define PG_SCHED __builtin_amdgcn_sched_barrier(0)
    Unit cur, nxt; int ui = 0;
    if (!S.next(0, cur)) return;
    f32x4 acc[2][2][4][2];
#pragma unroll
    for (int a = 0; a < 2; ++a)
#pragma unroll
        for (int b = 0; b < 2; ++b)
#pragma unroll
            for (int m = 0; m < 4; ++m)
#pragma unroll
                for (int n = 0; n < 2; ++n) acc[a][b][m][n] = (f32x4){0.f, 0.f, 0.f, 0.f};
    h16x8 At[4][2], B0[2][2], B1[2][2];
    const char* cA = cur.A; const char* cB = cur.B;
    PG_STAGE(PG_SB(0, 0), cB, voffB); PG_STAGE(PG_SB(0, 1), cB + hstep, voffB); PG_STAGE(PG_SA(0, 0), cA, voffA); PG_STAGE(PG_SA(0, 1), cA + hstep, voffA);
    PG_STAGE(PG_SB(1, 0), cB + kstep, voffB); PG_STAGE(PG_SA(1, 0), cA + kstep, voffA); PG_STAGE(PG_SB(1, 1), cB + hstep + kstep, voffB);
    if (wr == 1) PG_BAR;
    PG_WAIT_V(8); PG_BAR;
    PG_WAIT_V(6); PG_BAR;
    for (;;) {
        const bool has_next = S.next(ui + 1, nxt);
        const char* nA = has_next ? nxt.A : cA; const char* nB = has_next ? nxt.B : cB;
        for (int t = 0; t < nt; t += 2) {
            const bool last = (t == nt - 2);
            const char* a1 = cA + (size_t)(t + 1) * kstep;
            const char* a2 = last ? nA : cA + (size_t)(t + 2) * kstep; const char* b2 = last ? nB : cB + (size_t)(t + 2) * kstep;
            const char* a3 = a2 + kstep; const char* b3 = b2 + kstep;
            PG_LDB(B0, 0, 0); PG_LDB(B1, 0, 1); PG_SCHED; PG_LDA(At, 0, 0); PG_STAGE(PG_SA(1, 1), a1 + hstep, voffA);
            PG_WAIT_V(8); PG_WAIT_L(0); PG_BAR; PG_MMA(0, 0, At, B0); PG_MMA(0, 1, At, B1); PG_BAR; PG_SCHED;
            PG_LDA(At, 0, 1); PG_STAGE(PG_SB(0, 0), b2, voffB); PG_STAGE(PG_SB(0, 1), b2 + hstep, voffB); PG_STAGE(PG_SA(0, 0), a2, voffA);
            PG_WAIT_V(8); PG_WAIT_L(0); PG_BAR; PG_MMA(1, 0, At, B0); PG_MMA(1, 1, At, B1); PG_BAR; PG_SCHED;
            PG_LDB(B0, 1, 0); PG_LDB(B1, 1, 1); PG_SCHED; PG_LDA(At, 1, 0); PG_STAGE(PG_SA(0, 1), a2 + hstep, voffA);
            PG_WAIT_V(8); PG_WAIT_L(0); PG_BAR; PG_MMA(0, 0, At, B0); PG_MMA(0, 1, At, B1); PG_BAR; PG_SCHED;
            PG_LDA(At, 1, 1); PG_STAGE(PG_SB(1, 0), b3, voffB); PG_STAGE(PG_SB(1, 1), b3 + hstep, voffB); PG_STAGE(PG_SA(1, 0), a3, voffA);
            PG_WAIT_V(8); PG_WAIT_L(0); PG_BAR; PG_MMA(1, 0, At, B0); PG_MMA(1, 1, At, B1); PG_BAR; PG_SCHED;
        }
        if (wr == 0) PG_BAR;
        E(acc, cur, wr, wc, fr, fq);
        if (!has_next) break;
#pragma unroll
        for (int a = 0; a < 2; ++a)
#pragma unroll
            for (int b = 0; b < 2; ++b)
#pragma unroll
                for (int m = 0; m < 4; ++m)
#pragma unroll
                    for (int n = 0; n < 2; ++n) acc[a][b][m][n] = (f32x4){0.f, 0.f, 0.f, 0.f};
        cur = nxt; cA = nA; cB = nB; ++ui;
        if (wr == 1) PG_BAR;
    }
    PG_WAIT_V(0);
    PG_BAR;
#undef PG_SA
#undef PG_SB
#undef PG_STAGE
#undef PG_LDA
#undef PG_LDB
#undef PG_MMA
#undef PG_WAIT_V
#undef PG_WAIT_L
#undef PG_BAR
#undef PG_SCHED
}
}

#define XB_TMO      128
#define XB_XCNT(j)  (256  + 64 * (j))
#define XB_XSUB(j)  (1280 + 64 * (j))
#define XB_XGEN(j)  (2304 + 64 * (j))
#define XB_TOP      3328
#define XB_TOPGEN   3392
#define XCD_BAR_WORDS 3456
#define XB_SPIN_CAP (1u << 22)
__device__ __forceinline__ unsigned xb_ld(unsigned* p)              { return __hip_atomic_load(p, __ATOMIC_RELAXED, __HIP_MEMORY_SCOPE_AGENT); }
__device__ __forceinline__ unsigned xb_add(unsigned* p, unsigned v) { return __hip_atomic_fetch_add(p, v, __ATOMIC_RELAXED, __HIP_MEMORY_SCOPE_AGENT); }
__device__ __forceinline__ unsigned xb_xcc_id() { return (unsigned)__builtin_amdgcn_s_getreg((3 << 11) | 20) & 0xFu; }
#define XB_SPIN(cond, bar) do { unsigned _sp = 0; while (cond) { __builtin_amdgcn_s_sleep(1); \
    if ((++_sp & 255u) == 0u) { if (xb_ld(&(bar)[XB_TMO])) break; if (_sp > XB_SPIN_CAP) { atomicAdd(&(bar)[XB_TMO], 1u); break; } } } } while (0)
struct XcdBarrier { unsigned* bar; unsigned x; volatile LAS unsigned* st; };
__device__ __forceinline__ XcdBarrier xcd_barrier_post(unsigned* bar, volatile LAS unsigned* st, int wave_s) {
    XcdBarrier b; b.bar = bar; b.x = xb_xcc_id(); b.st = st;
    if (fresh_tid_w(wave_s) == 0) (void)xb_add(&bar[XB_XCNT(b.x)], 1u);
    return b;
}
__device__ __forceinline__ void xcd_barrier_complete(unsigned* bar, unsigned x, unsigned& nloc, unsigned& nx) {
    const unsigned G = gridDim.x * gridDim.y * gridDim.z;
    unsigned sum, cnt, mine, sp = 0u;
    for (;;) {
        sum = 0u; cnt = 0u; mine = 0u;
#pragma unroll
        for (unsigned j = 0; j < 16; ++j) { const unsigned c = xb_ld(&bar[XB_XCNT(j)]); sum += c; cnt += (c > 0u) ? 1u : 0u; mine = (j == x) ? c : mine; }
        if (sum == G) break;
        __builtin_amdgcn_s_sleep(1);
        if ((++sp & 255u) == 0u) { if (xb_ld(&bar[XB_TMO])) break; if (sp > XB_SPIN_CAP) { atomicAdd(&bar[XB_TMO], 1u); break; } }
    }
    nloc = mine > 0u ? mine : 1u; nx = cnt > 0u ? cnt : 1u;
}
__device__ __forceinline__ void xcd_barrier(const XcdBarrier& b, int wave_s) {
    asm volatile("s_waitcnt vmcnt(0)" ::: "memory");
    __syncthreads();
    if (fresh_tid_w(wave_s) == 0) {
        unsigned* bar = b.bar;
        __builtin_amdgcn_s_waitcnt(0);
        unsigned nloc = b.st[0], nx = b.st[1];
        if (nloc == 0u) { xcd_barrier_complete(bar, b.x, nloc, nx); b.st[0] = nloc; b.st[1] = nx; }
        const unsigned old = xb_add(&bar[XB_XSUB(b.x)], 1u);
        const unsigned gen = old / nloc;
        if (old + 1u == (gen + 1u) * nloc) {
            __builtin_amdgcn_fence(__ATOMIC_RELEASE, "agent");
            asm volatile("s_waitcnt vmcnt(0)" ::: "memory");
            const unsigned og = xb_add(&bar[XB_TOP], 1u);
            const unsigned tg = og / nx;
            if (og + 1u == (tg + 1u) * nx) xb_add(&bar[XB_TOPGEN], 1u);
            else XB_SPIN(xb_ld(&bar[XB_TOPGEN]) == tg, bar);
            __builtin_amdgcn_fence(__ATOMIC_ACQUIRE, "agent");
            xb_add(&bar[XB_XGEN(b.x)], 1u);
            asm volatile("s_waitcnt vmcnt(0)" ::: "memory");
        } else {
            XB_SPIN(xb_ld(&bar[XB_XGEN(b.x)]) == gen, bar);
            __builtin_amdgcn_fence(__ATOMIC_ACQUIRE, "agent");
            asm volatile("s_waitcnt vmcnt(0)" ::: "memory");
        }
    }
    __syncthreads();
}

struct Args { const float* in[27]; float* out; unsigned char* ws; int ph_lo, ph_hi, li, pad; };
struct Frame {
    LAS unsigned char* lds; volatile LAS unsigned* MISC; gu32* ctl;
    int G, bx, wave_s;
    const float* const* in; float* out; unsigned char* ws;
};
#define IN_X_P 0
#define IN_X_S 1
#define IN_ST_WKV 2
#define IN_ST_SHIFT 3
#define IN_ST_CONV 4
#define IN_P_P 5
#define IN_P_S 6
#define IN_G_NORM 7
#define IN_W_IN 8
#define IN_MU 9
#define IN_WDEC0 10
#define IN_WDEC2 11
#define IN_WICL0 12
#define IN_WICL2 13
#define IN_KREM 14
#define IN_KREP 15
#define IN_RBONUS 16
#define IN_GNW 17
#define IN_GNB 18
#define IN_CONVW 19
#define IN_WOA 20
#define IN_WOB 21
#define IN_WOUT 22
#define IN_GPLE 23
#define IN_WPLEG 24
#define IN_WPLE 25
#define IN_GFINAL 26

__device__ __forceinline__ float wave_sum(float v) {
#pragma unroll
    for (int o = 1; o < 64; o <<= 1) v += __shfl_xor(v, o);
    return v;
}
__device__ __forceinline__ h16* rowptr16(float* out, unsigned char* ws, int slot, int row) {
    return row < NP ? (h16*)out + (size_t)slot * NP * D + (size_t)row * D : (h16*)(ws + WS_SIDE) + (size_t)slot * SIDE_STRIDE + (size_t)(row - NP) * D;
}

__device__ __forceinline__ int w1_src_col(int n) {
    const int tile = n >> 8, c = n & 255;
    if (tile < 16) { const int plane = tile >> 2; return (plane == 3 ? 3200 : plane * 1024) + (tile & 3) * 256 + c; }
    if (tile == 16) return c < 128 ? 3072 + c : -1;
    if (tile < 33) { const int tb = tile - 17, kind = 2 * (c >> 7) + ((c >> 2) & 1), ch = 64 * tb + 16 * ((c >> 5) & 3) + 4 * ((c >> 3) & 3) + (c & 3); return SHIFT_COLS + kind * 1024 + ch; }
    return SHIFT_COLS + 4096 + (n - 8448);
}
template <bool MAP>
__device__ __forceinline__ void p0_transpose_item(const float* W, int Nsrc, int K, h16* WT, const float* kscale, LAS float* scr, int kb, int nb, int lane) {
    const int k0 = 64 * kb, n0 = 32 * nb, n4 = (lane & 7) * 4;
    const int src = MAP ? w1_src_col(n0 + n4) : n0 + n4;
    f32x4 v[8];
#pragma unroll
    for (int i = 0; i < 8; ++i) { const int kk = 8 * i + (lane >> 3); v[i] = (f32x4){0.f, 0.f, 0.f, 0.f}; if (src >= 0) { v[i] = *(const f32x4*)(W + (size_t)(k0 + kk) * Nsrc + src); if (kscale) v[i] = v[i] * kscale[k0 + kk]; } }
#pragma unroll
    for (int i = 0; i < 8; ++i) { const int kk = 8 * i + (lane >> 3); LAS float* d = scr + kk * 33 + n4; d[0] = v[i].x; d[1] = v[i].y; d[2] = v[i].z; d[3] = v[i].w; }
    asm volatile("s_waitcnt lgkmcnt(0)" ::: "memory");
    const int c = lane & 7;
#pragma unroll
    for (int j = 0; j < 4; ++j) { const int nn = (lane >> 3) + 8 * j; const LAS float* s = scr + (8 * c) * 33 + nn;
        h16x8 o;
#pragma unroll
        for (int e = 0; e < 8; ++e) o[e] = (h16)s[e * 33];
        *(h16x8*)(WT + (size_t)(n0 + nn) * K + k0 + 8 * c) = o; }
    asm volatile("s_waitcnt lgkmcnt(0)" ::: "memory");
}
__device__ __forceinline__ void p0_prologue(Frame& F) {
    const int tid_ = fresh_tid_w(F.wave_s), lane_ = tid_ & 63, wave_ = F.wave_s;
    LAS float* scr = (LAS float*)(F.lds + wave_ * 16384);
    const int gw = F.bx * NWAVES + wave_, NGW = F.G * NWAVES;
    unsigned char* ws = F.ws;
    constexpr int I_W1 = (D / 64) * (W1_ROWS / 32), I_SQ = (D / 64) * (D / 32), I_PLE = (PLE / 64) * (D / 32);
    constexpr int NITEMS = I_W1 + 4 * I_SQ + I_PLE;
    for (int it = gw; it < I_W1; it += NGW)
        p0_transpose_item<true>(F.in[IN_W_IN], IN_COLS, D, (h16*)(ws + WS_W1T), F.in[IN_G_NORM], scr, it / (W1_ROWS / 32), it % (W1_ROWS / 32), lane_);
    (void)NITEMS;
    for (int i = F.bx * 512 + tid_; i < 65536; i += F.G * 512) { const int n = i >> 6, j = i & 63;
        ((h16*)(ws + WS_W2T))[i] = (h16)(-1.4426950408889634f * F.in[IN_WDEC2][(size_t)j * D + n]); ((h16*)(ws + WS_I2T))[i] = (h16)(-1.4426950408889634f * F.in[IN_WICL2][(size_t)j * D + n]); }
    h16* XH = (h16*)(ws + WS_XH); float* rstd0 = (float*)(ws + WS_RSTD0);
    for (int m0 = 4 * gw; m0 < MP; m0 += 4 * NGW) {
        f32x4 v[4][4]; float s[4];
#pragma unroll
        for (int r = 0; r < 4; ++r) { const int m = m0 + r;
            if (m < MREAL) {
                const float* xrow = m < NP ? F.in[IN_X_P] + (size_t)m * D : F.in[IN_X_S] + (size_t)(m - NP) * D;
#pragma unroll
                for (int j = 0; j < 4; ++j) v[r][j] = __builtin_nontemporal_load((const f32x4*)xrow + lane_ + 64 * j);
            } else {
#pragma unroll
                for (int j = 0; j < 4; ++j) v[r][j] = (f32x4){0.f, 0.f, 0.f, 0.f};
            } }
#pragma unroll
        for (int r = 0; r < 4; ++r) { float t = 0.f;
#pragma unroll
            for (int j = 0; j < 4; ++j) t += (v[r][j].x * v[r][j].x + v[r][j].y * v[r][j].y) + (v[r][j].z * v[r][j].z + v[r][j].w * v[r][j].w);
            s[r] = wave_sum(t); }
#pragma unroll
        for (int r = 0; r < 4; ++r) { const int m = m0 + r;
            const float ms = s[r] * (1.0f / D) + EPS, rstd = __builtin_amdgcn_rsqf(ms);
            if (lane_ == 0) rstd0[m] = m < MREAL ? ms * rstd : 0.f;
            h16x4* o = (h16x4*)(XH + (size_t)m * D) + lane_;
#pragma unroll
            for (int j = 0; j < 4; ++j) o[64 * j] = cvt4(v[r][j] * rstd); }
    }
}
__device__ __forceinline__ void p0_deferred(Frame& F, int c, int nw) {
    const int tid_ = fresh_tid_w(F.wave_s), lane_ = tid_ & 63, wave_ = F.wave_s;
    LAS float* scr = (LAS float*)(F.lds + wave_ * 16384);
    const int gw = c * NWAVES + wave_, NGW = nw * NWAVES;
    unsigned char* ws = F.ws;
    constexpr int I_SQ = (D / 64) * (D / 32), I_PLE = (PLE / 64) * (D / 32);
    for (int it = gw; it < 4 * I_SQ + I_PLE; it += NGW) {
        int r = it;
        if (r < I_SQ) { p0_transpose_item<false>(F.in[IN_WOA], D, D, (h16*)(ws + WS_WOA), nullptr, scr, r / 32, r % 32, lane_); continue; } r -= I_SQ;
        if (r < I_SQ) { p0_transpose_item<false>(F.in[IN_WOB], D, D, (h16*)(ws + WS_WOB), nullptr, scr, r / 32, r % 32, lane_); continue; } r -= I_SQ;
        if (r < I_SQ) { p0_transpose_item<false>(F.in[IN_WOUT], D, D, (h16*)(ws + WS_WOUT), nullptr, scr, r / 32, r % 32, lane_); continue; } r -= I_SQ;
        if (r < I_SQ) { p0_transpose_item<false>(F.in[IN_WPLEG], D, D, (h16*)(ws + WS_WGATE), F.in[IN_GPLE], scr, r / 32, r % 32, lane_); continue; } r -= I_SQ;
        p0_transpose_item<false>(F.in[IN_WPLE], D, PLE, (h16*)(ws + WS_WPLE), nullptr, scr, r / 32, r % 32, lane_);
    }
    h16* PH = (h16*)(ws + WS_PH);
    for (int m0 = 8 * gw; m0 < MP; m0 += 8 * NGW) {
        f32x4 pv[8];
#pragma unroll
        for (int r = 0; r < 8; ++r) { const int m = m0 + r; pv[r] = (f32x4){0.f, 0.f, 0.f, 0.f};
            if (m < MREAL) pv[r] = __builtin_nontemporal_load((const f32x4*)(m < NP ? F.in[IN_P_P] + (size_t)m * PLE : F.in[IN_P_S] + (size_t)(m - NP) * PLE) + lane_); }
#pragma unroll
        for (int r = 0; r < 8; ++r) ((h16x4*)(PH + (size_t)(m0 + r) * PLE))[lane_] = cvt4(pv[r]);
    }
    asm volatile("s_waitcnt vmcnt(0)" ::: "memory");
    __syncthreads();
}

__device__ __forceinline__ char* slotbase(float* out, unsigned char* ws, int slot, bool prompt_tile) {
    return prompt_tile ? (char*)out + (size_t)slot * NP * D * 2 : (char*)(ws + WS_SIDE) + (size_t)slot * SIDE_STRIDE * 2 - (size_t)NP * D * 2;
}
__device__ __forceinline__ float dpp_row_shr1(float x) { return __builtin_bit_cast(float, __builtin_amdgcn_update_dpp(0, __builtin_bit_cast(int, x), 0x111, 0xf, 0xf, true)); }
struct Epi1 {
    float* out; unsigned char* ws; const float* rstd0; const float* cw; LAS unsigned char* lx;
    __device__ __forceinline__ void conv_tile(const f32x4 (&acc)[2][2][4][2], const pg::Unit& u, int wr, int wc, int fr, int fq) const {
        const int ch = 64 * (u.pn - 17) + 16 * wc + 4 * fq;
        f32x4 uu[2][4], gz[2][4];
#pragma unroll
        for (int ai = 0; ai < 2; ++ai)
#pragma unroll
            for (int m = 0; m < 4; ++m) {
                const int row = u.pm * 256 + ai * 128 + wr * 64 + fr * 4 + m;
                const f32x4 gb = acc[ai][0][m][0], gc = acc[ai][0][m][1], xb = acc[ai][1][m][0], zb = acc[ai][1][m][1];
                uu[ai][m] = gc * xb;
#pragma unroll
                for (int j = 0; j < 4; ++j) gz[ai][m][j] = gb[j] * fsilu(zb[j]);
                const int t = row & (SEQ - 1);
                if (t >= SEQ - 2) *(f32x4*)(out + OFF_CONV_P + ((size_t)(row >> 12) * 2 + (t - (SEQ - 2))) * D + ch) = uu[ai][m];
            }
        LAS float* X = (LAS float*)lx;
        if (fr == 15) {
#pragma unroll
            for (int ai = 0; ai < 2; ++ai) { *(LAS f32x4*)(X + ((2 * ai + wr) * 2 + 0) * 64 + 16 * wc + 4 * fq) = uu[ai][2]; *(LAS f32x4*)(X + ((2 * ai + wr) * 2 + 1) * 64 + 16 * wc + 4 * fq) = uu[ai][3]; }
            if (wr == 1) { float* su = (float*)(ws + WS_SIDEU) + (size_t)u.pm * 2048 + ch; *(f32x4*)su = uu[1][2]; *(f32x4*)(su + 1024) = uu[1][3]; }
        }
        asm volatile("s_waitcnt lgkmcnt(0)" ::: "memory"); __builtin_amdgcn_s_barrier(); asm volatile("" ::: "memory");
        const f32x4 c0 = *(const f32x4*)(cw + ch), c1 = *(const f32x4*)(cw + D + ch), c2 = *(const f32x4*)(cw + 2 * D + ch);
        const bool first = (u.pm & 15) == 0;
#pragma unroll
        for (int ai = 0; ai < 2; ++ai) {
            f32x4 q1, q2;
#pragma unroll
            for (int j = 0; j < 4; ++j) { q1[j] = dpp_row_shr1(uu[ai][3][j]); q2[j] = dpp_row_shr1(uu[ai][2][j]); }
            const int blk = 2 * ai + wr;
            if (fr == 0) {
                if (blk > 0) { q2 = *(const LAS f32x4*)(X + ((blk - 1) * 2 + 0) * 64 + 16 * wc + 4 * fq); q1 = *(const LAS f32x4*)(X + ((blk - 1) * 2 + 1) * 64 + 16 * wc + 4 * fq); }
                else { q2 = (f32x4){0.f, 0.f, 0.f, 0.f}; q1 = q2; }
            }
#pragma unroll
            for (int m = 0; m < 4; ++m) {
                const int row = u.pm * 256 + ai * 128 + wr * 64 + fr * 4 + m;
                const f32x4 p1 = m >= 1 ? uu[ai][m - 1] : q1, p2 = m >= 2 ? uu[ai][m - 2] : (m == 1 ? q1 : q2);
                const f32x4 cv = c2 * uu[ai][m] + c1 * p1 + c0 * p2;
                if (blk == 0 && fr == 0 && m < 2 && !first) {
                    float* sp = (float*)(ws + WS_SIDEP) + (size_t)u.pm * 2048 + m * 1024 + ch; float* sg = (float*)(ws + WS_SIDEG) + (size_t)u.pm * 2048 + m * 1024 + ch;
                    *(f32x4*)sp = gz[ai][m] * cv; *(f32x4*)sg = gz[ai][m];
                } else *(h16x4*)((char*)ws + WS_ACTB + (unsigned)(row * D + ch) * 2u) = cvt4(gz[ai][m] * cv);
            }
        }
    }
    __device__ __forceinline__ void operator()(const f32x4 (&acc)[2][2][4][2], const pg::Unit& u, int wr, int wc, int fr, int fq) const {
        const int tile = u.pn; const bool ptile = u.pm < NMT - 1;
        if (tile >= 17 && ptile) { conv_tile(acc, u, wr, wc, fr, fq); return; }
        const int plane = tile >> 2;
        char* pbase = (char*)ws + (plane == 0 ? WS_R : plane == 1 ? WS_K : plane == 2 ? WS_V : WS_Z);
        char* ub = slotbase(out, ws, 0, ptile); char* gzb = slotbase(out, ws, 1, ptile);
#pragma unroll
        for (int ai = 0; ai < 2; ++ai)
#pragma unroll
            for (int m = 0; m < 4; ++m) {
                const int row = u.pm * 256 + ai * 128 + wr * 64 + fr * 4 + m;
                int endj = -1, bidx = 0; bool samp = false;
                if (row < NP) { const int t = row & (SEQ - 1); if (t >= SEQ - 2) { endj = t - (SEQ - 2); bidx = row >> 12; } }
                else if (row < MREAL) { const int rr = row - NP, t = rr & (DSEQ - 1); if (t >= DSEQ - 2) { endj = t - (DSEQ - 2); bidx = rr >> 4; samp = true; } }
                if (tile < 17) {
#pragma unroll
                    for (int bj = 0; bj < 2; ++bj) {
                        const int cl = bj * 128 + wc * 32 + 8 * fq;
                        const f32x4 v0 = acc[ai][bj][m][0], v1 = acc[ai][bj][m][1];
                        int scol;
                        if (tile < 16) { *(h16x8*)(pbase + (unsigned)(row * D + (tile & 3) * 256 + cl) * 2u) = cvt8(v0, v1); scol = (plane == 3 ? 3200 : plane * 1024) + (tile & 3) * 256 + cl; }
                        else { if (bj == 1) continue; *(h16x8*)((char*)ws + WS_WA + (unsigned)(row * 128 + cl) * 2u) = cvt8(v0, v1); scol = 3072 + cl; }
                        if (endj == 1) { float* o = out + (samp ? OFF_SHIFT_S : OFF_SHIFT_P) + (size_t)bidx * SHIFT_COLS + scol; *(f32x4*)o = v0; *(f32x4*)(o + 4) = v1; }
                    }
                } else {
                    const int ch = 64 * (tile - 17) + 16 * wc + 4 * fq;
                    const f32x4 gb = acc[ai][0][m][0], gc = acc[ai][0][m][1], xb = acc[ai][1][m][0], zb = acc[ai][1][m][1];
                    f32x4 uu = gc * xb, gz;
#pragma unroll
                    for (int j = 0; j < 4; ++j) gz[j] = gb[j] * fsilu(zb[j]);
                    const unsigned o = (unsigned)(row * D + ch) * 2u;
                    *(h16x4*)(ub + o) = cvt4(uu);
                    *(h16x4*)(gzb + o) = cvt4(gz);
                    if (endj >= 0) *(f32x4*)(out + (samp ? OFF_CONV_S : OFF_CONV_P) + ((size_t)bidx * 2 + endj) * D + ch) = uu;
                }
            }
    }
};
struct Sched1 {
    pg::TileOrder o; const char* A; const char* B;
    __device__ bool next(int i, pg::Unit& u) const { int pm, pn; if (!o.get(i, pm, pn)) return false; u.pm = pm; u.pn = pn; u.kind = 0;
        u.A = A + (size_t)pm * 256 * D * 2; u.B = B + (size_t)pn * 256 * D * 2; return true; }
};

struct Epi3 {
    float* out; unsigned char* ws; const float* rstd0;
    __device__ __forceinline__ void operator()(const f32x4 (&acc)[2][2][4][2], const pg::Unit& u, int wr, int wc, int fr, int fq) const {
        const bool ptile = u.pm < NMT - 1;
        char* ga = slotbase(out, ws, 0, ptile); char* gb = slotbase(out, ws, 1, ptile); char* mb = (char*)ws + WS_R;
#pragma unroll
        for (int ai = 0; ai < 2; ++ai)
#pragma unroll
            for (int m = 0; m < 4; ++m) {
                const int row = u.pm * 256 + ai * 128 + wr * 64 + m * 16 + fr;
#pragma unroll
                for (int bj = 0; bj < 2; ++bj) {
                    const unsigned o = (unsigned)(row * D + u.pn * 256 + bj * 128 + wc * 32 + 8 * fq) * 2u;
                    const f32x4 a0 = acc[ai][bj][m][0], a1 = acc[ai][bj][m][1];
                    if (u.kind < 2) {
                        const float rs = -1.4426950408889634f; f32x4 g0, g1;
#pragma unroll
                        for (int j = 0; j < 4; ++j) { g0[j] = __builtin_amdgcn_rcpf(1.0f + __builtin_amdgcn_exp2f(a0[j] * rs)); g1[j] = __builtin_amdgcn_rcpf(1.0f + __builtin_amdgcn_exp2f(a1[j] * rs)); }
                        *(h16x8*)((u.kind == 0 ? ga : gb) + o) = cvt8(g0, g1);
                    } else if (u.kind == 3) {
                        const h16x8 g = *(const h16x8*)(gb + o);
                        const f32x4 g0 = up4(__builtin_shufflevector(g, g, 0, 1, 2, 3)), g1 = up4(__builtin_shufflevector(g, g, 4, 5, 6, 7));
                        *(h16x8*)(gb + o) = cvt8(g0 * a0, g1 * a1);
                    } else {
                        const h16x8 g = *(const h16x8*)(ga + o), t = *(const h16x8*)(gb + o);
                        const f32x4 t0 = up4(__builtin_shufflevector(t, t, 0, 1, 2, 3)), t1 = up4(__builtin_shufflevector(t, t, 4, 5, 6, 7));
                        const f32x4 g0 = up4(__builtin_shufflevector(g, g, 0, 1, 2, 3)), g1 = up4(__builtin_shufflevector(g, g, 4, 5, 6, 7));
                        *(h16x8*)(mb + o) = cvt8(t0 + g0 * a0, t1 + g1 * a1);
                    }
                }
            }
    }
};
struct Sched3 {
    pg::TileOrder o; unsigned char* ws; int nk; int kinds;
    __device__ bool next(int i, pg::Unit& u) const { int pm, pn; const int q = i / nk, kind = (kinds >> (4 * (i - q * nk))) & 15; if (!o.get(q, pm, pn)) return false; u.pm = pm; u.pn = pn; u.kind = kind;
        const size_t aoff = kind < 2 ? WS_XH : kind == 2 ? WS_Z : WS_ACTB;
        const size_t boff = kind == 0 ? WS_W1T + (size_t)8448 * D * 2 : kind == 1 ? WS_W1T + (size_t)(8448 + 1024) * D * 2 : kind == 2 ? WS_WOA : WS_WOB;
        u.A = (const char*)ws + aoff + (size_t)pm * 256 * D * 2; u.B = (const char*)ws + boff + (size_t)pn * 256 * D * 2; return true; }
};
__device__ __forceinline__ void unit3(pg::Unit& u, unsigned char* ws, int pm, int pn, int kind) {
    u.pm = pm; u.pn = pn; u.kind = kind;
    const size_t aoff = kind < 2 ? WS_XH : kind == 2 ? WS_Z : WS_ACTB;
    const size_t boff = kind == 0 ? WS_W1T + (size_t)8448 * D * 2 : kind == 1 ? WS_W1T + (size_t)(8448 + 1024) * D * 2 : kind == 2 ? WS_WOA : WS_WOB;
    u.A = (const char*)ws + aoff + (size_t)pm * 256 * D * 2; u.B = (const char*)ws + boff + (size_t)pn * 256 * D * 2;
}
struct SchedH {
    pg::TileOrder o; unsigned char* ws; int c;
    __device__ bool next(int i, pg::Unit& u) const {
        const int nreg = c < 4 ? 2 : 4; int q, kind;
        if (i < 3 * nreg) { const int r = i / 3, kk = i - 3 * r; q = c + 128 * r; kind = kk == 2 ? 3 : kk; }
        else { const int e = i - 3 * nreg;
            if (c >= 4 && c < 12 && e == 0) { const int ob = c - 4; q = (ob & 3) + 128 * (2 + (ob >> 2)); kind = 0; }
            else if (c >= 12 && c < 20 && e < 2) { const int ob = c - 12; q = (ob & 3) + 128 * (2 + (ob >> 2)); kind = e == 0 ? 1 : 3; }
            else return false; }
        int pm, pn; if (!o.get_linear(q, pm, pn)) return false;
        unit3(u, ws, pm, pn, kind); return true; }
};
struct SchedList3 { unsigned char* ws; int pm, pn, n, kinds;
    __device__ bool next(int i, pg::Unit& u) const { if (i >= n) return false; unit3(u, ws, pm, pn, (kinds >> (4 * i)) & 15); return true; } };
struct SchedOne { const char* A; const char* B; int pm, pn, K;
    __device__ bool next(int i, pg::Unit& u) const { if (i >= 1) return false; u.pm = pm; u.pn = pn; u.kind = 0; u.A = A + (size_t)pm * 256 * K * 2; u.B = B + (size_t)pn * 256 * K * 2; return true; } };
__device__ __forceinline__ void sub_barrier(unsigned* cnt, unsigned n, int wave_s) {
    asm volatile("s_waitcnt vmcnt(0)" ::: "memory");
    __syncthreads();
    if (fresh_tid_w(wave_s) == 0) {
        __builtin_amdgcn_fence(__ATOMIC_RELEASE, "agent");
        asm volatile("s_waitcnt vmcnt(0)" ::: "memory");
        xb_add(cnt, 1u);
        unsigned sp = 0; while (xb_ld(cnt) < n) {     __builtin_amdgcn_s_sleep(2); if (++sp > (1u << 24)) break; }
        __builtin_amdgcn_fence(__ATOMIC_ACQUIRE, "agent");
        asm volatile("s_waitcnt vmcnt(0)" ::: "memory");
    }
    __syncthreads();
}

__device__ __forceinline__ float ssq_total(const float* ssq, int row, int fq) {
    const f32x4 v = *(const f32x4*)(ssq + (size_t)row * 16 + 4 * fq); float s = (v.x + v.y) + (v.z + v.w);
    s += __shfl_xor(s, 16); s += __shfl_xor(s, 32); return s;
}
struct Epi4 {
    unsigned char* ws; const float* xp; const float* xs;
    __device__ __forceinline__ void operator()(const f32x4 (&acc)[2][2][4][2], const pg::Unit& u, int wr, int wc, int fr, int fq) const {
        float* ssq = (float*)(ws + WS_SSQ1);
        const char* xb = (const char*)ws + WS_XH; char* hb = (char*)ws + WS_K;
#pragma unroll
        for (int ai = 0; ai < 2; ++ai)
#pragma unroll
            for (int m = 0; m < 4; ++m) {
                const int row = u.pm * 256 + ai * 128 + wr * 64 + m * 16 + fr;
                const bool ok = row < MREAL; float s = 0.f;
                const float rms = ((const float*)(ws + WS_RSTD0))[ok ? row : 0];
#pragma unroll
                for (int bj = 0; bj < 2; ++bj) {
                    const unsigned e = (unsigned)(row * D + u.pn * 256 + bj * 128 + wc * 32 + 8 * fq);
                    if (ok) {
                        const h16x8 xh = *(const h16x8*)(xb + e * 2u);
                        const f32x4 x0 = up4(__builtin_shufflevector(xh, xh, 0, 1, 2, 3)) * rms + acc[ai][bj][m][0], x1 = up4(__builtin_shufflevector(xh, xh, 4, 5, 6, 7)) * rms + acc[ai][bj][m][1];
                        *(h16x8*)(hb + e * 2u) = cvt8(x0, x1);
                        s += (x0.x * x0.x + x0.y * x0.y) + (x0.z * x0.z + x0.w * x0.w) + (x1.x * x1.x + x1.y * x1.y) + (x1.z * x1.z + x1.w * x1.w);
                    }
                }
                s += __shfl_xor(s, 16); s += __shfl_xor(s, 32);
                if (ok && fq == 0) ssq[(unsigned)(row * 16 + u.pn * 4 + wc)] = s;
            }
    }
};
struct Sched4 { pg::TileOrder o; const char* A; const char* B;
    __device__ bool next(int i, pg::Unit& u) const { int pm, pn; if (!o.get(i, pm, pn)) return false; u.pm = pm; u.pn = pn; u.kind = 0;
        u.A = A + (size_t)pm * 256 * D * 2; u.B = B + (size_t)pn * 256 * D * 2; return true; } };
struct Epi5a {
    unsigned char* ws;
    __device__ __forceinline__ void operator()(const f32x4 (&acc)[2][2][4][2], const pg::Unit& u, int wr, int wc, int fr, int fq) const {
        const float* ssq = (const float*)(ws + WS_SSQ1); char* gbp = (char*)ws + WS_V;
#pragma unroll
        for (int ai = 0; ai < 2; ++ai)
#pragma unroll
            for (int m = 0; m < 4; ++m) {
                const int row = u.pm * 256 + ai * 128 + wr * 64 + m * 16 + fr;
                const int rowc = row < MREAL ? row : MREAL - 1;
                const float rs = -1.4426950408889634f * __builtin_amdgcn_rsqf(ssq_total(ssq, rowc, fq) * (1.0f / D) + EPS);
#pragma unroll
                for (int bj = 0; bj < 2; ++bj) {
                    const unsigned e = (unsigned)(row * D + u.pn * 256 + bj * 128 + wc * 32 + 8 * fq); f32x4 g0, g1;
#pragma unroll
                    for (int j = 0; j < 4; ++j) { g0[j] = __builtin_amdgcn_rcpf(1.0f + __builtin_amdgcn_exp2f(acc[ai][bj][m][0][j] * rs)); g1[j] = __builtin_amdgcn_rcpf(1.0f + __builtin_amdgcn_exp2f(acc[ai][bj][m][1][j] * rs)); }
                    *(h16x8*)(gbp + e * 2u) = cvt8(g0, g1);
                }
            }
    }
};
struct Epi5b {
    float* out; unsigned char* ws; const float* gfinal; gu32* ctl; LAS unsigned char* lx;
    __device__ __forceinline__ void operator()(f32x4 (&acc)[2][2][4][2], const pg::Unit& u, int wr, int wc, int fr_in, int fq_in) const {
        int fr = fr_in, fq = fq_in; asm volatile("" : "+v"(fr), "+v"(fq));
        const char* gbp = (const char*)ws + WS_V; const char* xhp = (const char*)ws + WS_K; char* ob = (char*)out;
        LAS float* P = (LAS float*)lx; LAS float* S = (LAS float*)(lx + 4096);
        const int wid = wr * 4 + wc, lane = fq * 16 + fr;
        LAS float* Pb = P + (wr * 64 + fr) * 4 + wc; const LAS float* Sb = S + wr * 64 + fr;
#pragma unroll
        for (int ai = 0; ai < 2; ++ai)
#pragma unroll
            for (int m = 0; m < 4; ++m) {
                const int rl = ai * 128 + wr * 64 + m * 16 + fr, row = u.pm * 256 + rl;
                const bool ok = row < MREAL; float s = 0.f;
#pragma unroll
                for (int bj = 0; bj < 2; ++bj) {
                    const unsigned e = (unsigned)(row * D + u.pn * 256 + bj * 128 + wc * 32 + 8 * fq);
                    if (ok) {
                        const h16x8 g = *(const h16x8*)(gbp + e * 2u), xh = *(const h16x8*)(xhp + e * 2u);
                        const f32x4 g0 = up4(__builtin_shufflevector(g, g, 0, 1, 2, 3)), g1 = up4(__builtin_shufflevector(g, g, 4, 5, 6, 7));
                        const f32x4 x0 = up4(__builtin_shufflevector(xh, xh, 0, 1, 2, 3)) + g0 * acc[ai][bj][m][0], x1 = up4(__builtin_shufflevector(xh, xh, 4, 5, 6, 7)) + g1 * acc[ai][bj][m][1];
                        acc[ai][bj][m][0] = x0; acc[ai][bj][m][1] = x1;
                        s += (x0.x * x0.x + x0.y * x0.y) + (x0.z * x0.z + x0.w * x0.w) + (x1.x * x1.x + x1.y * x1.y) + (x1.z * x1.z + x1.w * x1.w);
                    }
                }
                s += __shfl_xor(s, 16); s += __shfl_xor(s, 32);
                if (fq == 0) Pb[(ai * 128 + m * 16) * 4] = s;
                if (m & 1) asm volatile("" ::: "memory");
            }
        asm volatile("s_waitcnt lgkmcnt(0)" ::: "memory"); __builtin_amdgcn_s_barrier(); asm volatile("" ::: "memory");
        const int rrow = wid * 32 + (lane & 31);
        float* slots = (float*)(ws + WS_XCH) + ((size_t)u.pm * 256 + rrow) * 4;
        if (lane < 32) { const f32x4 p4 = *(const LAS f32x4*)(P + rrow * 4); __hip_atomic_store(slots + u.pn, (p4.x + p4.y) + (p4.z + p4.w), __ATOMIC_RELAXED, __HIP_MEMORY_SCOPE_AGENT); }
        asm volatile("s_waitcnt vmcnt(0)" ::: "memory");
        unsigned* cnt = (unsigned*)(ctl + CW_PANEL + 64 * u.pm);
        if (lane == 0) __hip_atomic_fetch_add(cnt, 1u, __ATOMIC_RELAXED, __HIP_MEMORY_SCOPE_AGENT);
        if (wid == 0) {
            unsigned sp = 0;
            while ((unsigned)__builtin_amdgcn_readfirstlane((int)__hip_atomic_load(cnt, __ATOMIC_RELAXED, __HIP_MEMORY_SCOPE_AGENT)) < 32u) { __builtin_amdgcn_s_sleep(2); if (++sp > (1u << 22)) break; }
            __builtin_amdgcn_fence(__ATOMIC_ACQUIRE, "agent");
        }
        asm volatile("s_waitcnt vmcnt(0) lgkmcnt(0)" ::: "memory"); __builtin_amdgcn_s_barrier(); asm volatile("" ::: "memory");
        if (lane < 32) { float t = 0.f;
#pragma unroll
            for (int q = 0; q < 4; ++q) t += __hip_atomic_load(slots + q, __ATOMIC_RELAXED, __HIP_MEMORY_SCOPE_AGENT);
            S[rrow] = __builtin_amdgcn_rsqf(t * (1.0f / D) + EPS); }
        asm volatile("s_waitcnt vmcnt(0) lgkmcnt(0)" ::: "memory"); __builtin_amdgcn_s_barrier(); asm volatile("" ::: "memory");
#pragma unroll
        for (int ai = 0; ai < 2; ++ai)
#pragma unroll
            for (int m = 0; m < 4; ++m) {
                const int rl = ai * 128 + wr * 64 + m * 16 + fr, row = u.pm * 256 + rl;
                const float rs = Sb[ai * 128 + m * 16];
                if (row < MREAL) {
#pragma unroll
                    for (int bj = 0; bj < 2; ++bj) {
                        const int col = u.pn * 256 + bj * 128 + wc * 32 + 8 * fq; const unsigned e = (unsigned)(row * D + col);
                        *(f32x4*)(ob + e * 4u) = acc[ai][bj][m][0] * rs * *(const f32x4*)(gfinal + col); *(f32x4*)(ob + e * 4u + 16) = acc[ai][bj][m][1] * rs * *(const f32x4*)(gfinal + col + 4);
                    }
                }
            }
        asm volatile("s_waitcnt lgkmcnt(0)" ::: "memory"); __builtin_amdgcn_s_barrier(); asm volatile("" ::: "memory");
    }
};
struct Sched5b { pg::TileOrder o; const char* A; const char* B;
    __device__ bool next(int i, pg::Unit& u) const { int pm, pn; if (!o.get(i, pm, pn)) return false; u.pm = pm; u.pn = pn; u.kind = 0;
        u.A = A + (size_t)pm * 256 * PLE * 2; u.B = B + (size_t)pn * 256 * PLE * 2; return true; } };

namespace s2 {
constexpr int RS = 72, MAT_B = 16 * RS * 2;
constexpr int CH_QT = 0, CH_RT = MAT_B, CH_BT = 2 * MAT_B, CH_KT = 3 * MAT_B, CH_VT = 4 * MAT_B, CH_MK = 5 * MAT_B, CH_NK = CH_MK + 512, CH_NB = CH_NK + 512, CH_TI = CH_NB + 512,
              CH_E8 = CH_TI + 512, CH_E16 = CH_E8 + 256, CH_BYTES = CH_E16 + 256;
constexpr int OFF_TW = 4 * CH_BYTES, OFF_AL = OFF_TW + 64 * RS * 2, OFF_YY = OFF_TW  , OFF_BON = OFF_AL + 64 * RS * 2, OFF_N2 = OFF_BON + 512, OFF_SZ = OFF_N2 + 512,
              OFF_CT = OFF_SZ + 8192, OFF_W2L = OFF_CT + 25 * 256, OFF_I2L = OFF_W2L + 64 * RS * 2, OFF_RAW = OFF_I2L + 64 * RS * 2;
constexpr int RAW_PLANE = 9216, RAW_R = 0, RAW_K = RAW_PLANE, RAW_V = 2 * RAW_PLANE, RAW_Z = 3 * RAW_PLANE, RAW_W = 4 * RAW_PLANE, RAW_BYTES = 4 * RAW_PLANE + 17408, OFF_END = OFF_RAW + RAW_BYTES;
static_assert(OFF_END <= SCAN_LDS_BYTES && 16384 <= 2 * 64 * RS * 2 && (OFF_RAW % 16) == 0, "scan LDS");
typedef short v4i16_t __attribute__((ext_vector_type(4)));
__device__ __forceinline__ f32x4 mm16(h16x4 a, h16x4 b, f32x4 c) {
    const h16x4 z = (h16x4){(h16)0.f, (h16)0.f, (h16)0.f, (h16)0.f};
    return __builtin_amdgcn_mfma_f32_16x16x32_f16(__builtin_shufflevector(a, z, 0, 1, 2, 3, 4, 5, 6, 7), __builtin_shufflevector(b, z, 0, 1, 2, 3, 4, 5, 6, 7), c, 0, 0, 0); }
__device__ __forceinline__ h16x4 ldtr(const LAS unsigned char* p) { return __builtin_bit_cast(h16x4, __builtin_amdgcn_ds_read_tr16_b64_v4i16((LAS v4i16_t*)p)); }
__device__ __forceinline__ h16x4 ldR(const LAS unsigned char* m, int row, int col) { return *(const LAS h16x4*)(m + (row * RS + col) * 2); }
__device__ __forceinline__ h16x4 ldS(const LAS unsigned char* m, int row, int col) { return *(const LAS h16x4*)(m + (row * 16 + col) * 2); }
template <int CTRL> __device__ __forceinline__ float dppf(float x) { return __builtin_bit_cast(float, __builtin_amdgcn_update_dpp(0, __builtin_bit_cast(int, x), CTRL, 0xf, 0xf, true)); }
__device__ __forceinline__ f32x4 mix4_(h16x4 c, h16x4 d, f32x4 mu) {
    return (f32x4){ __builtin_fmaf((float)d[0], mu[0], (float)c[0]), __builtin_fmaf((float)d[1], mu[1], (float)c[1]), __builtin_fmaf((float)d[2], mu[2], (float)c[2]), __builtin_fmaf((float)d[3], mu[3], (float)c[3]) }; }
typedef _Float16 h16x2 __attribute__((ext_vector_type(2)));
typedef unsigned u32x2 __attribute__((ext_vector_type(2)));
typedef _Float16 h16x2 __attribute__((ext_vector_type(2)));
#define HMUL(hv, i, b) __builtin_fmaf((float)(hv)[i], (b), 0.0f)
#define HFMA(hv, i, b, c) __builtin_fmaf((float)(hv)[i], (b), (c))
__device__ __forceinline__ float rowscan16(float x) { x += dppf<0x111>(x); x += dppf<0x112>(x); x += dppf<0x114>(x); x += dppf<0x118>(x); return x; }
}
__device__ __forceinline__ void scan_prefetch(LAS unsigned char* L, const unsigned char* ws, int wave, int lane, int h, int rr, bool skip0) {
    using namespace s2;
    for (int q = wave; q < 53; q += NWAVES) {
        if (q < 36) { const int p = q / 9, qq = q - 9 * p, r0 = 8 * qq + (lane >> 3), c = (lane & 7) ^ (r0 & 7);
            int r = r0 > 64 ? 64 : r0; if (skip0 && r == 0) r = 1;
            const size_t pb = p == 0 ? WS_R : p == 1 ? WS_K : p == 2 ? WS_V : WS_Z;
            __builtin_amdgcn_global_load_lds((const unsigned*)(ws + pb + (size_t)(rr + r) * 2048 + 128 * h + 16 * c), (LAS unsigned*)(L + OFF_RAW + p * RAW_PLANE + qq * 1024), 16, 0, 0);
        } else { const int qq = q - 36, r0 = 4 * qq + (lane >> 4), c = lane & 15, cs = (c & 8) | ((c & 7) ^ (r0 & 7));
            int r = r0 > 64 ? 64 : r0; if (skip0 && r == 0) r = 1;
            __builtin_amdgcn_global_load_lds((const unsigned*)(ws + WS_WA + (size_t)(rr + r) * 256 + 16 * cs), (LAS unsigned*)(L + OFF_RAW + RAW_W + qq * 1024), 16, 0, 0);
        }
    }
}
__device__ __forceinline__ void scan_prefetch_fast(LAS unsigned char* L, const unsigned char* ws, int wave, int lane, int h, int rr) {
    using namespace s2;
    if (wave < 4) {
        const int r_l = lane >> 3, cx = (lane & 7) ^ r_l;
        const size_t pb = wave == 0 ? WS_R : wave == 1 ? WS_K : wave == 2 ? WS_V : WS_Z;
        const unsigned char* base = ws + pb + 128 * h + 16 * cx;
        const unsigned char* a = base + (size_t)(rr + r_l) * 2048;
        LAS unsigned char* d = L + OFF_RAW + wave * RAW_PLANE;
#pragma unroll
        for (int qq = 0; qq < 8; ++qq) __builtin_amdgcn_global_load_lds((const unsigned*)(a + qq * 16384), (LAS unsigned*)(d + qq * 1024), 16, 0, 0);
        __builtin_amdgcn_global_load_lds((const unsigned*)(base + (size_t)(rr + 64) * 2048), (LAS unsigned*)(d + 8 * 1024), 16, 0, 0);
    } else {
        const int w4 = wave - 4, r_l = lane >> 4, c = lane & 15;
#pragma unroll
        for (int i = 0; i < 5; ++i) { const int qq = w4 + 4 * i;
            if (qq < 17) { const int r0 = 4 * qq + r_l, r = qq == 16 ? 64 : r0, cs = (c & 8) | ((c & 7) ^ (r0 & 7));
                __builtin_amdgcn_global_load_lds((const unsigned*)(ws + WS_WA + (size_t)(rr + r) * 256 + 16 * cs), (LAS unsigned*)(L + OFF_RAW + RAW_W + qq * 1024), 16, 0, 0); } }
    }
}
#define SBAR() do { asm volatile("s_waitcnt lgkmcnt(0)" ::: "memory"); __builtin_amdgcn_s_barrier(); asm volatile("" ::: "memory"); } while (0)
__device__ __forceinline__ void scan_head_v2(Frame& F, int bh, bool dry) {
    using namespace s2;
    const bool samp = bh >= 128; const int b = (bh & 127) >> 4, h = bh & 15;
    const int T = samp ? DSEQ : SEQ, row0 = samp ? NP + DSEQ * b : SEQ * b;
    unsigned char* ws = F.ws; float* out = F.out;
    char* Zb = (char*)(ws + WS_Z);
    LAS unsigned char* L = F.lds;
    const int tid = fresh_tid_w(F.wave_s), lane = tid & 63, wave = F.wave_s, c15 = lane & 15, g = lane >> 4;
    const int cw = wave & 3, hf = wave >> 2;
    scan_prefetch(L, ws, wave, lane, h, row0 - 1, true);
    for (int i = tid; i < 25 * 64; i += NWAVES * 64) { const int kind = i >> 6, k = i & 63, hk = 64 * h + k; float v;
        const float* mu = F.in[IN_MU]; const float* sh = F.in[IN_ST_SHIFT] + (size_t)b * SHIFT_COLS;
        switch (kind) { case 0: v = mu[hk]; break; case 1: v = mu[1024 + hk]; break; case 2: v = mu[2048 + hk]; break; case 3: v = mu[3200 + hk]; break;
            case 4: v = F.in[IN_KREM][hk]; break; case 5: v = F.in[IN_KREP][hk]; break; case 6: v = -1.4426950408889634f * F.in[IN_WDEC0][hk]; break; case 7: v = -1.4426950408889634f * F.in[IN_WICL0][hk]; break;
            case 8: v = F.in[IN_RBONUS][hk]; break; case 9: v = F.in[IN_GNW][hk]; break; case 10: v = F.in[IN_GNB][hk]; break; case 11: v = mu[3072 + k]; break; case 12: v = mu[3136 + k]; break;
            case 13: v = samp ? sh[hk] : 0.f; break; case 14: v = samp ? sh[1024 + hk] : 0.f; break; case 15: v = samp ? sh[2048 + hk] : 0.f; break; case 16: v = samp ? sh[3200 + hk] : 0.f; break;
            case 17: v = samp ? sh[3072 + k] : 0.f; break; case 18: v = samp ? sh[3136 + k] : 0.f; break;
            case 19: v = 1.f - F.in[IN_KREP][hk]; break; case 20: v = 1.f - mu[1024 + hk]; break; case 21: v = 1.f - mu[2048 + hk]; break; case 22: v = 1.f - mu[3200 + hk]; break;
            case 23: v = 1.f - mu[3072 + k]; break; default: v = 1.f - mu[3136 + k]; break; }
        *(LAS float*)(L + OFF_CT + i * 4) = v; }
    __syncthreads();
    for (int i = tid; i < 8 * 64; i += NWAVES * 64) { const int kind = i >> 6, k = i & 63;
        const int src = kind == 0 ? 0 : kind == 1 ? 1 : kind == 2 ? 2 : kind == 3 ? 3 : kind == 4 ? 4 : kind == 5 ? 8 : kind == 6 ? 11 : 12;
        const float v = *(const LAS float*)(L + OFF_CT + (src * 64 + k) * 4);
        asm volatile("" ::: "memory");
        *(LAS h16*)(L + OFF_CT + 20 * 256 + i * 2) = (h16)v; }
    { const int k = tid >> 3, ch = tid & 7;
      *(LAS h16x8*)(L + OFF_W2L + (k * RS + 8 * ch) * 2) = *(const h16x8*)((const h16*)(ws + WS_W2T) + (size_t)(64 * h + k) * 64 + 8 * ch);
      *(LAS h16x8*)(L + OFF_I2L + (k * RS + 8 * ch) * 2) = *(const h16x8*)((const h16*)(ws + WS_I2T) + (size_t)(64 * h + k) * 64 + 8 * ch); }
#define CT4(kind, k) (*(const LAS f32x4*)(L + OFF_CT + ((kind) * 64 + (k)) * 4))
#define CTH4(kind, k) (*(const LAS h16x4*)(L + OFF_CT + 20 * 256 + ((kind) * 64 + (k)) * 2))
#define CTH8(kind, k) (*(const LAS h16x8*)(L + OFF_CT + 20 * 256 + ((kind) * 64 + (k)) * 2))
#define CT1(kind, k) (*(const LAS float*)(L + OFF_CT + ((kind) * 64 + (k)) * 4))
#define RAW8(p, row, kc) (*(const LAS h16x4*)(L + OFF_RAW + (p) * RAW_PLANE + (row) * 128 + ((((kc) >> 3) ^ ((row) & 7)) << 4) + ((kc) & 7) * 2))
#define RAWW8(row, hc) (*(const LAS h16x4*)(L + OFF_RAW + RAW_W + (row) * 256 + (((((hc) >> 3) & 8) | ((((hc) >> 3) & 7) ^ ((row) & 7))) << 4) + ((hc) & 7) * 2))
    f32x4 S[4];
#pragma unroll
    for (int kt = 0; kt < 4; ++kt) { S[kt] = (f32x4){0.f, 0.f, 0.f, 0.f};
        if (samp && wave < 4) S[kt] = *(const f32x4*)(F.in[IN_ST_WKV] + ((size_t)(b * 16 + h) * 64 + 16 * wave + c15) * 64 + 16 * kt + 4 * g); }
    asm volatile("s_waitcnt vmcnt(0)" ::: "memory");
    SBAR();
    if (tid < 96) { const int kind = tid >> 4, c4 = (tid & 15) * 4;
        const int ctk = kind < 3 ? 13 + kind : kind == 3 ? 16 : 13 + kind; const h16x4 v = cvt4(CT4(ctk, c4));
        if (kind < 4) *(LAS h16x4*)(L + OFF_RAW + kind * RAW_PLANE + (((c4 >> 3) ^ 0) << 4) + (c4 & 7) * 2) = v;
        else { const int hc = (kind - 4) * 64 + c4; *(LAS h16x4*)(L + OFF_RAW + RAW_W + ((((hc >> 3) & 8) | (((hc >> 3) & 7) ^ 0)) << 4) + (hc & 7) * 2) = v; } }
    SBAR();
    for (int t0 = 0; t0 < T; t0 += 64) {
        const int nb = (T - t0) < 64 ? (T - t0) : 64, nch = nb >> 4;
        const bool cact = cw < nch;
        const int tl = 16 * cw + c15;
        LAS unsigned char* CB = L + cw * CH_BYTES;
        h16x4 rm[2], km[2], kapm[2], rbm[2]; float n2 = 0.f;
#define MIX4(c, p, mu4) mix4_((c), (p) - (c), (mu4))
        if (cact) {
#pragma unroll
            for (int kt = 0; kt < 2; ++kt) {
                const int kc = 32 * hf + 16 * kt + 4 * g;
                const h16x4 rc = RAW8(0, tl + 1, kc), kc4 = RAW8(1, tl + 1, kc), vc = RAW8(2, tl + 1, kc), wlc = RAWW8(tl + 1, kc), alc = RAWW8(tl + 1, 64 + kc);
                const h16x4 rp = RAW8(0, tl, kc), kp = RAW8(1, tl, kc), vp = RAW8(2, tl, kc), wlp = RAWW8(tl, kc), alp = RAWW8(tl, 64 + kc);
                const h16x4 r16 = rc + CTH4(0, kc) * (rp - rc), k16 = kc4 + CTH4(1, kc) * (kp - kc4), v16 = vc + CTH4(2, kc) * (vp - vc);
                const h16x4 wl16 = wlc + CTH4(6, kc) * (wlp - wlc), al16 = alc + CTH4(7, kc) * (alp - alc);
                const h16x4 kap16 = k16 * CTH4(4, kc), rb16 = r16 * CTH4(5, kc);
                rm[kt] = r16; km[kt] = k16; kapm[kt] = kap16; rbm[kt] = rb16;
                n2 = __builtin_amdgcn_fdot2(__builtin_shufflevector(kap16, kap16, 0, 1), __builtin_shufflevector(kap16, kap16, 0, 1), n2, false);
                n2 = __builtin_amdgcn_fdot2(__builtin_shufflevector(kap16, kap16, 2, 3), __builtin_shufflevector(kap16, kap16, 2, 3), n2, false);
                f32x4 tw;
#pragma unroll
                for (int i = 0; i < 4; ++i) tw[i] = __builtin_fmaf(-2.0f, __builtin_amdgcn_rcpf(1.0f + __builtin_amdgcn_exp2f(HMUL(wl16, i, 2.0f * 1.4426950408889634f))), 1.0f);
                *(LAS h16x4*)(L + OFF_TW + (tl * RS + kc) * 2) = cvt4(tw); *(LAS h16x4*)(L + OFF_AL + (tl * RS + kc) * 2) = al16;
                *(LAS h16x4*)(CB + CH_VT + (c15 * RS + kc) * 2) = v16;
            }
            n2 += __shfl_xor(n2, 16); n2 += __shfl_xor(n2, 32);
            if (g == 0) *(LAS float*)(L + OFF_N2 + (hf * 64 + tl) * 4) = n2;
        }
        {
            const int t = tid >> 3, vg = tid & 7, v0 = 8 * vg;
            if (t < nb) {
                const h16x8 zc8 = *(const LAS h16x8*)(L + OFF_RAW + RAW_Z + (t + 1) * 128 + ((vg ^ ((t + 1) & 7)) << 4));
                const h16x8 zp8 = *(const LAS h16x8*)(L + OFF_RAW + RAW_Z + t * 128 + ((vg ^ (t & 7)) << 4));
                const h16x8 z8 = zc8 + CTH8(3, v0) * (zp8 - zc8);
                float sv[8];
#pragma unroll
                for (int j = 0; j < 8; ++j) sv[j] = HMUL(z8, j, __builtin_amdgcn_rcpf(1.0f + __builtin_amdgcn_exp2f(HMUL(z8, j, -1.4426950408889634f))));
                *(LAS h16x8*)(L + OFF_SZ + (t * 64 + v0) * 2) = cvt8((f32x4){sv[0], sv[1], sv[2], sv[3]}, (f32x4){sv[4], sv[5], sv[6], sv[7]});
            }
        }
        SBAR();
        if (t0 + 64 < T) scan_prefetch_fast(L, ws, wave, lane, h, row0 + t0 + 63);
        if (cact) {
            f32x4 dacc[2], aacc[2];
#pragma unroll
            for (int kt = 0; kt < 2; ++kt) { dacc[kt] = CT4(6, 32 * hf + 16 * kt + 4 * g); aacc[kt] = CT4(7, 32 * hf + 16 * kt + 4 * g); }
#pragma unroll
            for (int jp = 0; jp < 2; ++jp) {
                const h16x4 tw0 = *(const LAS h16x4*)(L + OFF_TW + (tl * RS + 32 * jp + 4 * g) * 2), tw1 = *(const LAS h16x4*)(L + OFF_TW + (tl * RS + 32 * jp + 16 + 4 * g) * 2);
                const h16x4 al0 = *(const LAS h16x4*)(L + OFF_AL + (tl * RS + 32 * jp + 4 * g) * 2), al1 = *(const LAS h16x4*)(L + OFF_AL + (tl * RS + 32 * jp + 16 + 4 * g) * 2);
                const h16x8 twf = __builtin_shufflevector(tw0, tw1, 0, 1, 2, 3, 4, 5, 6, 7), alf = __builtin_shufflevector(al0, al1, 0, 1, 2, 3, 4, 5, 6, 7);
#pragma unroll
                for (int kt = 0; kt < 2; ++kt) { const int o = ((32 * hf + 16 * kt + c15) * RS + 32 * jp + 4 * g) * 2;
                    const h16x8 wf = __builtin_shufflevector(*(const LAS h16x4*)(L + OFF_W2L + o), *(const LAS h16x4*)(L + OFF_W2L + o + 32), 0, 1, 2, 3, 4, 5, 6, 7);
                    const h16x8 jf = __builtin_shufflevector(*(const LAS h16x4*)(L + OFF_I2L + o), *(const LAS h16x4*)(L + OFF_I2L + o + 32), 0, 1, 2, 3, 4, 5, 6, 7);
                    dacc[kt] = __builtin_amdgcn_mfma_f32_16x16x32_f16(wf, twf, dacc[kt], 0, 0, 0); aacc[kt] = __builtin_amdgcn_mfma_f32_16x16x32_f16(jf, alf, aacc[kt], 0, 0, 0); }
            }
            const float rn = __builtin_amdgcn_rsqf(fmaxf(*(const LAS float*)(L + OFF_N2 + tl * 4) + *(const LAS float*)(L + OFF_N2 + (64 + tl) * 4), 1e-24f));
            float bs = 0.f;
#pragma unroll
            for (int kt = 0; kt < 2; ++kt) {
                const int kc = 32 * hf + 16 * kt + 4 * g;
                const f32x4 krep = CT4(5, kc), omk = CT4(19, kc);
                f32x4 qt, rt, bt, kt4, e8v, e16v, khv, ktvv, bbv, Lcv, Lpv, refv;
#pragma unroll
                for (int i = 0; i < 4; ++i) {
                    const float lam = __builtin_amdgcn_rcpf(__builtin_fmaf(__builtin_amdgcn_exp2f(dacc[kt][i]), -1.0f / (DECAY_SCALE * 1.4426950408889634f), -1.0f / (DECAY_SCALE * 1.4426950408889634f))), a = __builtin_amdgcn_rcpf(1.0f + __builtin_amdgcn_exp2f(aacc[kt][i]));
                    khv[i] = HMUL(kapm[kt], i, rn); ktvv[i] = HMUL(km[kt], i, __builtin_fmaf(a, krep[i], omk[i])); bbv[i] = a * khv[i];
                    bs = HFMA(rbm[kt], i, ktvv[i], bs);
                    Lcv[i] = rowscan16(lam); Lpv[i] = Lcv[i] - lam;
                }
#pragma unroll
                for (int i = 0; i < 4; ++i) { refv[i] = __shfl(Lcv[i], (lane & 48) | 7); e16v[i] = __shfl(Lcv[i], (lane & 48) | 15); }
#pragma unroll
                for (int i = 0; i < 4; ++i) {
                    const float ea = __builtin_amdgcn_exp2f(Lpv[i] - refv[i]), eb = __builtin_amdgcn_exp2f(Lcv[i] - refv[i]), ec = __builtin_amdgcn_rcpf(eb);
                    qt[i] = khv[i] * ea; rt[i] = HMUL(rm[kt], i, eb); bt[i] = bbv[i] * ec; kt4[i] = ktvv[i] * ec; e8v[i] = refv[i];
                }
                const int o = (c15 * RS + kc) * 2;
                *(LAS h16x4*)(CB + CH_QT + o) = cvt4(qt); *(LAS h16x4*)(CB + CH_RT + o) = cvt4(rt); *(LAS h16x4*)(CB + CH_BT + o) = cvt4(bt); *(LAS h16x4*)(CB + CH_KT + o) = cvt4(kt4);
                if (c15 == 0) { *(LAS f32x4*)(CB + CH_E8 + kc * 4) = e8v; *(LAS f32x4*)(CB + CH_E16 + kc * 4) = e16v; }
            }
            bs += __shfl_xor(bs, 16); bs += __shfl_xor(bs, 32);
            if (g == 0) *(LAS float*)(L + OFF_BON + (hf * 64 + tl) * 4) = bs;
        }
        SBAR();
        if (cact) {
            h16x8 qf[2], bf[2];
#pragma unroll
            for (int p = 0; p < 2; ++p) { qf[p] = __builtin_shufflevector(ldR(CB + CH_QT, c15, 32 * p + 4 * g), ldR(CB + CH_QT, c15, 32 * p + 16 + 4 * g), 0, 1, 2, 3, 4, 5, 6, 7);
                bf[p] = __builtin_shufflevector(ldR(CB + CH_BT, c15, 32 * p + 4 * g), ldR(CB + CH_BT, c15, 32 * p + 16 + 4 * g), 0, 1, 2, 3, 4, 5, 6, 7); }
            const f32x4 z4 = (f32x4){0.f, 0.f, 0.f, 0.f};
            if (hf == 0) {
                f32x4 Dr = z4, Dc = z4;
#pragma unroll
                for (int p = 0; p < 2; ++p) { Dr = __builtin_amdgcn_mfma_f32_16x16x32_f16(bf[p], qf[p], Dr, 0, 0, 0); Dc = __builtin_amdgcn_mfma_f32_16x16x32_f16(qf[p], bf[p], Dc, 0, 0, 0); }
                f32x4 Xr, Xc, Id;
#pragma unroll
                for (int i = 0; i < 4; ++i) { const int u = 4 * g + i; Xr[i] = u < c15 ? -Dr[i] : 0.f; Xc[i] = c15 < u ? -Dc[i] : 0.f; Id[i] = u == c15 ? 1.f : 0.f; }
                const h16x4 hXr = cvt4(Xr), hXc = cvt4(Xc);
                const f32x4 X2c = mm16(hXr, hXc, z4), X2r = mm16(hXc, hXr, z4);
                const f32x4 S1c = Id + Xc, S1r = Id + Xr;
                const h16x4 hX2r = cvt4(X2r), hX2c = cvt4(X2c), hS1c = cvt4(S1c);
                const f32x4 S2c = mm16(hX2r, hS1c, S1c), S2r = mm16(hS1c, hX2r, S1r);
                const f32x4 X4c = mm16(hX2r, hX2c, z4), X4r = mm16(hX2c, hX2r, z4);
                const h16x4 hX4r = cvt4(X4r), hX4c = cvt4(X4c), hS2c = cvt4(S2c);
                const f32x4 S4c = mm16(hX4r, hS2c, S2c), S4r = mm16(hS2c, hX4r, S2r);
                const f32x4 X8r = mm16(hX4c, hX4r, z4);
                const f32x4 TIr = mm16(cvt4(S4c), cvt4(X8r), S4r);
                *(LAS h16x4*)(CB + CH_TI + (c15 * 16 + 4 * g) * 2) = cvt4(TIr);
            } else {
                h16x8 kf[2], rf[2];
#pragma unroll
                for (int p = 0; p < 2; ++p) { kf[p] = __builtin_shufflevector(ldR(CB + CH_KT, c15, 32 * p + 4 * g), ldR(CB + CH_KT, c15, 32 * p + 16 + 4 * g), 0, 1, 2, 3, 4, 5, 6, 7);
                    rf[p] = __builtin_shufflevector(ldR(CB + CH_RT, c15, 32 * p + 4 * g), ldR(CB + CH_RT, c15, 32 * p + 16 + 4 * g), 0, 1, 2, 3, 4, 5, 6, 7); }
                f32x4 mk = z4, nk = z4, nbm = z4;
#pragma unroll
                for (int p = 0; p < 2; ++p) { mk = __builtin_amdgcn_mfma_f32_16x16x32_f16(kf[p], qf[p], mk, 0, 0, 0); nk = __builtin_amdgcn_mfma_f32_16x16x32_f16(kf[p], rf[p], nk, 0, 0, 0); nbm = __builtin_amdgcn_mfma_f32_16x16x32_f16(bf[p], rf[p], nbm, 0, 0, 0); }
#pragma unroll
                for (int i = 0; i < 4; ++i) { const int u = 4 * g + i; if (!(u < c15)) mk[i] = 0.f; if (!(u <= c15)) { nk[i] = 0.f; nbm[i] = 0.f; } }
                const int o = (c15 * 16 + 4 * g) * 2;
                *(LAS h16x4*)(CB + CH_MK + o) = cvt4(mk); *(LAS h16x4*)(CB + CH_NK + o) = cvt4(nk); *(LAS h16x4*)(CB + CH_NB + o) = cvt4(nbm);
                { LAS float* e8 = (LAS float*)(CB + CH_E8) + lane; LAS float* e16 = (LAS float*)(CB + CH_E16) + lane; const float rf = *e8; *e8 = __builtin_amdgcn_exp2f(rf); *e16 = __builtin_amdgcn_exp2f(*e16 - rf); }
            }
        }
        SBAR();
        if (wave < 4) {
            const int troff = ((4 * g + (c15 >> 2)) * RS + 4 * (c15 & 3)) * 2;
            for (int c = 0; c < nch; ++c) {
                const LAS unsigned char* B = L + c * CH_BYTES;
                f32x4 e8[4], e16[4]; h16x4 q[4], r[4], ktr[4], btr[4];
#pragma unroll
                for (int kt = 0; kt < 4; ++kt) { e8[kt] = *(const LAS f32x4*)(B + CH_E8 + (16 * kt + 4 * g) * 4); q[kt] = ldR(B + CH_QT, c15, 16 * kt + 4 * g); }
                const h16x4 vh = ldtr(B + CH_VT + troff + 16 * wave * 2), mk = ldS(B + CH_MK, c15, 4 * g), ti = ldS(B + CH_TI, c15, 4 * g), nk = ldS(B + CH_NK, c15, 4 * g), nbm = ldS(B + CH_NB, c15, 4 * g);
#pragma unroll
                for (int kt = 0; kt < 4; ++kt) { r[kt] = ldR(B + CH_RT, c15, 16 * kt + 4 * g); ktr[kt] = ldtr(B + CH_KT + troff + 16 * kt * 2); btr[kt] = ldtr(B + CH_BT + troff + 16 * kt * 2);
                    e16[kt] = *(const LAS f32x4*)(B + CH_E16 + (16 * kt + 4 * g) * 4); }
                f32x4 S8[4]; h16x4 s8h[4];
#pragma unroll
                for (int kt = 0; kt < 4; ++kt) { S8[kt] = S[kt] * e8[kt]; s8h[kt] = cvt4(S8[kt]); }
                const f32x4 z4 = (f32x4){0.f, 0.f, 0.f, 0.f};
                const h16x8 s01 = __builtin_shufflevector(s8h[0], s8h[1], 0, 1, 2, 3, 4, 5, 6, 7), s23 = __builtin_shufflevector(s8h[2], s8h[3], 0, 1, 2, 3, 4, 5, 6, 7);
                f32x4 Pa = mm16(mk, vh, z4);
                Pa = __builtin_amdgcn_mfma_f32_16x16x32_f16(__builtin_shufflevector(q[0], q[1], 0, 1, 2, 3, 4, 5, 6, 7), s01, Pa, 0, 0, 0);
                const f32x4 Pb = __builtin_amdgcn_mfma_f32_16x16x32_f16(__builtin_shufflevector(q[2], q[3], 0, 1, 2, 3, 4, 5, 6, 7), s23, z4, 0, 0, 0);
                const f32x4 sg = mm16(ti, cvt4(Pa + Pb), z4);
                const h16x4 sn = -cvt4(sg);
                f32x4 Ya = mm16(nk, vh, z4);
                Ya = __builtin_amdgcn_mfma_f32_16x16x32_f16(__builtin_shufflevector(r[0], r[1], 0, 1, 2, 3, 4, 5, 6, 7), s01, Ya, 0, 0, 0);
                f32x4 Yb = __builtin_amdgcn_mfma_f32_16x16x32_f16(__builtin_shufflevector(r[2], r[3], 0, 1, 2, 3, 4, 5, 6, 7), s23, z4, 0, 0, 0);
#pragma unroll
                for (int kt = 0; kt < 4; ++kt) S8[kt] = mm16(ktr[kt], vh, S8[kt]);
                Yb = mm16(nbm, sn, Yb);
#pragma unroll
                for (int kt = 0; kt < 4; ++kt) S[kt] = mm16(btr[kt], sn, S8[kt]) * e16[kt];
                const f32x4 Y = Ya + Yb;
#pragma unroll
                for (int i = 0; i < 4; ++i) *(LAS float*)(L + OFF_YY + ((16 * c + 4 * g + i) * 64 + 16 * wave + c15) * 4) = Y[i];
            }
        }
        asm volatile("s_waitcnt vmcnt(0)" ::: "memory");
        SBAR();
        {
            const int t = tid >> 3, vg = tid & 7, v0 = 8 * vg;
            if (t < nb) {
                const f32x4 y0 = *(const LAS f32x4*)(L + OFF_YY + (t * 64 + v0) * 4), y1 = *(const LAS f32x4*)(L + OFF_YY + (t * 64 + v0 + 4) * 4);
                float y[8] = {y0.x, y0.y, y0.z, y0.w, y1.x, y1.y, y1.z, y1.w};
                float s = 0.f;
#pragma unroll
                for (int j = 0; j < 8; ++j) s += y[j];
                s += dppf<0xB1>(s); s += dppf<0x4E>(s); s += dppf<0x141>(s);
                const float mean = s * (1.0f / 64.0f); float q = 0.f;
#pragma unroll
                for (int j = 0; j < 8; ++j) { y[j] -= mean; q += y[j] * y[j]; }
                q += dppf<0xB1>(q); q += dppf<0x4E>(q); q += dppf<0x141>(q);
                const float rstd = __builtin_amdgcn_rsqf(q * (1.0f / 64.0f) + GN_EPS);
                const float bonus = *(const LAS float*)(L + OFF_BON + t * 4) + *(const LAS float*)(L + OFF_BON + (64 + t) * 4);
                const h16x8 vv = *(const LAS h16x8*)(L + (t >> 4) * CH_BYTES + CH_VT + ((t & 15) * RS + v0) * 2);
                const h16x8 sz = *(const LAS h16x8*)(L + OFF_SZ + (t * 64 + v0) * 2);
                const f32x4 gw0 = CT4(9, v0), gw1 = CT4(9, v0 + 4), gb0 = CT4(10, v0), gb1 = CT4(10, v0 + 4);
                h16x8 o;
#pragma unroll
                for (int j = 0; j < 8; ++j) o[j] = (h16)((y[j] * rstd * (j < 4 ? gw0[j & 3] : gw1[j & 3]) + (j < 4 ? gb0[j & 3] : gb1[j & 3]) + bonus * (float)vv[j]) * (float)sz[j]);
                if (!dry) { char* zp = Zb + (size_t)(row0 + t0 + t) * 2048 + 128 * h + 16 * vg; const u32x4 ov = __builtin_bit_cast(u32x4, o);
                    asm volatile("global_store_dwordx4 %0, %1, off sc1\n\ts_nop 1" :: "v"(zp), "v"(ov) : "memory"); }
            }
        }
        if (!samp && (t0 & 255) == 192) {
            asm volatile("s_waitcnt vmcnt(0)" ::: "memory");
            SBAR();
            if (tid == 0 && !dry) __hip_atomic_fetch_add((unsigned*)(F.ctl + CW_RDY) + 64 * (b * 16 + (t0 >> 8)), 1u, __ATOMIC_RELAXED, __HIP_MEMORY_SCOPE_AGENT);
        } else SBAR();
    }
#undef CT4
#undef CT1
#undef RAW8
#undef RAWW8
    if (wave < 4 && !dry) {
#pragma unroll
        for (int kt = 0; kt < 4; ++kt) *(f32x4*)(out + (samp ? OFF_WKV_S : OFF_WKV_P) + ((size_t)(b * 16 + h) * 64 + 16 * wave + c15) * 64 + 16 * kt + 4 * g) = S[kt];
    }
    asm volatile("s_waitcnt vmcnt(0)" ::: "memory");
    __syncthreads();
}
__device__ __forceinline__ void conv_pass(Frame& F, int part, int nparts) {
    const int tid_ = fresh_tid_w(F.wave_s);
    float* out = F.out; unsigned char* ws = F.ws; const float* cw = F.in[IN_CONVW]; h16* AB = (h16*)(ws + WS_ACTB);
    for (int it = part * 512 + tid_; it < (NMT - 1) * 2 * 128; it += nparts * 512) {
        const int c8 = (it & 127) * 8, m = (it >> 7) & 1, pm = it >> 8;
        if ((pm & 15) == 0) continue;
        const float* sp = (const float*)(ws + WS_SIDEP) + (size_t)pm * 2048 + m * 1024 + c8; const float* sg = (const float*)(ws + WS_SIDEG) + (size_t)pm * 2048 + m * 1024 + c8;
        const float* su = (const float*)(ws + WS_SIDEU) + (size_t)(pm - 1) * 2048 + c8;
        h16x8 o;
#pragma unroll
        for (int j = 0; j < 8; ++j) { const float um2 = su[j], um1 = su[1024 + j];
            const float extra = m == 0 ? cw[c8 + j] * um2 + cw[D + c8 + j] * um1 : cw[c8 + j] * um1;
            o[j] = (h16)(sp[j] + sg[j] * extra); }
        *(h16x8*)(AB + ((size_t)pm * 256 + m) * D + c8) = o;
    }
    for (int it = part * 512 + tid_; it < NS * 128; it += nparts * 512) {
        const int row = NP + (it >> 7), c8 = (it & 127) * 8, rr = row - NP, t = rr & (DSEQ - 1), b = rr >> 4;
        const h16x8 u0 = *(const h16x8*)(rowptr16(out, ws, 0, row) + c8), gz = *(const h16x8*)(rowptr16(out, ws, 1, row) + c8);
        float um1[8], um2[8];
        if (t >= 1) { const h16x8 v = *(const h16x8*)(rowptr16(out, ws, 0, row - 1) + c8);
#pragma unroll
            for (int j = 0; j < 8; ++j) um1[j] = (float)v[j]; }
        else {
#pragma unroll
            for (int j = 0; j < 8; ++j) um1[j] = F.in[IN_ST_CONV][((size_t)b * 2 + 1) * D + c8 + j]; }
        if (t >= 2) { const h16x8 v = *(const h16x8*)(rowptr16(out, ws, 0, row - 2) + c8);
#pragma unroll
            for (int j = 0; j < 8; ++j) um2[j] = (float)v[j]; }
        else {
#pragma unroll
            for (int j = 0; j < 8; ++j) um2[j] = F.in[IN_ST_CONV][((size_t)b * 2 + t) * D + c8 + j]; }
        h16x8 o;
#pragma unroll
        for (int j = 0; j < 8; ++j) { const float cv = cw[c8 + j] * um2[j] + cw[D + c8 + j] * um1[j] + cw[2 * D + c8 + j] * (float)u0[j]; o[j] = (h16)((float)gz[j] * cv); }
        *(h16x8*)(AB + (size_t)row * D + c8) = o;
    }
    for (int i = part * 512 + tid_; i < (MP - MREAL) * 128; i += nparts * 512) { h16x8 z;
#pragma unroll
        for (int j = 0; j < 8; ++j) z[j] = (h16)0.f;
        *(h16x8*)(AB + (size_t)MREAL * D + (size_t)i * 8) = z; }
}

constexpr int N_PHASES = 6;
__device__ __forceinline__ void merge_queue(Frame& F, const float* rstd0, bool wait_helpers) {
    unsigned char* ws = F.ws;
    for (;;) {
        if (fresh_tid_w(F.wave_s) == 0) {
            unsigned sp = 0;
            if (wait_helpers) { unsigned* hd = (unsigned*)(F.ctl + CW_SUB); while (xb_ld(hd) < 2u * (unsigned)(F.G - 128)) { __builtin_amdgcn_s_sleep(8); if (++sp > (1u << 24)) break; } }
            const unsigned idx = xb_add((unsigned*)(F.ctl + CW_MQ), 1u);
            if (idx < 512u) {
                unsigned* rdy = (unsigned*)(F.ctl + CW_RDY) + 64 * (((idx >> 2) & 7) * 16 + (idx >> 5)); sp = 0;
                while (xb_ld(rdy) < 16u) { __builtin_amdgcn_s_sleep(8); if (++sp > (1u << 24)) break; }
                __builtin_amdgcn_fence(__ATOMIC_ACQUIRE, "agent");
                asm volatile("s_waitcnt vmcnt(0)" ::: "memory");
            }
            F.MISC[0] = idx;
        }
        __syncthreads();
        const unsigned idx = (unsigned)__builtin_amdgcn_readfirstlane((int)F.MISC[0]);
        if (idx >= 512u) break;
        SchedList3 S{ws, (int)(((idx >> 2) & 7) * 16 + (idx >> 5)), (int)(idx & 3), 1, 0x2}; Epi3 E{F.out, ws, rstd0};
        pg::gemm_phase(F.lds, F.wave_s, D, S, E);
    }
}
__global__ void __launch_bounds__(NWAVES * 64, 2) mk_fwd(Args args) {
    extern __shared__ __attribute__((aligned(16))) unsigned char lds[];
    Frame F;
    F.lds = (LAS unsigned char*)lds; F.MISC = (volatile LAS unsigned*)(F.lds + MISC_OFF);
    F.wave_s = __builtin_amdgcn_readfirstlane((int)threadIdx.x >> 6);
    F.G = gridDim.x; F.bx = blockIdx.x; F.in = args.in; F.out = args.out; F.ws = args.ws;
    F.ctl = (gu32*)(args.ws + WS_CTL);
    for (int u = fresh_tid_w(F.wave_s); u < (LDS_BYTES - LDSCTL_OFF) / 4; u += NWAVES * 64) ((LAS unsigned*)(F.lds + LDSCTL_OFF))[u] = 0u;
    __syncthreads();
    XcdBarrier bar; bar.bar = (unsigned*)(F.ctl + CW_BAR); bar.x = 0; bar.st = nullptr;
    const int lo = args.ph_lo, hi = args.ph_hi;
    if (hi - lo > 1) bar = xcd_barrier_post((unsigned*)(F.ctl + CW_BAR), F.MISC + 8, F.wave_s);
#define IN(k) (lo <= (k) && (k) < hi)
#define SEAM(k) do { if (IN(k) && IN((k) + 1)) xcd_barrier(bar, F.wave_s); } while (0)
    unsigned char* ws = args.ws;
    const float* rstd0 = (const float*)(ws + WS_RSTD0);
#define REPS(k) _Pragma("unroll") for (int _r = (PROBE_PHASE == (k)) ? 0 : 1; _r < 2; ++_r)
    if (IN(0)) { REPS(0) { p0_prologue(F); asm volatile("s_waitcnt vmcnt(0)" ::: "memory"); __syncthreads(); } SEAM(0); }
    if (IN(1)) {
        REPS(1) {
        Sched1 S; S.o.init(NMT, 33, F.G, F.bx); S.A = (const char*)ws + WS_XH; S.B = (const char*)ws + WS_W1T;
        Epi1 E{F.out, ws, rstd0, F.in[IN_CONVW], F.lds + RING_BYTES};
        pg::gemm_phase<Sched1, Epi1, true>(F.lds, F.wave_s, D, S, E);
        { constexpr int NLAST = NMT * 33 - 16 * 256;
          if (_r == 1 && F.bx >= NLAST) p0_deferred(F, F.bx - NLAST, 256 - NLAST); } }
        SEAM(1);
    }
    if (IN(2)) {
        REPS(2) {
        scan_head_v2(F, F.bx, _r == 0);
        if (F.bx < 128 && _r == 1) merge_queue(F, rstd0, true);
        if (F.bx >= 128 && _r == 1) {
            const int c = F.bx - 128;
            conv_pass(F, c, F.G - 128);
            sub_barrier((unsigned*)(F.ctl + CW_SUB), (unsigned)(F.G - 128), F.wave_s);
            if (c < 4) {
                unsigned* c4 = (unsigned*)(F.ctl + CW_SUB + 64);
                { SchedList3 S{ws, NMT - 1, c, 4, 0x2310}; Epi3 E{F.out, ws, rstd0}; pg::gemm_phase(F.lds, F.wave_s, D, S, E); }
                sub_barrier(c4, 4u, F.wave_s);
                { SchedOne S{(const char*)ws + WS_R, (const char*)ws + WS_WOUT, NMT - 1, c, D}; Epi4 E{ws, F.in[IN_X_P], F.in[IN_X_S]}; pg::gemm_phase(F.lds, F.wave_s, D, S, E); }
                sub_barrier(c4, 8u, F.wave_s);
                { SchedOne S{(const char*)ws + WS_K, (const char*)ws + WS_WGATE, NMT - 1, c, D}; Epi5a E{ws}; pg::gemm_phase(F.lds, F.wave_s, D, S, E); }
                asm volatile("s_waitcnt vmcnt(0)" ::: "memory"); __syncthreads();
                { SchedOne S{(const char*)ws + WS_PH, (const char*)ws + WS_WPLE, NMT - 1, c, PLE}; Epi5b E{F.out, ws, F.in[IN_GFINAL], F.ctl, F.lds + RING_BYTES}; pg::gemm_phase(F.lds, F.wave_s, PLE, S, E); }
            }
            { SchedH S; S.o.init(NMT - 1, 4, 1, 0); S.ws = ws; S.c = c;
              Epi3 E{F.out, ws, rstd0};
              pg::gemm_phase(F.lds, F.wave_s, D, S, E); }
            sub_barrier((unsigned*)(F.ctl + CW_SUB), 2u * (unsigned)(F.G - 128), F.wave_s);
            merge_queue(F, rstd0, false);
        } }
        SEAM(2);
    }
    if (IN(4)) {
        REPS(4) {
        Sched4 S; S.o.init(NMT - 1, 4, F.G, F.bx); S.A = (const char*)ws + WS_R; S.B = (const char*)ws + WS_WOUT;
        Epi4 E{ws, F.in[IN_X_P], F.in[IN_X_S]};
        pg::gemm_phase(F.lds, F.wave_s, D, S, E); }
        SEAM(4);
    }
    if (IN(5)) {
        REPS(5) { Sched4 S; S.o.init(NMT - 1, 4, F.G, F.bx); S.A = (const char*)ws + WS_K; S.B = (const char*)ws + WS_WGATE;
          Epi5a E{ws}; pg::gemm_phase(F.lds, F.wave_s, D, S, E); }
        asm volatile("s_waitcnt vmcnt(0)" ::: "memory"); __syncthreads();
        { Sched5b S; S.o.init(NMT - 1, 4, F.G, F.bx); S.A = (const char*)ws + WS_PH; S.B = (const char*)ws + WS_WPLE;
          Epi5b E{F.out, ws, F.in[IN_GFINAL], F.ctl, F.lds + RING_BYTES}; pg::gemm_phase(F.lds, F.wave_s, PLE, S, E); }
    }
#undef REPS
#undef IN
#undef SEAM
}

extern "C" void kernel_launch(void* const* d_in, const int* in_sizes, int n_in, void* d_out, int out_size, void* d_ws, size_t ws_size, hipStream_t stream) {
    static int grid = 0;
    if (grid == 0) {
        if (n_in != 27 || ws_size < WS_END) { fprintf(stderr, "kernel_launch: unexpected shapes (n_in %d, ws %zu)\n", n_in, ws_size); grid = -1; return; }
        int dev = 0, cus = 0;
        if (hipGetDevice(&dev) != hipSuccess || hipDeviceGetAttribute(&cus, hipDeviceAttributeMultiprocessorCount, dev) != hipSuccess) { grid = -1; return; }
        if (hipFuncSetAttribute((const void*)mk_fwd, hipFuncAttributeMaxDynamicSharedMemorySize, LDS_BYTES) != hipSuccess) { fprintf(stderr, "kernel_launch: hipFuncSetAttribute failed\n"); grid = -1; return; }
        int per_cu = 0;
        if (hipOccupancyMaxActiveBlocksPerMultiprocessor(&per_cu, (const void*)mk_fwd, NWAVES * 64, LDS_BYTES) != hipSuccess || per_cu < 1) { fprintf(stderr, "kernel_launch: occupancy query says %d\n", per_cu); }
        (void)hipGetLastError();
        if (cus < 256) { fprintf(stderr, "kernel_launch: needs 256 CUs, got %d\n", cus); grid = -1; return; }
        grid = 256;
    }
    if (grid < 0) return;
    (void)hipMemsetAsync((char*)d_ws + WS_CTL, 0, CTL_ZERO_BYTES, stream);
    Args a{};
    for (int i = 0; i < 27; ++i) a.in[i] = (const float*)d_in[i];
    a.out = (float*)d_out; a.ws = (unsigned char*)d_ws;
    if (MK_N_LAUNCHES == 1) { a.ph_lo = 0; a.ph_hi = N_PHASES; a.li = PROBE_PHASE; hipLaunchKernelGGL(mk_fwd, dim3(grid), dim3(NWAVES * 64), LDS_BYTES, stream, a); }
    else for (int li = 0; li < N_PHASES; ++li) { a.ph_lo = li; a.ph_hi = li + 1; a.li = PROBE_PHASE; hipLaunchKernelGGL(mk_fwd, dim3(grid), dim3(NWAVES * 64), LDS_BYTES, stream, a); }
}
```

```cpp
#include <hip/hip_runtime.h>
#include <cstdio>
#include <cstdint>

#ifndef MK_N_LAUNCHES
#define MK_N_LAUNCHES 1
#endif

#ifndef PROBE_PHASE
#define PROBE_PHASE -1
#endif
#define LAS __attribute__((address_space(3)))
#define GAS __attribute__((address_space(1)))
typedef _Float16 h16;
typedef _Float16 h16x8 __attribute__((ext_vector_type(8)));
typedef _Float16 h16x4 __attribute__((ext_vector_type(4)));
typedef float f32x4 __attribute__((ext_vector_type(4)));
typedef float f32x2 __attribute__((ext_vector_type(2)));
typedef unsigned u32x4 __attribute__((ext_vector_type(4)));
typedef GAS unsigned gu32;

constexpr int D = 1024, NP = 32768, NS = 128, MREAL = NP + NS, MP = 33024, NMT = MP / 256;
constexpr int SEQ = 4096, DSEQ = 16, NH = 16, HD = 64, PLE = 256;
constexpr int SHIFT_COLS = 4224, IN_COLS = 10368;
constexpr int W1_ROWS = 8448 + 2048;
constexpr float EPS = 1e-6f, GN_EPS = 64e-5f, DECAY_SCALE = 0.60653065971f;
constexpr size_t OFF_Y = 0, OFF_WKV_P = (size_t)MREAL * D, OFF_SHIFT_P = OFF_WKV_P + 8 * 16 * 64 * 64, OFF_CONV_P = OFF_SHIFT_P + 8 * SHIFT_COLS,
                 OFF_WKV_S = OFF_CONV_P + 8 * 2 * D, OFF_SHIFT_S = OFF_WKV_S + 8 * 16 * 64 * 64, OFF_CONV_S = OFF_SHIFT_S + 8 * SHIFT_COLS;
constexpr size_t MiB = 1u << 20;
constexpr size_t WS_CTL = 0, CTL_ZERO_BYTES = 131072;
static_assert((16384 + 128 * 64) * 4 <= 131072, "control words inside the per-call memset");
constexpr size_t WS_W1T = 1 * MiB, WS_WOA = 22 * MiB, WS_WOB = 24 * MiB, WS_WOUT = 26 * MiB, WS_WGATE = 28 * MiB, WS_WPLE = 30 * MiB;
constexpr size_t WS_W2T = 30 * MiB + 512 * 1024, WS_I2T = WS_W2T + 128 * 1024;
constexpr size_t WS_RSTD0 = 31 * MiB, WS_SIDE = 32 * MiB, WS_SSQ1 = 34 * MiB, WS_XCH = 37 * MiB;
constexpr size_t WS_XH = 40 * MiB, WS_PH = 105 * MiB, WS_R = 122 * MiB, WS_K = 187 * MiB, WS_V = 252 * MiB, WS_Z = 317 * MiB, WS_WA = 382 * MiB, WS_ACTB = 391 * MiB, WS_SIDEU = 456 * MiB, WS_SIDEP = 457 * MiB, WS_SIDEG = 458 * MiB, WS_END = 459 * MiB;
constexpr size_t SIDE_STRIDE = 256 * 1024;
constexpr int CW_BAR = 1024, CW_SUB = 512, CW_PANEL = 5120, CW_RDY = 16384, CW_MQ = 640, CW_P4Q = 768, CW_MRG = 24576;

constexpr int NWAVES = 8;
constexpr int RING_BYTES = 131072, SCAN_LDS_BYTES = 163072, LDSCTL_OFF = SCAN_LDS_BYTES, MISC_OFF = LDSCTL_OFF + 320, LDS_BYTES = 163840;

__device__ __forceinline__ int fresh_tid_w(int wave_s) { int lane; asm volatile("v_mbcnt_lo_u32_b32 %0, -1, 0\n\tv_mbcnt_hi_u32_b32 %0, -1, %0" : "=v"(lane)); return (wave_s << 6) | lane; }
__device__ __forceinline__ float fsigmoid(float x) { return __builtin_amdgcn_rcpf(1.0f + __expf(-x)); }
__device__ __forceinline__ float fsilu(float x) { return x * fsigmoid(x); }
__device__ __forceinline__ float ftanh(float x) { return 1.0f - 2.0f * __builtin_amdgcn_rcpf(__expf(2.0f * x) + 1.0f); }
__device__ __forceinline__ h16x4 cvt4(f32x4 v) { return __builtin_convertvector(v, h16x4); }
__device__ __forceinline__ h16x8 cvt8(f32x4 a, f32x4 b) { h16x4 x = cvt4(a), y = cvt4(b); return __builtin_shufflevector(x, y, 0, 1, 2, 3, 4, 5, 6, 7); }
__device__ __forceinline__ f32x4 up4(h16x4 v) { return __builtin_convertvector(v, f32x4); }

namespace pg {
constexpr int BM = 256, BK = 64, HALF = 128, HTB = HALF * BK * 2, NXCD = 8, WGM = 8;
__host__ __device__ __forceinline__ int lds_byte(int r, int c) { const int st = (r >> 4) * 2 + (c >> 5), rr = r & 15, cc = c & 31, ob = rr * 64 + cc * 2; return st * 1024 + (ob ^ (((ob >> 9) & 1) << 5)); }
__host__ __device__ __forceinline__ void stage_rc(int b, int& R, int& C) { const int st = b / 1024, sb = b % 1024, swz = sb ^ (((sb >> 9) & 1) << 5); R = (st >> 1) * 16 + swz / 64; C = (st & 1) * 32 + (swz % 64) / 2; }
__host__ __device__ __forceinline__ int perm32(int rho) { const int n = rho >> 4, i = rho & 15; return 8 * (i >> 2) + 4 * n + (i & 3); }

struct Unit { int pm, pn, kind; const char* A; const char* B; };

struct TileOrder {
    int nM, nN, nwg, G, c;
    __device__ void init(int nM_, int nN_, int G_, int c_) { nM = nM_; nN = nN_; nwg = nM * nN; G = G_; c = c_; }
    __device__ bool get(int i, int& pm, int& pn) const { return get_linear((long)i * G + c, pm, pn); }
    __device__ bool get_linear(long L, int& pm, int& pn) const {
        if (L >= nwg) return false;
        int wgid = (int)L; { const int q = nwg / NXCD, r = nwg % NXCD, xcd = wgid % NXCD, off = wgid / NXCD; wgid = (xcd < r ? xcd * (q + 1) : r * (q + 1) + (xcd - r) * q) + off; }
        const int nig = WGM * nN, gid = wgid / nig, fm = gid * WGM, gsz = (nM - fm) < WGM ? (nM - fm) : WGM;
        pm = fm + ((wgid % nig) % gsz); pn = (wgid % nig) / gsz; return true;
    }
};

template <class Sched, class Epi, bool APERM = false>
__device__ __forceinline__ void gemm_phase(LAS unsigned char* lds, const int wave_s, const int K, const Sched& S, const Epi& E) {
    const int tid = fresh_tid_w(wave_s), wid = wave_s, lane = tid & 63, wr = wid >> 2, wc = wid & 3, fr = lane & 15, fq = lane >> 4;
    const int nt = K / BK;
    unsigned voffA[2], voffB[2];
#pragma unroll
    for (int i = 0; i < 2; ++i) { int R, C; stage_rc(tid * 16 + i * 8192, R, C); const int Rb = (R & ~31) + perm32(R & 31);
        const int Ra = APERM ? (R & ~63) + 4 * (R & 15) + ((R & 63) >> 4) : R;
        voffA[i] = (unsigned)(Ra * K + C) * 2u; voffB[i] = (unsigned)(Rb * K + C) * 2u; }
    const size_t kstep = (size_t)(BK * 2);
    const size_t hstep = (size_t)HALF * K * 2;
    const unsigned ldsw = (unsigned)wid * 1024u;
    const int aoff = lds_byte(wr * 64 + fr, fq * 8), boff = lds_byte(wc * 32 + fr, fq * 8);
#define PG_SA(b, h) (((b) * 2 + (h)) * HTB)
#define PG_SB(b, h) ((4 + (b) * 2 + (h)) * HTB)
#define PG_STAGE(bufoff, gbase, voff) do { _Pragma("unroll") for (int _i = 0; _i < 2; ++_i) \
        __builtin_amdgcn_global_load_lds((const unsigned*)((const char*)(gbase) + (voff)[_i]), (LAS unsigned*)(lds + (bufoff) + ldsw + _i * 8192), 16, 0, 0); } while (0)
#define PG_LDA(dst, b, h) do { _Pragma("unroll") for (int m = 0; m < 4; ++m) _Pragma("unroll") for (int k = 0; k < 2; ++k) dst[m][k] = *(const LAS h16x8*)(lds + PG_SA(b, h) + aoff + m * 2048 + k * 1024); } while (0)
#define PG_LDB(dst, b, h) do { _Pragma("unroll") for (int n = 0; n < 2; ++n) _Pragma("unroll") for (int k = 0; k < 2; ++k) dst[n][k] = *(const LAS h16x8*)(lds + PG_SB(b, h) + boff + n * 2048 + k * 1024); } while (0)
#define PG_MMA(ai, bj, At, Bt) do { __builtin_amdgcn_s_setprio(1); _Pragma("unroll") for (int m = 0; m < 4; ++m) _Pragma("unroll") for (int n = 0; n < 2; ++n) _Pragma("unroll") for (int k = 0; k < 2; ++k) \
        acc[ai][bj][m][n] = __builtin_amdgcn_mfma_f32_16x16x32_f16(Bt[n][k], At[m][k], acc[ai][bj][m][n], 0, 0, 0); __builtin_amdgcn_s_setprio(0); } while (0)
#define PG_WAIT_V(n) asm volatile("s_waitcnt vmcnt(" #n ")" ::: "memory")
#define PG_WAIT_L(n) asm volatile("s_waitcnt lgkmcnt(" #n ")" ::: "memory")
#define PG_BAR __builtin_amdgcn_s_barrier()
#define PG_SCHED __builtin_amdgcn_sched_barrier(0)
    Unit cur, nxt; int ui = 0;
    if (!S.next(0, cur)) return;
    f32x4 acc[2][2][4][2];
#pragma unroll
    for (int a = 0; a < 2; ++a)
#pragma unroll
        for (int b = 0; b < 2; ++b)
#pragma unroll
            for (int m = 0; m < 4; ++m)
#pragma unroll
                for (int n = 0; n < 2; ++n) acc[a][b][m][n] = (f32x4){0.f, 0.f, 0.f, 0.f};
    h16x8 At[4][2], B0[2][2], B1[2][2];
    const char* cA = cur.A; const char* cB = cur.B;
    PG_STAGE(PG_SB(0, 0), cB, voffB); PG_STAGE(PG_SB(0, 1), cB + hstep, voffB); PG_STAGE(PG_SA(0, 0), cA, voffA); PG_STAGE(PG_SA(0, 1), cA + hstep, voffA);
    PG_STAGE(PG_SB(1, 0), cB + kstep, voffB); PG_STAGE(PG_SA(1, 0), cA + kstep, voffA); PG_STAGE(PG_SB(1, 1), cB + hstep + kstep, voffB);
    if (wr == 1) PG_BAR;
    PG_WAIT_V(8); PG_BAR;
    PG_WAIT_V(6); PG_BAR;
    for (;;) {
        const bool has_next = S.next(ui + 1, nxt);
        const char* nA = has_next ? nxt.A : cA; const char* nB = has_next ? nxt.B : cB;
        for (int t = 0; t < nt; t += 2) {
            const bool last = (t == nt - 2);
            const char* a1 = cA + (size_t)(t + 1) * kstep;
            const char* a2 = last ? nA : cA + (size_t)(t + 2) * kstep; const char* b2 = last ? nB : cB + (size_t)(t + 2) * kstep;
            const char* a3 = a2 + kstep; const char* b3 = b2 + kstep;
            PG_LDB(B0, 0, 0); PG_LDB(B1, 0, 1); PG_SCHED; PG_LDA(At, 0, 0); PG_STAGE(PG_SA(1, 1), a1 + hstep, voffA);
            PG_WAIT_V(8); PG_WAIT_L(0); PG_BAR; PG_MMA(0, 0, At, B0); PG_MMA(0, 1, At, B1); PG_BAR; PG_SCHED;
            PG_LDA(At, 0, 1); PG_STAGE(PG_SB(0, 0), b2, voffB); PG_STAGE(PG_SB(0, 1), b2 + hstep, voffB); PG_STAGE(PG_SA(0, 0), a2, voffA);
            PG_WAIT_V(8); PG_WAIT_L(0); PG_BAR; PG_MMA(1, 0, At, B0); PG_MMA(1, 1, At, B1); PG_BAR; PG_SCHED;
            PG_LDB(B0, 1, 0); PG_LDB(B1, 1, 1); PG_SCHED; PG_LDA(At, 1, 0); PG_STAGE(PG_SA(0, 1), a2 + hstep, voffA);
            PG_WAIT_V(8); PG_WAIT_L(0); PG_BAR; PG_MMA(0, 0, At, B0); PG_MMA(0, 1, At, B1); PG_BAR; PG_SCHED;
            PG_LDA(At, 1, 1); PG_STAGE(PG_SB(1, 0), b3, voffB); PG_STAGE(PG_SB(1, 1), b3 + hstep, voffB); PG_STAGE(PG_SA(1, 0), a3, voffA);
            PG_WAIT_V(8); PG_WAIT_L(0); PG_BAR; PG_MMA(1, 0, At, B0); PG_MMA(1, 1, At, B1); PG_BAR; PG_SCHED;
        }
        if (wr == 0) PG_BAR;
        E(acc, cur, wr, wc, fr, fq);
        if (!has_next) break;
#pragma unroll
        for (int a = 0; a < 2; ++a)
#pragma unroll
            for (int b = 0; b < 2; ++b)
#pragma unroll
                for (int m = 0; m < 4; ++m)
#pragma unroll
                    for (int n = 0; n < 2; ++n) acc[a][b][m][n] = (f32x4){0.f, 0.f, 0.f, 0.f};
        cur = nxt; cA = nA; cB = nB; ++ui;
        if (wr == 1) PG_BAR;
    }
    PG_WAIT_V(0);
    PG_BAR;
#undef PG_SA
#undef PG_SB
#undef PG_STAGE
#undef PG_LDA
#undef PG_LDB
#undef PG_MMA
#undef PG_WAIT_V
#undef PG_WAIT_L
#undef PG_BAR
#undef PG_SCHED
}
}

#define XB_TMO      128
#define XB_XCNT(j)  (256  + 64 * (j))
#define XB_XSUB(j)  (1280 + 64 * (j))
#define XB_XGEN(j)  (2304 + 64 * (j))
#define XB_TOP      3328
#define XB_TOPGEN   3392
#define XCD_BAR_WORDS 3456
#define XB_SPIN_CAP (1u << 22)
__device__ __forceinline__ unsigned xb_ld(unsigned* p)              { return __hip_atomic_load(p, __ATOMIC_RELAXED, __HIP_MEMORY_SCOPE_AGENT); }
__device__ __forceinline__ unsigned xb_add(unsigned* p, unsigned v) { return __hip_atomic_fetch_add(p, v, __ATOMIC_RELAXED, __HIP_MEMORY_SCOPE_AGENT); }
__device__ __forceinline__ unsigned xb_xcc_id() { return (unsigned)__builtin_amdgcn_s_getreg((3 << 11) | 20) & 0xFu; }
#define XB_SPIN(cond, bar) do { unsigned _sp = 0; while (cond) { __builtin_amdgcn_s_sleep(1); \
    if ((++_sp & 255u) == 0u) { if (xb_ld(&(bar)[XB_TMO])) break; if (_sp > XB_SPIN_CAP) { atomicAdd(&(bar)[XB_TMO], 1u); break; } } } } while (0)
struct XcdBarrier { unsigned* bar; unsigned x; volatile LAS unsigned* st; };
__device__ __forceinline__ XcdBarrier xcd_barrier_post(unsigned* bar, volatile LAS unsigned* st, int wave_s) {
    XcdBarrier b; b.bar = bar; b.x = xb_xcc_id(); b.st = st;
    if (fresh_tid_w(wave_s) == 0) (void)xb_add(&bar[XB_XCNT(b.x)], 1u);
    return b;
}
__device__ __forceinline__ void xcd_barrier_complete(unsigned* bar, unsigned x, unsigned& nloc, unsigned& nx) {
    const unsigned G = gridDim.x * gridDim.y * gridDim.z;
    unsigned sum, cnt, mine, sp = 0u;
    for (;;) {
        sum = 0u; cnt = 0u; mine = 0u;
#pragma unroll
        for (unsigned j = 0; j < 16; ++j) { const unsigned c = xb_ld(&bar[XB_XCNT(j)]); sum += c; cnt += (c > 0u) ? 1u : 0u; mine = (j == x) ? c : mine; }
        if (sum == G) break;
        __builtin_amdgcn_s_sleep(1);
        if ((++sp & 255u) == 0u) { if (xb_ld(&bar[XB_TMO])) break; if (sp > XB_SPIN_CAP) { atomicAdd(&bar[XB_TMO], 1u); break; } }
    }
    nloc = mine > 0u ? mine : 1u; nx = cnt > 0u ? cnt : 1u;
}
__device__ __forceinline__ void xcd_barrier(const XcdBarrier& b, int wave_s) {
    asm volatile("s_waitcnt vmcnt(0)" ::: "memory");
    __syncthreads();
    if (fresh_tid_w(wave_s) == 0) {
        unsigned* bar = b.bar;
        __builtin_amdgcn_s_waitcnt(0);
        unsigned nloc = b.st[0], nx = b.st[1];
        if (nloc == 0u) { xcd_barrier_complete(bar, b.x, nloc, nx); b.st[0] = nloc; b.st[1] = nx; }
        const unsigned old = xb_add(&bar[XB_XSUB(b.x)], 1u);
        const unsigned gen = old / nloc;
        if (old + 1u == (gen + 1u) * nloc) {
            __builtin_amdgcn_fence(__ATOMIC_RELEASE, "agent");
            asm volatile("s_waitcnt vmcnt(0)" ::: "memory");
            const unsigned og = xb_add(&bar[XB_TOP], 1u);
            const unsigned tg = og / nx;
            if (og + 1u == (tg + 1u) * nx) xb_add(&bar[XB_TOPGEN], 1u);
            else XB_SPIN(xb_ld(&bar[XB_TOPGEN]) == tg, bar);
            __builtin_amdgcn_fence(__ATOMIC_ACQUIRE, "agent");
            xb_add(&bar[XB_XGEN(b.x)], 1u);
            asm volatile("s_waitcnt vmcnt(0)" ::: "memory");
        } else {
            XB_SPIN(xb_ld(&bar[XB_XGEN(b.x)]) == gen, bar);
            __builtin_amdgcn_fence(__ATOMIC_ACQUIRE, "agent");
            asm volatile("s_waitcnt vmcnt(0)" ::: "memory");
        }
    }
    __syncthreads();
}

struct Args { const float* in[27]; float* out; unsigned char* ws; int ph_lo, ph_hi, li, pad; };
struct Frame {
    LAS unsigned char* lds; volatile LAS unsigned* MISC; gu32* ctl;
    int G, bx, wave_s;
    const float* const* in; float* out; unsigned char* ws;
};
#define IN_X_P 0
#define IN_X_S 1
#define IN_ST_WKV 2
#define IN_ST_SHIFT 3
#define IN_ST_CONV 4
#define IN_P_P 5
#define IN_P_S 6
#define IN_G_NORM 7
#define IN_W_IN 8
#define IN_MU 9
#define IN_WDEC0 10
#define IN_WDEC2 11
#define IN_WICL0 12
#define IN_WICL2 13
#define IN_KREM 14
#define IN_KREP 15
#define IN_RBONUS 16
#define IN_GNW 17
#define IN_GNB 18
#define IN_CONVW 19
#define IN_WOA 20
#define IN_WOB 21
#define IN_WOUT 22
#define IN_GPLE 23
#define IN_WPLEG 24
#define IN_WPLE 25
#define IN_GFINAL 26

__device__ __forceinline__ float wave_sum(float v) {
#pragma unroll
    for (int o = 1; o < 64; o <<= 1) v += __shfl_xor(v, o);
    return v;
}
__device__ __forceinline__ h16* rowptr16(float* out, unsigned char* ws, int slot, int row) {
    return row < NP ? (h16*)out + (size_t)slot * NP * D + (size_t)row * D : (h16*)(ws + WS_SIDE) + (size_t)slot * SIDE_STRIDE + (size_t)(row - NP) * D;
}

__device__ __forceinline__ int w1_src_col(int n) {
    const int tile = n >> 8, c = n & 255;
    if (tile < 16) { const int plane = tile >> 2; return (plane == 3 ? 3200 : plane * 1024) + (tile & 3) * 256 + c; }
    if (tile == 16) return c < 128 ? 3072 + c : -1;
    if (tile < 33) { const int tb = tile - 17, kind = 2 * (c >> 7) + ((c >> 2) & 1), ch = 64 * tb + 16 * ((c >> 5) & 3) + 4 * ((c >> 3) & 3) + (c & 3); return SHIFT_COLS + kind * 1024 + ch; }
    return SHIFT_COLS + 4096 + (n - 8448);
}
template <bool MAP>
__device__ __forceinline__ void p0_transpose_item(const float* W, int Nsrc, int K, h16* WT, const float* kscale, LAS float* scr, int kb, int nb, int lane) {
    const int k0 = 64 * kb, n0 = 32 * nb, n4 = (lane & 7) * 4;
    const int src = MAP ? w1_src_col(n0 + n4) : n0 + n4;
    f32x4 v[8];
#pragma unroll
    for (int i = 0; i < 8; ++i) { const int kk = 8 * i + (lane >> 3); v[i] = (f32x4){0.f, 0.f, 0.f, 0.f}; if (src >= 0) { v[i] = *(const f32x4*)(W + (size_t)(k0 + kk) * Nsrc + src); if (kscale) v[i] = v[i] * kscale[k0 + kk]; } }
#pragma unroll
    for (int i = 0; i < 8; ++i) { const int kk = 8 * i + (lane >> 3); LAS float* d = scr + kk * 33 + n4; d[0] = v[i].x; d[1] = v[i].y; d[2] = v[i].z; d[3] = v[i].w; }
    asm volatile("s_waitcnt lgkmcnt(0)" ::: "memory");
    const int c = lane & 7;
#pragma unroll
    for (int j = 0; j < 4; ++j) { const int nn = (lane >> 3) + 8 * j; const LAS float* s = scr + (8 * c) * 33 + nn;
        h16x8 o;
#pragma unroll
        for (int e = 0; e < 8; ++e) o[e] = (h16)s[e * 33];
        *(h16x8*)(WT + (size_t)(n0 + nn) * K + k0 + 8 * c) = o; }
    asm volatile("s_waitcnt lgkmcnt(0)" ::: "memory");
}
__device__ __forceinline__ void p0_prologue(Frame& F) {
    const int tid_ = fresh_tid_w(F.wave_s), lane_ = tid_ & 63, wave_ = F.wave_s;
    LAS float* scr = (LAS float*)(F.lds + wave_ * 16384);
    const int gw = F.bx * NWAVES + wave_, NGW = F.G * NWAVES;
    unsigned char* ws = F.ws;
    constexpr int I_W1 = (D / 64) * (W1_ROWS / 32), I_SQ = (D / 64) * (D / 32), I_PLE = (PLE / 64) * (D / 32);
    constexpr int NITEMS = I_W1 + 4 * I_SQ + I_PLE;
    for (int it = gw; it < I_W1; it += NGW)
        p0_transpose_item<true>(F.in[IN_W_IN], IN_COLS, D, (h16*)(ws + WS_W1T), F.in[IN_G_NORM], scr, it / (W1_ROWS / 32), it % (W1_ROWS / 32), lane_);
    (void)NITEMS;
    for (int i = F.bx * 512 + tid_; i < 65536; i += F.G * 512) { const int n = i >> 6, j = i & 63;
        ((h16*)(ws + WS_W2T))[i] = (h16)(-1.4426950408889634f * F.in[IN_WDEC2][(size_t)j * D + n]); ((h16*)(ws + WS_I2T))[i] = (h16)(-1.4426950408889634f * F.in[IN_WICL2][(size_t)j * D + n]); }
    h16* XH = (h16*)(ws + WS_XH); float* rstd0 = (float*)(ws + WS_RSTD0);
    for (int m0 = 4 * gw; m0 < MP; m0 += 4 * NGW) {
        f32x4 v[4][4]; float s[4];
#pragma unroll
        for (int r = 0; r < 4; ++r) { const int m = m0 + r;
            if (m < MREAL) {
                const float* xrow = m < NP ? F.in[IN_X_P] + (size_t)m * D : F.in[IN_X_S] + (size_t)(m - NP) * D;
#pragma unroll
                for (int j = 0; j < 4; ++j) v[r][j] = __builtin_nontemporal_load((const f32x4*)xrow + lane_ + 64 * j);
            } else {
#pragma unroll
                for (int j = 0; j < 4; ++j) v[r][j] = (f32x4){0.f, 0.f, 0.f, 0.f};
            } }
#pragma unroll
        for (int r = 0; r < 4; ++r) { float t = 0.f;
#pragma unroll
            for (int j = 0; j < 4; ++j) t += (v[r][j].x * v[r][j].x + v[r][j].y * v[r][j].y) + (v[r][j].z * v[r][j].z + v[r][j].w * v[r][j].w);
            s[r] = wave_sum(t); }
#pragma unroll
        for (int r = 0; r < 4; ++r) { const int m = m0 + r;
            const float ms = s[r] * (1.0f / D) + EPS, rstd = __builtin_amdgcn_rsqf(ms);
            if (lane_ == 0) rstd0[m] = m < MREAL ? ms * rstd : 0.f;
            h16x4* o = (h16x4*)(XH + (size_t)m * D) + lane_;
#pragma unroll
            for (int j = 0; j < 4; ++j) o[64 * j] = cvt4(v[r][j] * rstd); }
    }
}
__device__ __forceinline__ void p0_deferred(Frame& F, int c, int nw) {
    const int tid_ = fresh_tid_w(F.wave_s), lane_ = tid_ & 63, wave_ = F.wave_s;
    LAS float* scr = (LAS float*)(F.lds + wave_ * 16384);
    const int gw = c * NWAVES + wave_, NGW = nw * NWAVES;
    unsigned char* ws = F.ws;
    constexpr int I_SQ = (D / 64) * (D / 32), I_PLE = (PLE / 64) * (D / 32);
    for (int it = gw; it < 4 * I_SQ + I_PLE; it += NGW) {
        int r = it;
        if (r < I_SQ) { p0_transpose_item<false>(F.in[IN_WOA], D, D, (h16*)(ws + WS_WOA), nullptr, scr, r / 32, r % 32, lane_); continue; } r -= I_SQ;
        if (r < I_SQ) { p0_transpose_item<false>(F.in[IN_WOB], D, D, (h16*)(ws + WS_WOB), nullptr, scr, r / 32, r % 32, lane_); continue; } r -= I_SQ;
        if (r < I_SQ) { p0_transpose_item<false>(F.in[IN_WOUT], D, D, (h16*)(ws + WS_WOUT), nullptr, scr, r / 32, r % 32, lane_); continue; } r -= I_SQ;
        if (r < I_SQ) { p0_transpose_item<false>(F.in[IN_WPLEG], D, D, (h16*)(ws + WS_WGATE), F.in[IN_GPLE], scr, r / 32, r % 32, lane_); continue; } r -= I_SQ;
        p0_transpose_item<false>(F.in[IN_WPLE], D, PLE, (h16*)(ws + WS_WPLE), nullptr, scr, r / 32, r % 32, lane_);
    }
    h16* PH = (h16*)(ws + WS_PH);
    for (int m0 = 8 * gw; m0 < MP; m0 += 8 * NGW) {
        f32x4 pv[8];
#pragma unroll
        for (int r = 0; r < 8; ++r) { const int m = m0 + r; pv[r] = (f32x4){0.f, 0.f, 0.f, 0.f};
            if (m < MREAL) pv[r] = __builtin_nontemporal_load((const f32x4*)(m < NP ? F.in[IN_P_P] + (size_t)m * PLE : F.in[IN_P_S] + (size_t)(m - NP) * PLE) + lane_); }
#pragma unroll
        for (int r = 0; r < 8; ++r) ((h16x4*)(PH + (size_t)(m0 + r) * PLE))[lane_] = cvt4(pv[r]);
    }
    asm volatile("s_waitcnt vmcnt(0)" ::: "memory");
    __syncthreads();
}

__device__ __forceinline__ char* slotbase(float* out, unsigned char* ws, int slot, bool prompt_tile) {
    return prompt_tile ? (char*)out + (size_t)slot * NP * D * 2 : (char*)(ws + WS_SIDE) + (size_t)slot * SIDE_STRIDE * 2 - (size_t)NP * D * 2;
}
__device__ __forceinline__ float dpp_row_shr1(float x) { return __builtin_bit_cast(float, __builtin_amdgcn_update_dpp(0, __builtin_bit_cast(int, x), 0x111, 0xf, 0xf, true)); }
struct Epi1 {
    float* out; unsigned char* ws; const float* rstd0; const float* cw; LAS unsigned char* lx;
    __device__ __forceinline__ void conv_tile(const f32x4 (&acc)[2][2][4][2], const pg::Unit& u, int wr, int wc, int fr, int fq) const {
        const int ch = 64 * (u.pn - 17) + 16 * wc + 4 * fq;
        f32x4 uu[2][4], gz[2][4];
#pragma unroll
        for (int ai = 0; ai < 2; ++ai)
#pragma unroll
            for (int m = 0; m < 4; ++m) {
                const int row = u.pm * 256 + ai * 128 + wr * 64 + fr * 4 + m;
                const f32x4 gb = acc[ai][0][m][0], gc = acc[ai][0][m][1], xb = acc[ai][1][m][0], zb = acc[ai][1][m][1];
                uu[ai][m] = gc * xb;
#pragma unroll
                for (int j = 0; j < 4; ++j) gz[ai][m][j] = gb[j] * fsilu(zb[j]);
                const int t = row & (SEQ - 1);
                if (t >= SEQ - 2) *(f32x4*)(out + OFF_CONV_P + ((size_t)(row >> 12) * 2 + (t - (SEQ - 2))) * D + ch) = uu[ai][m];
            }
        LAS float* X = (LAS float*)lx;
        if (fr == 15) {
#pragma unroll
            for (int ai = 0; ai < 2; ++ai) { *(LAS f32x4*)(X + ((2 * ai + wr) * 2 + 0) * 64 + 16 * wc + 4 * fq) = uu[ai][2]; *(LAS f32x4*)(X + ((2 * ai + wr) * 2 + 1) * 64 + 16 * wc + 4 * fq) = uu[ai][3]; }
            if (wr == 1) { float* su = (float*)(ws + WS_SIDEU) + (size_t)u.pm * 2048 + ch; *(f32x4*)su = uu[1][2]; *(f32x4*)(su + 1024) = uu[1][3]; }
        }
        asm volatile("s_waitcnt lgkmcnt(0)" ::: "memory"); __builtin_amdgcn_s_barrier(); asm volatile("" ::: "memory");
        const f32x4 c0 = *(const f32x4*)(cw + ch), c1 = *(const f32x4*)(cw + D + ch), c2 = *(const f32x4*)(cw + 2 * D + ch);
        const bool first = (u.pm & 15) == 0;
#pragma unroll
        for (int ai = 0; ai < 2; ++ai) {
            f32x4 q1, q2;
#pragma unroll
            for (int j = 0; j < 4; ++j) { q1[j] = dpp_row_shr1(uu[ai][3][j]); q2[j] = dpp_row_shr1(uu[ai][2][j]); }
            const int blk = 2 * ai + wr;
            if (fr == 0) {
                if (blk > 0) { q2 = *(const LAS f32x4*)(X + ((blk - 1) * 2 + 0) * 64 + 16 * wc + 4 * fq); q1 = *(const LAS f32x4*)(X + ((blk - 1) * 2 + 1) * 64 + 16 * wc + 4 * fq); }
                else { q2 = (f32x4){0.f, 0.f, 0.f, 0.f}; q1 = q2; }
            }
#pragma unroll
            for (int m = 0; m < 4; ++m) {
                const int row = u.pm * 256 + ai * 128 + wr * 64 + fr * 4 + m;
                const f32x4 p1 = m >= 1 ? uu[ai][m - 1] : q1, p2 = m >= 2 ? uu[ai][m - 2] : (m == 1 ? q1 : q2);
                const f32x4 cv = c2 * uu[ai][m] + c1 * p1 + c0 * p2;
                if (blk == 0 && fr == 0 && m < 2 && !first) {
                    float* sp = (float*)(ws + WS_SIDEP) + (size_t)u.pm * 2048 + m * 1024 + ch; float* sg = (float*)(ws + WS_SIDEG) + (size_t)u.pm * 2048 + m * 1024 + ch;
                    *(f32x4*)sp = gz[ai][m] * cv; *(f32x4*)sg = gz[ai][m];
                } else *(h16x4*)((char*)ws + WS_ACTB + (unsigned)(row * D + ch) * 2u) = cvt4(gz[ai][m] * cv);
            }
        }
    }
    __device__ __forceinline__ void operator()(const f32x4 (&acc)[2][2][4][2], const pg::Unit& u, int wr, int wc, int fr, int fq) const {
        const int tile = u.pn; const bool ptile = u.pm < NMT - 1;
        if (tile >= 17 && ptile) { conv_tile(acc, u, wr, wc, fr, fq); return; }
        const int plane = tile >> 2;
        char* pbase = (char*)ws + (plane == 0 ? WS_R : plane == 1 ? WS_K : plane == 2 ? WS_V : WS_Z);
        char* ub = slotbase(out, ws, 0, ptile); char* gzb = slotbase(out, ws, 1, ptile);
#pragma unroll
        for (int ai = 0; ai < 2; ++ai)
#pragma unroll
            for (int m = 0; m < 4; ++m) {
                const int row = u.pm * 256 + ai * 128 + wr * 64 + fr * 4 + m;
                int endj = -1, bidx = 0; bool samp = false;
                if (row < NP) { const int t = row & (SEQ - 1); if (t >= SEQ - 2) { endj = t - (SEQ - 2); bidx = row >> 12; } }
                else if (row < MREAL) { const int rr = row - NP, t = rr & (DSEQ - 1); if (t >= DSEQ - 2) { endj = t - (DSEQ - 2); bidx = rr >> 4; samp = true; } }
                if (tile < 17) {
#pragma unroll
                    for (int bj = 0; bj < 2; ++bj) {
                        const int cl = bj * 128 + wc * 32 + 8 * fq;
                        const f32x4 v0 = acc[ai][bj][m][0], v1 = acc[ai][bj][m][1];
                        int scol;
                        if (tile < 16) { *(h16x8*)(pbase + (unsigned)(row * D + (tile & 3) * 256 + cl) * 2u) = cvt8(v0, v1); scol = (plane == 3 ? 3200 : plane * 1024) + (tile & 3) * 256 + cl; }
                        else { if (bj == 1) continue; *(h16x8*)((char*)ws + WS_WA + (unsigned)(row * 128 + cl) * 2u) = cvt8(v0, v1); scol = 3072 + cl; }
                        if (endj == 1) { float* o = out + (samp ? OFF_SHIFT_S : OFF_SHIFT_P) + (size_t)bidx * SHIFT_COLS + scol; *(f32x4*)o = v0; *(f32x4*)(o + 4) = v1; }
                    }
                } else {
                    const int ch = 64 * (tile - 17) + 16 * wc + 4 * fq;
                    const f32x4 gb = acc[ai][0][m][0], gc = acc[ai][0][m][1], xb = acc[ai][1][m][0], zb = acc[ai][1][m][1];
                    f32x4 uu = gc * xb, gz;
#pragma unroll
                    for (int j = 0; j < 4; ++j) gz[j] = gb[j] * fsilu(zb[j]);
                    const unsigned o = (unsigned)(row * D + ch) * 2u;
                    *(h16x4*)(ub + o) = cvt4(uu);
                    *(h16x4*)(gzb + o) = cvt4(gz);
                    if (endj >= 0) *(f32x4*)(out + (samp ? OFF_CONV_S : OFF_CONV_P) + ((size_t)bidx * 2 + endj) * D + ch) = uu;
                }
            }
    }
};
struct Sched1 {
    pg::TileOrder o; const char* A; const char* B;
    __device__ bool next(int i, pg::Unit& u) const { int pm, pn; if (!o.get(i, pm, pn)) return false; u.pm = pm; u.pn = pn; u.kind = 0;
        u.A = A + (size_t)pm * 256 * D * 2; u.B = B + (size_t)pn * 256 * D * 2; return true; }
};

struct Epi3 {
    float* out; unsigned char* ws; const float* rstd0;
    __device__ __forceinline__ void operator()(const f32x4 (&acc)[2][2][4][2], const pg::Unit& u, int wr, int wc, int fr, int fq) const {
        const bool ptile = u.pm < NMT - 1;
        char* ga = slotbase(out, ws, 0, ptile); char* gb = slotbase(out, ws, 1, ptile); char* mb = (char*)ws + WS_R;
#pragma unroll
        for (int ai = 0; ai < 2; ++ai)
#pragma unroll
            for (int m = 0; m < 4; ++m) {
                const int row = u.pm * 256 + ai * 128 + wr * 64 + m * 16 + fr;
#pragma unroll
                for (int bj = 0; bj < 2; ++bj) {
                    const unsigned o = (unsigned)(row * D + u.pn * 256 + bj * 128 + wc * 32 + 8 * fq) * 2u;
                    const f32x4 a0 = acc[ai][bj][m][0], a1 = acc[ai][bj][m][1];
                    if (u.kind < 2) {
                        const float rs = -1.4426950408889634f; f32x4 g0, g1;
#pragma unroll
                        for (int j = 0; j < 4; ++j) { g0[j] = __builtin_amdgcn_rcpf(1.0f + __builtin_amdgcn_exp2f(a0[j] * rs)); g1[j] = __builtin_amdgcn_rcpf(1.0f + __builtin_amdgcn_exp2f(a1[j] * rs)); }
                        *(h16x8*)((u.kind == 0 ? ga : gb) + o) = cvt8(g0, g1);
                    } else if (u.kind == 3) {
                        const h16x8 g = *(const h16x8*)(gb + o);
                        const f32x4 g0 = up4(__builtin_shufflevector(g, g, 0, 1, 2, 3)), g1 = up4(__builtin_shufflevector(g, g, 4, 5, 6, 7));
                        *(h16x8*)(gb + o) = cvt8(g0 * a0, g1 * a1);
                    } else {
                        const h16x8 g = *(const h16x8*)(ga + o), t = *(const h16x8*)(gb + o);
                        const f32x4 t0 = up4(__builtin_shufflevector(t, t, 0, 1, 2, 3)), t1 = up4(__builtin_shufflevector(t, t, 4, 5, 6, 7));
                        const f32x4 g0 = up4(__builtin_shufflevector(g, g, 0, 1, 2, 3)), g1 = up4(__builtin_shufflevector(g, g, 4, 5, 6, 7));
                        *(h16x8*)(mb + o) = cvt8(t0 + g0 * a0, t1 + g1 * a1);
                    }
                }
            }
    }
};
struct Sched3 {
    pg::TileOrder o; unsigned char* ws; int nk; int kinds;
    __device__ bool next(int i, pg::Unit& u) const { int pm, pn; const int q = i / nk, kind = (kinds >> (4 * (i - q * nk))) & 15; if (!o.get(q, pm, pn)) return false; u.pm = pm; u.pn = pn; u.kind = kind;
        const size_t aoff = kind < 2 ? WS_XH : kind == 2 ? WS_Z : WS_ACTB;
        const size_t boff = kind == 0 ? WS_W1T + (size_t)8448 * D * 2 : kind == 1 ? WS_W1T + (size_t)(8448 + 1024) * D * 2 : kind == 2 ? WS_WOA : WS_WOB;
        u.A = (const char*)ws + aoff + (size_t)pm * 256 * D * 2; u.B = (const char*)ws + boff + (size_t)pn * 256 * D * 2; return true; }
};
__device__ __forceinline__ void unit3(pg::Unit& u, unsigned char* ws, int pm, int pn, int kind) {
    u.pm = pm; u.pn = pn; u.kind = kind;
    const size_t aoff = kind < 2 ? WS_XH : kind == 2 ? WS_Z : WS_ACTB;
    const size_t boff = kind == 0 ? WS_W1T + (size_t)8448 * D * 2 : kind == 1 ? WS_W1T + (size_t)(8448 + 1024) * D * 2 : kind == 2 ? WS_WOA : WS_WOB;
    u.A = (const char*)ws + aoff + (size_t)pm * 256 * D * 2; u.B = (const char*)ws + boff + (size_t)pn * 256 * D * 2;
}
struct SchedH {
    pg::TileOrder o; unsigned char* ws; int c;
    __device__ bool next(int i, pg::Unit& u) const {
        const int nreg = c < 4 ? 2 : 4; int q, kind;
        if (i < 3 * nreg) { const int r = i / 3, kk = i - 3 * r; q = c + 128 * r; kind = kk == 2 ? 3 : kk; }
        else { const int e = i - 3 * nreg;
            if (c >= 4 && c < 12 && e == 0) { const int ob = c - 4; q = (ob & 3) + 128 * (2 + (ob >> 2)); kind = 0; }
            else if (c >= 12 && c < 20 && e < 2) { const int ob = c - 12; q = (ob & 3) + 128 * (2 + (ob >> 2)); kind = e == 0 ? 1 : 3; }
            else return false; }
        int pm, pn; if (!o.get_linear(q, pm, pn)) return false;
        unit3(u, ws, pm, pn, kind); return true; }
};
struct SchedList3 { unsigned char* ws; int pm, pn, n, kinds;
    __device__ bool next(int i, pg::Unit& u) const { if (i >= n) return false; unit3(u, ws, pm, pn, (kinds >> (4 * i)) & 15); return true; } };
struct SchedOne { const char* A; const char* B; int pm, pn, K;
    __device__ bool next(int i, pg::Unit& u) const { if (i >= 1) return false; u.pm = pm; u.pn = pn; u.kind = 0; u.A = A + (size_t)pm * 256 * K * 2; u.B = B + (size_t)pn * 256 * K * 2; return true; } };
__device__ __forceinline__ void sub_barrier(unsigned* cnt, unsigned n, int wave_s) {
    asm volatile("s_waitcnt vmcnt(0)" ::: "memory");
    __syncthreads();
    if (fresh_tid_w(wave_s) == 0) {
        __builtin_amdgcn_fence(__ATOMIC_RELEASE, "agent");
        asm volatile("s_waitcnt vmcnt(0)" ::: "memory");
        xb_add(cnt, 1u);
        unsigned sp = 0; while (xb_ld(cnt) < n) {     __builtin_amdgcn_s_sleep(2); if (++sp > (1u << 24)) break; }
        __builtin_amdgcn_fence(__ATOMIC_ACQUIRE, "agent");
        asm volatile("s_waitcnt vmcnt(0)" ::: "memory");
    }
    __syncthreads();
}

__device__ __forceinline__ float ssq_total(const float* ssq, int row, int fq) {
    const f32x4 v = *(const f32x4*)(ssq + (size_t)row * 16 + 4 * fq); float s = (v.x + v.y) + (v.z + v.w);
    s += __shfl_xor(s, 16); s += __shfl_xor(s, 32); return s;
}
struct Epi4 {
    unsigned char* ws; const float* xp; const float* xs;
    __device__ __forceinline__ void operator()(const f32x4 (&acc)[2][2][4][2], const pg::Unit& u, int wr, int wc, int fr, int fq) const {
        float* ssq = (float*)(ws + WS_SSQ1);
        const char* xb = (const char*)ws + WS_XH; char* hb = (char*)ws + WS_K;
#pragma unroll
        for (int ai = 0; ai < 2; ++ai)
#pragma unroll
            for (int m = 0; m < 4; ++m) {
                const int row = u.pm * 256 + ai * 128 + wr * 64 + m * 16 + fr;
                const bool ok = row < MREAL; float s = 0.f;
                const float rms = ((const float*)(ws + WS_RSTD0))[ok ? row : 0];
#pragma unroll
                for (int bj = 0; bj < 2; ++bj) {
                    const unsigned e = (unsigned)(row * D + u.pn * 256 + bj * 128 + wc * 32 + 8 * fq);
                    if (ok) {
                        const h16x8 xh = *(const h16x8*)(xb + e * 2u);
                        const f32x4 x0 = up4(__builtin_shufflevector(xh, xh, 0, 1, 2, 3)) * rms + acc[ai][bj][m][0], x1 = up4(__builtin_shufflevector(xh, xh, 4, 5, 6, 7)) * rms + acc[ai][bj][m][1];
                        *(h16x8*)(hb + e * 2u) = cvt8(x0, x1);
                        s += (x0.x * x0.x + x0.y * x0.y) + (x0.z * x0.z + x0.w * x0.w) + (x1.x * x1.x + x1.y * x1.y) + (x1.z * x1.z + x1.w * x1.w);
                    }
                }
                s += __shfl_xor(s, 16); s += __shfl_xor(s, 32);
                if (ok && fq == 0) ssq[(unsigned)(row * 16 + u.pn * 4 + wc)] = s;
            }
    }
};
struct Sched4 { pg::TileOrder o; const char* A; const char* B;
    __device__ bool next(int i, pg::Unit& u) const { int pm, pn; if (!o.get(i, pm, pn)) return false; u.pm = pm; u.pn = pn; u.kind = 0;
        u.A = A + (size_t)pm * 256 * D * 2; u.B = B + (size_t)pn * 256 * D * 2; return true; } };
struct Epi5a {
    unsigned char* ws;
    __device__ __forceinline__ void operator()(const f32x4 (&acc)[2][2][4][2], const pg::Unit& u, int wr, int wc, int fr, int fq) const {
        const float* ssq = (const float*)(ws + WS_SSQ1); char* gbp = (char*)ws + WS_V;
#pragma unroll
        for (int ai = 0; ai < 2; ++ai)
#pragma unroll
            for (int m = 0; m < 4; ++m) {
                const int row = u.pm * 256 + ai * 128 + wr * 64 + m * 16 + fr;
                const int rowc = row < MREAL ? row : MREAL - 1;
                const float rs = -1.4426950408889634f * __builtin_amdgcn_rsqf(ssq_total(ssq, rowc, fq) * (1.0f / D) + EPS);
#pragma unroll
                for (int bj = 0; bj < 2; ++bj) {
                    const unsigned e = (unsigned)(row * D + u.pn * 256 + bj * 128 + wc * 32 + 8 * fq); f32x4 g0, g1;
#pragma unroll
                    for (int j = 0; j < 4; ++j) { g0[j] = __builtin_amdgcn_rcpf(1.0f + __builtin_amdgcn_exp2f(acc[ai][bj][m][0][j] * rs)); g1[j] = __builtin_amdgcn_rcpf(1.0f + __builtin_amdgcn_exp2f(acc[ai][bj][m][1][j] * rs)); }
                    *(h16x8*)(gbp + e * 2u) = cvt8(g0, g1);
                }
            }
    }
};
struct Epi5b {
    float* out; unsigned char* ws; const float* gfinal; gu32* ctl; LAS unsigned char* lx;
    __device__ __forceinline__ void operator()(f32x4 (&acc)[2][2][4][2], const pg::Unit& u, int wr, int wc, int fr_in, int fq_in) const {
        int fr = fr_in, fq = fq_in; asm volatile("" : "+v"(fr), "+v"(fq));
        const char* gbp = (const char*)ws + WS_V; const char* xhp = (const char*)ws + WS_K; char* ob = (char*)out;
        LAS float* P = (LAS float*)lx; LAS float* S = (LAS float*)(lx + 4096);
        const int wid = wr * 4 + wc, lane = fq * 16 + fr;
        LAS float* Pb = P + (wr * 64 + fr) * 4 + wc; const LAS float* Sb = S + wr * 64 + fr;
#pragma unroll
        for (int ai = 0; ai < 2; ++ai)
#pragma unroll
            for (int m = 0; m < 4; ++m) {
                const int rl = ai * 128 + wr * 64 + m * 16 + fr, row = u.pm * 256 + rl;
                const bool ok = row < MREAL; float s = 0.f;
#pragma unroll
                for (int bj = 0; bj < 2; ++bj) {
                    const unsigned e = (unsigned)(row * D + u.pn * 256 + bj * 128 + wc * 32 + 8 * fq);
                    if (ok) {
                        const h16x8 g = *(const h16x8*)(gbp + e * 2u), xh = *(const h16x8*)(xhp + e * 2u);
                        const f32x4 g0 = up4(__builtin_shufflevector(g, g, 0, 1, 2, 3)), g1 = up4(__builtin_shufflevector(g, g, 4, 5, 6, 7));
                        const f32x4 x0 = up4(__builtin_shufflevector(xh, xh, 0, 1, 2, 3)) + g0 * acc[ai][bj][m][0], x1 = up4(__builtin_shufflevector(xh, xh, 4, 5, 6, 7)) + g1 * acc[ai][bj][m][1];
                        acc[ai][bj][m][0] = x0; acc[ai][bj][m][1] = x1;
                        s += (x0.x * x0.x + x0.y * x0.y) + (x0.z * x0.z + x0.w * x0.w) + (x1.x * x1.x + x1.y * x1.y) + (x1.z * x1.z + x1.w * x1.w);
                    }
                }
                s += __shfl_xor(s, 16); s += __shfl_xor(s, 32);
                if (fq == 0) Pb[(ai * 128 + m * 16) * 4] = s;
                if (m & 1) asm volatile("" ::: "memory");
            }
        asm volatile("s_waitcnt lgkmcnt(0)" ::: "memory"); __builtin_amdgcn_s_barrier(); asm volatile("" ::: "memory");
        const int rrow = wid * 32 + (lane & 31);
        float* slots = (float*)(ws + WS_XCH) + ((size_t)u.pm * 256 + rrow) * 4;
        if (lane < 32) { const f32x4 p4 = *(const LAS f32x4*)(P + rrow * 4); __hip_atomic_store(slots + u.pn, (p4.x + p4.y) + (p4.z + p4.w), __ATOMIC_RELAXED, __HIP_MEMORY_SCOPE_AGENT); }
        asm volatile("s_waitcnt vmcnt(0)" ::: "memory");
        unsigned* cnt = (unsigned*)(ctl + CW_PANEL + 64 * u.pm);
        if (lane == 0) __hip_atomic_fetch_add(cnt, 1u, __ATOMIC_RELAXED, __HIP_MEMORY_SCOPE_AGENT);
        if (wid == 0) {
            unsigned sp = 0;
            while ((unsigned)__builtin_amdgcn_readfirstlane((int)__hip_atomic_load(cnt, __ATOMIC_RELAXED, __HIP_MEMORY_SCOPE_AGENT)) < 32u) { __builtin_amdgcn_s_sleep(2); if (++sp > (1u << 22)) break; }
            __builtin_amdgcn_fence(__ATOMIC_ACQUIRE, "agent");
        }
        asm volatile("s_waitcnt vmcnt(0) lgkmcnt(0)" ::: "memory"); __builtin_amdgcn_s_barrier(); asm volatile("" ::: "memory");
        if (lane < 32) { float t = 0.f;
#pragma unroll
            for (int q = 0; q < 4; ++q) t += __hip_atomic_load(slots + q, __ATOMIC_RELAXED, __HIP_MEMORY_SCOPE_AGENT);
            S[rrow] = __builtin_amdgcn_rsqf(t * (1.0f / D) + EPS); }
        asm volatile("s_waitcnt vmcnt(0) lgkmcnt(0)" ::: "memory"); __builtin_amdgcn_s_barrier(); asm volatile("" ::: "memory");
#pragma unroll
        for (int ai = 0; ai < 2; ++ai)
#pragma unroll
            for (int m = 0; m < 4; ++m) {
                const int rl = ai * 128 + wr * 64 + m * 16 + fr, row = u.pm * 256 + rl;
                const float rs = Sb[ai * 128 + m * 16];
                if (row < MREAL) {
#pragma unroll
                    for (int bj = 0; bj < 2; ++bj) {
                        const int col = u.pn * 256 + bj * 128 + wc * 32 + 8 * fq; const unsigned e = (unsigned)(row * D + col);
                        *(f32x4*)(ob + e * 4u) = acc[ai][bj][m][0] * rs * *(const f32x4*)(gfinal + col); *(f32x4*)(ob + e * 4u + 16) = acc[ai][bj][m][1] * rs * *(const f32x4*)(gfinal + col + 4);
                    }
                }
            }
        asm volatile("s_waitcnt lgkmcnt(0)" ::: "memory"); __builtin_amdgcn_s_barrier(); asm volatile("" ::: "memory");
    }
};
struct Sched5b { pg::TileOrder o; const char* A; const char* B;
    __device__ bool next(int i, pg::Unit& u) const { int pm, pn; if (!o.get(i, pm, pn)) return false; u.pm = pm; u.pn = pn; u.kind = 0;
        u.A = A + (size_t)pm * 256 * PLE * 2; u.B = B + (size_t)pn * 256 * PLE * 2; return true; } };

namespace s2 {
constexpr int RS = 72, MAT_B = 16 * RS * 2;
constexpr int CH_QT = 0, CH_RT = MAT_B, CH_BT = 2 * MAT_B, CH_KT = 3 * MAT_B, CH_VT = 4 * MAT_B, CH_MK = 5 * MAT_B, CH_NK = CH_MK + 512, CH_NB = CH_NK + 512, CH_TI = CH_NB + 512,
              CH_E8 = CH_TI + 512, CH_E16 = CH_E8 + 256, CH_BYTES = CH_E16 + 256;
constexpr int OFF_TW = 4 * CH_BYTES, OFF_AL = OFF_TW + 64 * RS * 2, OFF_YY = OFF_TW  , OFF_BON = OFF_AL + 64 * RS * 2, OFF_N2 = OFF_BON + 512, OFF_SZ = OFF_N2 + 512,
              OFF_CT = OFF_SZ + 8192, OFF_W2L = OFF_CT + 25 * 256, OFF_I2L = OFF_W2L + 64 * RS * 2, OFF_RAW = OFF_I2L + 64 * RS * 2;
constexpr int RAW_PLANE = 9216, RAW_R = 0, RAW_K = RAW_PLANE, RAW_V = 2 * RAW_PLANE, RAW_Z = 3 * RAW_PLANE, RAW_W = 4 * RAW_PLANE, RAW_BYTES = 4 * RAW_PLANE + 17408, OFF_END = OFF_RAW + RAW_BYTES;
static_assert(OFF_END <= SCAN_LDS_BYTES && 16384 <= 2 * 64 * RS * 2 && (OFF_RAW % 16) == 0, "scan LDS");
typedef short v4i16_t __attribute__((ext_vector_type(4)));
__device__ __forceinline__ f32x4 mm16(h16x4 a, h16x4 b, f32x4 c) {
    const h16x4 z = (h16x4){(h16)0.f, (h16)0.f, (h16)0.f, (h16)0.f};
    return __builtin_amdgcn_mfma_f32_16x16x32_f16(__builtin_shufflevector(a, z, 0, 1, 2, 3, 4, 5, 6, 7), __builtin_shufflevector(b, z, 0, 1, 2, 3, 4, 5, 6, 7), c, 0, 0, 0); }
__device__ __forceinline__ h16x4 ldtr(const LAS unsigned char* p) { return __builtin_bit_cast(h16x4, __builtin_amdgcn_ds_read_tr16_b64_v4i16((LAS v4i16_t*)p)); }
__device__ __forceinline__ h16x4 ldR(const LAS unsigned char* m, int row, int col) { return *(const LAS h16x4*)(m + (row * RS + col) * 2); }
__device__ __forceinline__ h16x4 ldS(const LAS unsigned char* m, int row, int col) { return *(const LAS h16x4*)(m + (row * 16 + col) * 2); }
template <int CTRL> __device__ __forceinline__ float dppf(float x) { return __builtin_bit_cast(float, __builtin_amdgcn_update_dpp(0, __builtin_bit_cast(int, x), CTRL, 0xf, 0xf, true)); }
__device__ __forceinline__ f32x4 mix4_(h16x4 c, h16x4 d, f32x4 mu) {
    return (f32x4){ __builtin_fmaf((float)d[0], mu[0], (float)c[0]), __builtin_fmaf((float)d[1], mu[1], (float)c[1]), __builtin_fmaf((float)d[2], mu[2], (float)c[2]), __builtin_fmaf((float)d[3], mu[3], (float)c[3]) }; }
typedef _Float16 h16x2 __attribute__((ext_vector_type(2)));
typedef unsigned u32x2 __attribute__((ext_vector_type(2)));
typedef _Float16 h16x2 __attribute__((ext_vector_type(2)));
#define HMUL(hv, i, b) __builtin_fmaf((float)(hv)[i], (b), 0.0f)
#define HFMA(hv, i, b, c) __builtin_fmaf((float)(hv)[i], (b), (c))
__device__ __forceinline__ float rowscan16(float x) { x += dppf<0x111>(x); x += dppf<0x112>(x); x += dppf<0x114>(x); x += dppf<0x118>(x); return x; }
}
__device__ __forceinline__ void scan_prefetch(LAS unsigned char* L, const unsigned char* ws, int wave, int lane, int h, int rr, bool skip0) {
    using namespace s2;
    for (int q = wave; q < 53; q += NWAVES) {
        if (q < 36) { const int p = q / 9, qq = q - 9 * p, r0 = 8 * qq + (lane >> 3), c = (lane & 7) ^ (r0 & 7);
            int r = r0 > 64 ? 64 : r0; if (skip0 && r == 0) r = 1;
            const size_t pb = p == 0 ? WS_R : p == 1 ? WS_K : p == 2 ? WS_V : WS_Z;
            __builtin_amdgcn_global_load_lds((const unsigned*)(ws + pb + (size_t)(rr + r) * 2048 + 128 * h + 16 * c), (LAS unsigned*)(L + OFF_RAW + p * RAW_PLANE + qq * 1024), 16, 0, 0);
        } else { const int qq = q - 36, r0 = 4 * qq + (lane >> 4), c = lane & 15, cs = (c & 8) | ((c & 7) ^ (r0 & 7));
            int r = r0 > 64 ? 64 : r0; if (skip0 && r == 0) r = 1;
            __builtin_amdgcn_global_load_lds((const unsigned*)(ws + WS_WA + (size_t)(rr + r) * 256 + 16 * cs), (LAS unsigned*)(L + OFF_RAW + RAW_W + qq * 1024), 16, 0, 0);
        }
    }
}
__device__ __forceinline__ void scan_prefetch_fast(LAS unsigned char* L, const unsigned char* ws, int wave, int lane, int h, int rr) {
    using namespace s2;
    if (wave < 4) {
        const int r_l = lane >> 3, cx = (lane & 7) ^ r_l;
        const size_t pb = wave == 0 ? WS_R : wave == 1 ? WS_K : wave == 2 ? WS_V : WS_Z;
        const unsigned char* base = ws + pb + 128 * h + 16 * cx;
        const unsigned char* a = base + (size_t)(rr + r_l) * 2048;
        LAS unsigned char* d = L + OFF_RAW + wave * RAW_PLANE;
#pragma unroll
        for (int qq = 0; qq < 8; ++qq) __builtin_amdgcn_global_load_lds((const unsigned*)(a + qq * 16384), (LAS unsigned*)(d + qq * 1024), 16, 0, 0);
        __builtin_amdgcn_global_load_lds((const unsigned*)(base + (size_t)(rr + 64) * 2048), (LAS unsigned*)(d + 8 * 1024), 16, 0, 0);
    } else {
        const int w4 = wave - 4, r_l = lane >> 4, c = lane & 15;
#pragma unroll
        for (int i = 0; i < 5; ++i) { const int qq = w4 + 4 * i;
            if (qq < 17) { const int r0 = 4 * qq + r_l, r = qq == 16 ? 64 : r0, cs = (c & 8) | ((c & 7) ^ (r0 & 7));
                __builtin_amdgcn_global_load_lds((const unsigned*)(ws + WS_WA + (size_t)(rr + r) * 256 + 16 * cs), (LAS unsigned*)(L + OFF_RAW + RAW_W + qq * 1024), 16, 0, 0); } }
    }
}
#define SBAR() do { asm volatile("s_waitcnt lgkmcnt(0)" ::: "memory"); __builtin_amdgcn_s_barrier(); asm volatile("" ::: "memory"); } while (0)
__device__ __forceinline__ void scan_head_v2(Frame& F, int bh, bool dry) {
    using namespace s2;
    const bool samp = bh >= 128; const int b = (bh & 127) >> 4, h = bh & 15;
    const int T = samp ? DSEQ : SEQ, row0 = samp ? NP + DSEQ * b : SEQ * b;
    unsigned char* ws = F.ws; float* out = F.out;
    char* Zb = (char*)(ws + WS_Z);
    LAS unsigned char* L = F.lds;
    const int tid = fresh_tid_w(F.wave_s), lane = tid & 63, wave = F.wave_s, c15 = lane & 15, g = lane >> 4;
    const int cw = wave & 3, hf = wave >> 2;
    scan_prefetch(L, ws, wave, lane, h, row0 - 1, true);
    for (int i = tid; i < 25 * 64; i += NWAVES * 64) { const int kind = i >> 6, k = i & 63, hk = 64 * h + k; float v;
        const float* mu = F.in[IN_MU]; const float* sh = F.in[IN_ST_SHIFT] + (size_t)b * SHIFT_COLS;
        switch (kind) { case 0: v = mu[hk]; break; case 1: v = mu[1024 + hk]; break; case 2: v = mu[2048 + hk]; break; case 3: v = mu[3200 + hk]; break;
            case 4: v = F.in[IN_KREM][hk]; break; case 5: v = F.in[IN_KREP][hk]; break; case 6: v = -1.4426950408889634f * F.in[IN_WDEC0][hk]; break; case 7: v = -1.4426950408889634f * F.in[IN_WICL0][hk]; break;
            case 8: v = F.in[IN_RBONUS][hk]; break; case 9: v = F.in[IN_GNW][hk]; break; case 10: v = F.in[IN_GNB][hk]; break; case 11: v = mu[3072 + k]; break; case 12: v = mu[3136 + k]; break;
            case 13: v = samp ? sh[hk] : 0.f; break; case 14: v = samp ? sh[1024 + hk] : 0.f; break; case 15: v = samp ? sh[2048 + hk] : 0.f; break; case 16: v = samp ? sh[3200 + hk] : 0.f; break;
            case 17: v = samp ? sh[3072 + k] : 0.f; break; case 18: v = samp ? sh[3136 + k] : 0.f; break;
            case 19: v = 1.f - F.in[IN_KREP][hk]; break; case 20: v = 1.f - mu[1024 + hk]; break; case 21: v = 1.f - mu[2048 + hk]; break; case 22: v = 1.f - mu[3200 + hk]; break;
            case 23: v = 1.f - mu[3072 + k]; break; default: v = 1.f - mu[3136 + k]; break; }
        *(LAS float*)(L + OFF_CT + i * 4) = v; }
    __syncthreads();
    for (int i = tid; i < 8 * 64; i += NWAVES * 64) { const int kind = i >> 6, k = i & 63;
        const int src = kind == 0 ? 0 : kind == 1 ? 1 : kind == 2 ? 2 : kind == 3 ? 3 : kind == 4 ? 4 : kind == 5 ? 8 : kind == 6 ? 11 : 12;
        const float v = *(const LAS float*)(L + OFF_CT + (src * 64 + k) * 4);
        asm volatile("" ::: "memory");
        *(LAS h16*)(L + OFF_CT + 20 * 256 + i * 2) = (h16)v; }
    { const int k = tid >> 3, ch = tid & 7;
      *(LAS h16x8*)(L + OFF_W2L + (k * RS + 8 * ch) * 2) = *(const h16x8*)((const h16*)(ws + WS_W2T) + (size_t)(64 * h + k) * 64 + 8 * ch);
      *(LAS h16x8*)(L + OFF_I2L + (k * RS + 8 * ch) * 2) = *(const h16x8*)((const h16*)(ws + WS_I2T) + (size_t)(64 * h + k) * 64 + 8 * ch); }
#define CT4(kind, k) (*(const LAS f32x4*)(L + OFF_CT + ((kind) * 64 + (k)) * 4))
#define CTH4(kind, k) (*(const LAS h16x4*)(L + OFF_CT + 20 * 256 + ((kind) * 64 + (k)) * 2))
#define CTH8(kind, k) (*(const LAS h16x8*)(L + OFF_CT + 20 * 256 + ((kind) * 64 + (k)) * 2))
#define CT1(kind, k) (*(const LAS float*)(L + OFF_CT + ((kind) * 64 + (k)) * 4))
#define RAW8(p, row, kc) (*(const LAS h16x4*)(L + OFF_RAW + (p) * RAW_PLANE + (row) * 128 + ((((kc) >> 3) ^ ((row) & 7)) << 4) + ((kc) & 7) * 2))
#define RAWW8(row, hc) (*(const LAS h16x4*)(L + OFF_RAW + RAW_W + (row) * 256 + (((((hc) >> 3) & 8) | ((((hc) >> 3) & 7) ^ ((row) & 7))) << 4) + ((hc) & 7) * 2))
    f32x4 S[4];
#pragma unroll
    for (int kt = 0; kt < 4; ++kt) { S[kt] = (f32x4){0.f, 0.f, 0.f, 0.f};
        if (samp && wave < 4) S[kt] = *(const f32x4*)(F.in[IN_ST_WKV] + ((size_t)(b * 16 + h) * 64 + 16 * wave + c15) * 64 + 16 * kt + 4 * g); }
    asm volatile("s_waitcnt vmcnt(0)" ::: "memory");
    SBAR();
    if (tid < 96) { const int kind = tid >> 4, c4 = (tid & 15) * 4;
        const int ctk = kind < 3 ? 13 + kind : kind == 3 ? 16 : 13 + kind; const h16x4 v = cvt4(CT4(ctk, c4));
        if (kind < 4) *(LAS h16x4*)(L + OFF_RAW + kind * RAW_PLANE + (((c4 >> 3) ^ 0) << 4) + (c4 & 7) * 2) = v;
        else { const int hc = (kind - 4) * 64 + c4; *(LAS h16x4*)(L + OFF_RAW + RAW_W + ((((hc >> 3) & 8) | (((hc >> 3) & 7) ^ 0)) << 4) + (hc & 7) * 2) = v; } }
    SBAR();
    for (int t0 = 0; t0 < T; t0 += 64) {
        const int nb = (T - t0) < 64 ? (T - t0) : 64, nch = nb >> 4;
        const bool cact = cw < nch;
        const int tl = 16 * cw + c15;
        LAS unsigned char* CB = L + cw * CH_BYTES;
        h16x4 rm[2], km[2], kapm[2], rbm[2]; float n2 = 0.f;
#define MIX4(c, p, mu4) mix4_((c), (p) - (c), (mu4))
        if (cact) {
#pragma unroll
            for (int kt = 0; kt < 2; ++kt) {
                const int kc = 32 * hf + 16 * kt + 4 * g;
                const h16x4 rc = RAW8(0, tl + 1, kc), kc4 = RAW8(1, tl + 1, kc), vc = RAW8(2, tl + 1, kc), wlc = RAWW8(tl + 1, kc), alc = RAWW8(tl + 1, 64 + kc);
                const h16x4 rp = RAW8(0, tl, kc), kp = RAW8(1, tl, kc), vp = RAW8(2, tl, kc), wlp = RAWW8(tl, kc), alp = RAWW8(tl, 64 + kc);
                const h16x4 r16 = rc + CTH4(0, kc) * (rp - rc), k16 = kc4 + CTH4(1, kc) * (kp - kc4), v16 = vc + CTH4(2, kc) * (vp - vc);
                const h16x4 wl16 = wlc + CTH4(6, kc) * (wlp - wlc), al16 = alc + CTH4(7, kc) * (alp - alc);
                const h16x4 kap16 = k16 * CTH4(4, kc), rb16 = r16 * CTH4(5, kc);
                rm[kt] = r16; km[kt] = k16; kapm[kt] = kap16; rbm[kt] = rb16;
                n2 = __builtin_amdgcn_fdot2(__builtin_shufflevector(kap16, kap16, 0, 1), __builtin_shufflevector(kap16, kap16, 0, 1), n2, false);
                n2 = __builtin_amdgcn_fdot2(__builtin_shufflevector(kap16, kap16, 2, 3), __builtin_shufflevector(kap16, kap16, 2, 3), n2, false);
                f32x4 tw;
#pragma unroll
                for (int i = 0; i < 4; ++i) tw[i] = __builtin_fmaf(-2.0f, __builtin_amdgcn_rcpf(1.0f + __builtin_amdgcn_exp2f(HMUL(wl16, i, 2.0f * 1.4426950408889634f))), 1.0f);
                *(LAS h16x4*)(L + OFF_TW + (tl * RS + kc) * 2) = cvt4(tw); *(LAS h16x4*)(L + OFF_AL + (tl * RS + kc) * 2) = al16;
                *(LAS h16x4*)(CB + CH_VT + (c15 * RS + kc) * 2) = v16;
            }
            n2 += __shfl_xor(n2, 16); n2 += __shfl_xor(n2, 32);
            if (g == 0) *(LAS float*)(L + OFF_N2 + (hf * 64 + tl) * 4) = n2;
        }
        {
            const int t = tid >> 3, vg = tid & 7, v0 = 8 * vg;
            if (t < nb) {
                const h16x8 zc8 = *(const LAS h16x8*)(L + OFF_RAW + RAW_Z + (t + 1) * 128 + ((vg ^ ((t + 1) & 7)) << 4));
                const h16x8 zp8 = *(const LAS h16x8*)(L + OFF_RAW + RAW_Z + t * 128 + ((vg ^ (t & 7)) << 4));
                const h16x8 z8 = zc8 + CTH8(3, v0) * (zp8 - zc8);
                float sv[8];
#pragma unroll
                for (int j = 0; j < 8; ++j) sv[j] = HMUL(z8, j, __builtin_amdgcn_rcpf(1.0f + __builtin_amdgcn_exp2f(HMUL(z8, j, -1.4426950408889634f))));
                *(LAS h16x8*)(L + OFF_SZ + (t * 64 + v0) * 2) = cvt8((f32x4){sv[0], sv[1], sv[2], sv[3]}, (f32x4){sv[4], sv[5], sv[6], sv[7]});
            }
        }
        SBAR();
        if (t0 + 64 < T) scan_prefetch_fast(L, ws, wave, lane, h, row0 + t0 + 63);
        if (cact) {
            f32x4 dacc[2], aacc[2];
#pragma unroll
            for (int kt = 0; kt < 2; ++kt) { dacc[kt] = CT4(6, 32 * hf + 16 * kt + 4 * g); aacc[kt] = CT4(7, 32 * hf + 16 * kt + 4 * g); }
#pragma unroll
            for (int jp = 0; jp < 2; ++jp) {
                const h16x4 tw0 = *(const LAS h16x4*)(L + OFF_TW + (tl * RS + 32 * jp + 4 * g) * 2), tw1 = *(const LAS h16x4*)(L + OFF_TW + (tl * RS + 32 * jp + 16 + 4 * g) * 2);
                const h16x4 al0 = *(const LAS h16x4*)(L + OFF_AL + (tl * RS + 32 * jp + 4 * g) * 2), al1 = *(const LAS h16x4*)(L + OFF_AL + (tl * RS + 32 * jp + 16 + 4 * g) * 2);
                const h16x8 twf = __builtin_shufflevector(tw0, tw1, 0, 1, 2, 3, 4, 5, 6, 7), alf = __builtin_shufflevector(al0, al1, 0, 1, 2, 3, 4, 5, 6, 7);
#pragma unroll
                for (int kt = 0; kt < 2; ++kt) { const int o = ((32 * hf + 16 * kt + c15) * RS + 32 * jp + 4 * g) * 2;
                    const h16x8 wf = __builtin_shufflevector(*(const LAS h16x4*)(L + OFF_W2L + o), *(const LAS h16x4*)(L + OFF_W2L + o + 32), 0, 1, 2, 3, 4, 5, 6, 7);
                    const h16x8 jf = __builtin_shufflevector(*(const LAS h16x4*)(L + OFF_I2L + o), *(const LAS h16x4*)(L + OFF_I2L + o + 32), 0, 1, 2, 3, 4, 5, 6, 7);
                    dacc[kt] = __builtin_amdgcn_mfma_f32_16x16x32_f16(wf, twf, dacc[kt], 0, 0, 0); aacc[kt] = __builtin_amdgcn_mfma_f32_16x16x32_f16(jf, alf, aacc[kt], 0, 0, 0); }
            }
            const float rn = __builtin_amdgcn_rsqf(fmaxf(*(const LAS float*)(L + OFF_N2 + tl * 4) + *(const LAS float*)(L + OFF_N2 + (64 + tl) * 4), 1e-24f));
            float bs = 0.f;
#pragma unroll
            for (int kt = 0; kt < 2; ++kt) {
                const int kc = 32 * hf + 16 * kt + 4 * g;
                const f32x4 krep = CT4(5, kc), omk = CT4(19, kc);
                f32x4 qt, rt, bt, kt4, e8v, e16v, khv, ktvv, bbv, Lcv, Lpv, refv;
#pragma unroll
                for (int i = 0; i < 4; ++i) {
                    const float lam = __builtin_amdgcn_rcpf(__builtin_fmaf(__builtin_amdgcn_exp2f(dacc[kt][i]), -1.0f / (DECAY_SCALE * 1.4426950408889634f), -1.0f / (DECAY_SCALE * 1.4426950408889634f))), a = __builtin_amdgcn_rcpf(1.0f + __builtin_amdgcn_exp2f(aacc[kt][i]));
                    khv[i] = HMUL(kapm[kt], i, rn); ktvv[i] = HMUL(km[kt], i, __builtin_fmaf(a, krep[i], omk[i])); bbv[i] = a * khv[i];
                    bs = HFMA(rbm[kt], i, ktvv[i], bs);
                    Lcv[i] = rowscan16(lam); Lpv[i] = Lcv[i] - lam;
                }
#pragma unroll
                for (int i = 0; i < 4; ++i) { refv[i] = __shfl(Lcv[i], (lane & 48) | 7); e16v[i] = __shfl(Lcv[i], (lane & 48) | 15); }
#pragma unroll
                for (int i = 0; i < 4; ++i) {
                    const float ea = __builtin_amdgcn_exp2f(Lpv[i] - refv[i]), eb = __builtin_amdgcn_exp2f(Lcv[i] - refv[i]), ec = __builtin_amdgcn_rcpf(eb);
                    qt[i] = khv[i] * ea; rt[i] = HMUL(rm[kt], i, eb); bt[i] = bbv[i] * ec; kt4[i] = ktvv[i] * ec; e8v[i] = refv[i];
                }
                const int o = (c15 * RS + kc) * 2;
                *(LAS h16x4*)(CB + CH_QT + o) = cvt4(qt); *(LAS h16x4*)(CB + CH_RT + o) = cvt4(rt); *(LAS h16x4*)(CB + CH_BT + o) = cvt4(bt); *(LAS h16x4*)(CB + CH_KT + o) = cvt4(kt4);
                if (c15 == 0) { *(LAS f32x4*)(CB + CH_E8 + kc * 4) = e8v; *(LAS f32x4*)(CB + CH_E16 + kc * 4) = e16v; }
            }
            bs += __shfl_xor(bs, 16); bs += __shfl_xor(bs, 32);
            if (g == 0) *(LAS float*)(L + OFF_BON + (hf * 64 + tl) * 4) = bs;
        }
        SBAR();
        if (cact) {
            h16x8 qf[2], bf[2];
#pragma unroll
            for (int p = 0; p < 2; ++p) { qf[p] = __builtin_shufflevector(ldR(CB + CH_QT, c15, 32 * p + 4 * g), ldR(CB + CH_QT, c15, 32 * p + 16 + 4 * g), 0, 1, 2, 3, 4, 5, 6, 7);
                bf[p] = __builtin_shufflevector(ldR(CB + CH_BT, c15, 32 * p + 4 * g), ldR(CB + CH_BT, c15, 32 * p + 16 + 4 * g), 0, 1, 2, 3, 4, 5, 6, 7); }
            const f32x4 z4 = (f32x4){0.f, 0.f, 0.f, 0.f};
            if (hf == 0) {
                f32x4 Dr = z4, Dc = z4;
#pragma unroll
                for (int p = 0; p < 2; ++p) { Dr = __builtin_amdgcn_mfma_f32_16x16x32_f16(bf[p], qf[p], Dr, 0, 0, 0); Dc = __builtin_amdgcn_mfma_f32_16x16x32_f16(qf[p], bf[p], Dc, 0, 0, 0); }
                f32x4 Xr, Xc, Id;
#pragma unroll
                for (int i = 0; i < 4; ++i) { const int u = 4 * g + i; Xr[i] = u < c15 ? -Dr[i] : 0.f; Xc[i] = c15 < u ? -Dc[i] : 0.f; Id[i] = u == c15 ? 1.f : 0.f; }
                const h16x4 hXr = cvt4(Xr), hXc = cvt4(Xc);
                const f32x4 X2c = mm16(hXr, hXc, z4), X2r = mm16(hXc, hXr, z4);
                const f32x4 S1c = Id + Xc, S1r = Id + Xr;
                const h16x4 hX2r = cvt4(X2r), hX2c = cvt4(X2c), hS1c = cvt4(S1c);
                const f32x4 S2c = mm16(hX2r, hS1c, S1c), S2r = mm16(hS1c, hX2r, S1r);
                const f32x4 X4c = mm16(hX2r, hX2c, z4), X4r = mm16(hX2c, hX2r, z4);
                const h16x4 hX4r = cvt4(X4r), hX4c = cvt4(X4c), hS2c = cvt4(S2c);
                const f32x4 S4c = mm16(hX4r, hS2c, S2c), S4r = mm16(hS2c, hX4r, S2r);
                const f32x4 X8r = mm16(hX4c, hX4r, z4);
                const f32x4 TIr = mm16(cvt4(S4c), cvt4(X8r), S4r);
                *(LAS h16x4*)(CB + CH_TI + (c15 * 16 + 4 * g) * 2) = cvt4(TIr);
            } else {
                h16x8 kf[2], rf[2];
#pragma unroll
                for (int p = 0; p < 2; ++p) { kf[p] = __builtin_shufflevector(ldR(CB + CH_KT, c15, 32 * p + 4 * g), ldR(CB + CH_KT, c15, 32 * p + 16 + 4 * g), 0, 1, 2, 3, 4, 5, 6, 7);
                    rf[p] = __builtin_shufflevector(ldR(CB + CH_RT, c15, 32 * p + 4 * g), ldR(CB + CH_RT, c15, 32 * p + 16 + 4 * g), 0, 1, 2, 3, 4, 5, 6, 7); }
                f32x4 mk = z4, nk = z4, nbm = z4;
#pragma unroll
                for (int p = 0; p < 2; ++p) { mk = __builtin_amdgcn_mfma_f32_16x16x32_f16(kf[p], qf[p], mk, 0, 0, 0); nk = __builtin_amdgcn_mfma_f32_16x16x32_f16(kf[p], rf[p], nk, 0, 0, 0); nbm = __builtin_amdgcn_mfma_f32_16x16x32_f16(bf[p], rf[p], nbm, 0, 0, 0); }
#pragma unroll
                for (int i = 0; i < 4; ++i) { const int u = 4 * g + i; if (!(u < c15)) mk[i] = 0.f; if (!(u <= c15)) { nk[i] = 0.f; nbm[i] = 0.f; } }
                const int o = (c15 * 16 + 4 * g) * 2;
                *(LAS h16x4*)(CB + CH_MK + o) = cvt4(mk); *(LAS h16x4*)(CB + CH_NK + o) = cvt4(nk); *(LAS h16x4*)(CB + CH_NB + o) = cvt4(nbm);
                { LAS float* e8 = (LAS float*)(CB + CH_E8) + lane; LAS float* e16 = (LAS float*)(CB + CH_E16) + lane; const float rf = *e8; *e8 = __builtin_amdgcn_exp2f(rf); *e16 = __builtin_amdgcn_exp2f(*e16 - rf); }
            }
        }
        SBAR();
        if (wave < 4) {
            const int troff = ((4 * g + (c15 >> 2)) * RS + 4 * (c15 & 3)) * 2;
            for (int c = 0; c < nch; ++c) {
                const LAS unsigned char* B = L + c * CH_BYTES;
                f32x4 e8[4], e16[4]; h16x4 q[4], r[4], ktr[4], btr[4];
#pragma unroll
                for (int kt = 0; kt < 4; ++kt) { e8[kt] = *(const LAS f32x4*)(B + CH_E8 + (16 * kt + 4 * g) * 4); q[kt] = ldR(B + CH_QT, c15, 16 * kt + 4 * g); }
                const h16x4 vh = ldtr(B + CH_VT + troff + 16 * wave * 2), mk = ldS(B + CH_MK, c15, 4 * g), ti = ldS(B + CH_TI, c15, 4 * g), nk = ldS(B + CH_NK, c15, 4 * g), nbm = ldS(B + CH_NB, c15, 4 * g);
#pragma unroll
                for (int kt = 0; kt < 4; ++kt) { r[kt] = ldR(B + CH_RT, c15, 16 * kt + 4 * g); ktr[kt] = ldtr(B + CH_KT + troff + 16 * kt * 2); btr[kt] = ldtr(B + CH_BT + troff + 16 * kt * 2);
                    e16[kt] = *(const LAS f32x4*)(B + CH_E16 + (16 * kt + 4 * g) * 4); }
                f32x4 S8[4]; h16x4 s8h[4];
#pragma unroll
                for (int kt = 0; kt < 4; ++kt) { S8[kt] = S[kt] * e8[kt]; s8h[kt] = cvt4(S8[kt]); }
                const f32x4 z4 = (f32x4){0.f, 0.f, 0.f, 0.f};
                const h16x8 s01 = __builtin_shufflevector(s8h[0], s8h[1], 0, 1, 2, 3, 4, 5, 6, 7), s23 = __builtin_shufflevector(s8h[2], s8h[3], 0, 1, 2, 3, 4, 5, 6, 7);
                f32x4 Pa = mm16(mk, vh, z4);
                Pa = __builtin_amdgcn_mfma_f32_16x16x32_f16(__builtin_shufflevector(q[0], q[1], 0, 1, 2, 3, 4, 5, 6, 7), s01, Pa, 0, 0, 0);
                const f32x4 Pb = __builtin_amdgcn_mfma_f32_16x16x32_f16(__builtin_shufflevector(q[2], q[3], 0, 1, 2, 3, 4, 5, 6, 7), s23, z4, 0, 0, 0);
                const f32x4 sg = mm16(ti, cvt4(Pa + Pb), z4);
                const h16x4 sn = -cvt4(sg);
                f32x4 Ya = mm16(nk, vh, z4);
                Ya = __builtin_amdgcn_mfma_f32_16x16x32_f16(__builtin_shufflevector(r[0], r[1], 0, 1, 2, 3, 4, 5, 6, 7), s01, Ya, 0, 0, 0);
                f32x4 Yb = __builtin_amdgcn_mfma_f32_16x16x32_f16(__builtin_shufflevector(r[2], r[3], 0, 1, 2, 3, 4, 5, 6, 7), s23, z4, 0, 0, 0);
#pragma unroll
                for (int kt = 0; kt < 4; ++kt) S8[kt] = mm16(ktr[kt], vh, S8[kt]);
                Yb = mm16(nbm, sn, Yb);
#pragma unroll
                for (int kt = 0; kt < 4; ++kt) S[kt] = mm16(btr[kt], sn, S8[kt]) * e16[kt];
                const f32x4 Y = Ya + Yb;
#pragma unroll
                for (int i = 0; i < 4; ++i) *(LAS float*)(L + OFF_YY + ((16 * c + 4 * g + i) * 64 + 16 * wave + c15) * 4) = Y[i];
            }
        }
        asm volatile("s_waitcnt vmcnt(0)" ::: "memory");
        SBAR();
        {
            const int t = tid >> 3, vg = tid & 7, v0 = 8 * vg;
            if (t < nb) {
                const f32x4 y0 = *(const LAS f32x4*)(L + OFF_YY + (t * 64 + v0) * 4), y1 = *(const LAS f32x4*)(L + OFF_YY + (t * 64 + v0 + 4) * 4);
                float y[8] = {y0.x, y0.y, y0.z, y0.w, y1.x, y1.y, y1.z, y1.w};
                float s = 0.f;
#pragma unroll
                for (int j = 0; j < 8; ++j) s += y[j];
                s += dppf<0xB1>(s); s += dppf<0x4E>(s); s += dppf<0x141>(s);
                const float mean = s * (1.0f / 64.0f); float q = 0.f;
#pragma unroll
                for (int j = 0; j < 8; ++j) { y[j] -= mean; q += y[j] * y[j]; }
                q += dppf<0xB1>(q); q += dppf<0x4E>(q); q += dppf<0x141>(q);
                const float rstd = __builtin_amdgcn_rsqf(q * (1.0f / 64.0f) + GN_EPS);
                const float bonus = *(const LAS float*)(L + OFF_BON + t * 4) + *(const LAS float*)(L + OFF_BON + (64 + t) * 4);
                const h16x8 vv = *(const LAS h16x8*)(L + (t >> 4) * CH_BYTES + CH_VT + ((t & 15) * RS + v0) * 2);
                const h16x8 sz = *(const LAS h16x8*)(L + OFF_SZ + (t * 64 + v0) * 2);
                const f32x4 gw0 = CT4(9, v0), gw1 = CT4(9, v0 + 4), gb0 = CT4(10, v0), gb1 = CT4(10, v0 + 4);
                h16x8 o;
#pragma unroll
                for (int j = 0; j < 8; ++j) o[j] = (h16)((y[j] * rstd * (j < 4 ? gw0[j & 3] : gw1[j & 3]) + (j < 4 ? gb0[j & 3] : gb1[j & 3]) + bonus * (float)vv[j]) * (float)sz[j]);
                if (!dry) { char* zp = Zb + (size_t)(row0 + t0 + t) * 2048 + 128 * h + 16 * vg; const u32x4 ov = __builtin_bit_cast(u32x4, o);
                    asm volatile("global_store_dwordx4 %0, %1, off sc1\n\ts_nop 1" :: "v"(zp), "v"(ov) : "memory"); }
            }
        }
        if (!samp && (t0 & 255) == 192) {
            asm volatile("s_waitcnt vmcnt(0)" ::: "memory");
            SBAR();
            if (tid == 0 && !dry) __hip_atomic_fetch_add((unsigned*)(F.ctl + CW_RDY) + 64 * (b * 16 + (t0 >> 8)), 1u, __ATOMIC_RELAXED, __HIP_MEMORY_SCOPE_AGENT);
        } else SBAR();
    }
#undef CT4
#undef CT1
#undef RAW8
#undef RAWW8
    if (wave < 4 && !dry) {
#pragma unroll
        for (int kt = 0; kt < 4; ++kt) *(f32x4*)(out + (samp ? OFF_WKV_S : OFF_WKV_P) + ((size_t)(b * 16 + h) * 64 + 16 * wave + c15) * 64 + 16 * kt + 4 * g) = S[kt];
    }
    asm volatile("s_waitcnt vmcnt(0)" ::: "memory");
    __syncthreads();
}
__device__ __forceinline__ void conv_pass(Frame& F, int part, int nparts) {
    const int tid_ = fresh_tid_w(F.wave_s);
    float* out = F.out; unsigned char* ws = F.ws; const float* cw = F.in[IN_CONVW]; h16* AB = (h16*)(ws + WS_ACTB);
    for (int it = part * 512 + tid_; it < (NMT - 1) * 2 * 128; it += nparts * 512) {
        const int c8 = (it & 127) * 8, m = (it >> 7) & 1, pm = it >> 8;
        if ((pm & 15) == 0) continue;
        const float* sp = (const float*)(ws + WS_SIDEP) + (size_t)pm * 2048 + m * 1024 + c8; const float* sg = (const float*)(ws + WS_SIDEG) + (size_t)pm * 2048 + m * 1024 + c8;
        const float* su = (const float*)(ws + WS_SIDEU) + (size_t)(pm - 1) * 2048 + c8;
        h16x8 o;
#pragma unroll
        for (int j = 0; j < 8; ++j) { const float um2 = su[j], um1 = su[1024 + j];
            const float extra = m == 0 ? cw[c8 + j] * um2 + cw[D + c8 + j] * um1 : cw[c8 + j] * um1;
            o[j] = (h16)(sp[j] + sg[j] * extra); }
        *(h16x8*)(AB + ((size_t)pm * 256 + m) * D + c8) = o;
    }
    for (int it = part * 512 + tid_; it < NS * 128; it += nparts * 512) {
        const int row = NP + (it >> 7), c8 = (it & 127) * 8, rr = row - NP, t = rr & (DSEQ - 1), b = rr >> 4;
        const h16x8 u0 = *(const h16x8*)(rowptr16(out, ws, 0, row) + c8), gz = *(const h16x8*)(rowptr16(out, ws, 1, row) + c8);
        float um1[8], um2[8];
        if (t >= 1) { const h16x8 v = *(const h16x8*)(rowptr16(out, ws, 0, row - 1) + c8);
#pragma unroll
            for (int j = 0; j < 8; ++j) um1[j] = (float)v[j]; }
        else {
#pragma unroll
            for (int j = 0; j < 8; ++j) um1[j] = F.in[IN_ST_CONV][((size_t)b * 2 + 1) * D + c8 + j]; }
        if (t >= 2) { const h16x8 v = *(const h16x8*)(rowptr16(out, ws, 0, row - 2) + c8);
#pragma unroll
            for (int j = 0; j < 8; ++j) um2[j] = (float)v[j]; }
        else {
#pragma unroll
            for (int j = 0; j < 8; ++j) um2[j] = F.in[IN_ST_CONV][((size_t)b * 2 + t) * D + c8 + j]; }
        h16x8 o;
#pragma unroll
        for (int j = 0; j < 8; ++j) { const float cv = cw[c8 + j] * um2[j] + cw[D + c8 + j] * um1[j] + cw[2 * D + c8 + j] * (float)u0[j]; o[j] = (h16)((float)gz[j] * cv); }
        *(h16x8*)(AB + (size_t)row * D + c8) = o;
    }
    for (int i = part * 512 + tid_; i < (MP - MREAL) * 128; i += nparts * 512) { h16x8 z;
#pragma unroll
        for (int j = 0; j < 8; ++j) z[j] = (h16)0.f;
        *(h16x8*)(AB + (size_t)MREAL * D + (size_t)i * 8) = z; }
}

constexpr int N_PHASES = 6;
__device__ __forceinline__ void merge_queue(Frame& F, const float* rstd0, bool wait_helpers) {
    unsigned char* ws = F.ws;
    for (;;) {
        if (fresh_tid_w(F.wave_s) == 0) {
            unsigned sp = 0;
            if (wait_helpers) { unsigned* hd = (unsigned*)(F.ctl + CW_SUB); while (xb_ld(hd) < 2u * (unsigned)(F.G - 128)) { __builtin_amdgcn_s_sleep(8); if (++sp > (1u << 24)) break; } }
            const unsigned idx = xb_add((unsigned*)(F.ctl + CW_MQ), 1u);
            if (idx < 512u) {
                unsigned* rdy = (unsigned*)(F.ctl + CW_RDY) + 64 * (((idx >> 2) & 7) * 16 + (idx >> 5)); sp = 0;
                while (xb_ld(rdy) < 16u) { __builtin_amdgcn_s_sleep(8); if (++sp > (1u << 24)) break; }
                __builtin_amdgcn_fence(__ATOMIC_ACQUIRE, "agent");
                asm volatile("s_waitcnt vmcnt(0)" ::: "memory");
            }
            F.MISC[0] = idx;
        }
        __syncthreads();
        const unsigned idx = (unsigned)__builtin_amdgcn_readfirstlane((int)F.MISC[0]);
        if (idx >= 512u) break;
        const int pm = (int)(((idx >> 2) & 7) * 16 + (idx >> 5));
        SchedList3 S{ws, pm, (int)(idx & 3), 1, 0x2}; Epi3 E{F.out, ws, rstd0};
        pg::gemm_phase(F.lds, F.wave_s, D, S, E);
        if (fresh_tid_w(F.wave_s) == 0) { __builtin_amdgcn_fence(__ATOMIC_RELEASE, "agent"); asm volatile("s_waitcnt vmcnt(0)" ::: "memory"); xb_add((unsigned*)(F.ctl + CW_MRG) + 64 * pm, 1u); }
    }
}
__device__ __forceinline__ void p4_queue(Frame& F) {
    unsigned char* ws = F.ws;
    int qi = 0;
    for (;;) {
        if (fresh_tid_w(F.wave_s) == 0) {
            unsigned got = 0xFFFFFFFFu;
            while (qi < 8) { const unsigned x = (unsigned)((F.bx + qi) & 7); const unsigned idx = xb_add((unsigned*)(F.ctl + CW_P4Q) + 32 * x, 1u); if (idx < 64u) { got = x * 64u + idx; break; } ++qi; }
            if (got != 0xFFFFFFFFu) {
                unsigned* m = (unsigned*)(F.ctl + CW_MRG) + 64 * (16 * (got >> 6) + ((got & 63u) >> 2)); unsigned sp = 0;
                while (xb_ld(m) < 4u) { __builtin_amdgcn_s_sleep(8); if (++sp > (1u << 24)) break; }
                __builtin_amdgcn_fence(__ATOMIC_ACQUIRE, "agent");
                asm volatile("s_waitcnt vmcnt(0)" ::: "memory");
            }
            F.MISC[0] = got;
        }
        __syncthreads();
        const unsigned got = (unsigned)__builtin_amdgcn_readfirstlane((int)F.MISC[0]);
        if (got == 0xFFFFFFFFu) break;
        SchedOne S{(const char*)ws + WS_R, (const char*)ws + WS_WOUT, (int)(16 * (got >> 6) + ((got & 63u) >> 2)), (int)(got & 3u), D}; Epi4 E{ws, F.in[IN_X_P], F.in[IN_X_S]};
        pg::gemm_phase(F.lds, F.wave_s, D, S, E);
    }
}
__global__ void __launch_bounds__(NWAVES * 64, 2) mk_fwd(Args args) {
    extern __shared__ __attribute__((aligned(16))) unsigned char lds[];
    Frame F;
    F.lds = (LAS unsigned char*)lds; F.MISC = (volatile LAS unsigned*)(F.lds + MISC_OFF);
    F.wave_s = __builtin_amdgcn_readfirstlane((int)threadIdx.x >> 6);
    F.G = gridDim.x; F.bx = blockIdx.x; F.in = args.in; F.out = args.out; F.ws = args.ws;
    F.ctl = (gu32*)(args.ws + WS_CTL);
    for (int u = fresh_tid_w(F.wave_s); u < (LDS_BYTES - LDSCTL_OFF) / 4; u += NWAVES * 64) ((LAS unsigned*)(F.lds + LDSCTL_OFF))[u] = 0u;
    __syncthreads();
    XcdBarrier bar; bar.bar = (unsigned*)(F.ctl + CW_BAR); bar.x = 0; bar.st = nullptr;
    const int lo = args.ph_lo, hi = args.ph_hi;
    if (hi - lo > 1) bar = xcd_barrier_post((unsigned*)(F.ctl + CW_BAR), F.MISC + 8, F.wave_s);
#define IN(k) (lo <= (k) && (k) < hi)
#define SEAM(k) do { if (IN(k) && IN((k) + 1)) xcd_barrier(bar, F.wave_s); } while (0)
    unsigned char* ws = args.ws;
    const float* rstd0 = (const float*)(ws + WS_RSTD0);
#define REPS(k) _Pragma("unroll") for (int _r = (PROBE_PHASE == (k)) ? 0 : 1; _r < 2; ++_r)
    if (IN(0)) { REPS(0) { p0_prologue(F); asm volatile("s_waitcnt vmcnt(0)" ::: "memory"); __syncthreads(); } SEAM(0); }
    if (IN(1)) {
        REPS(1) {
        Sched1 S; S.o.init(NMT, 33, F.G, F.bx); S.A = (const char*)ws + WS_XH; S.B = (const char*)ws + WS_W1T;
        Epi1 E{F.out, ws, rstd0, F.in[IN_CONVW], F.lds + RING_BYTES};
        pg::gemm_phase<Sched1, Epi1, true>(F.lds, F.wave_s, D, S, E);
        { constexpr int NLAST = NMT * 33 - 16 * 256;
          if (_r == 1 && F.bx >= NLAST) p0_deferred(F, F.bx - NLAST, 256 - NLAST); } }
        SEAM(1);
    }
    if (IN(2)) {
        REPS(2) {
        scan_head_v2(F, F.bx, _r == 0);
        if (F.bx < 128 && _r == 1) merge_queue(F, rstd0, true);
        if (F.bx >= 128 && _r == 1) {
            const int c = F.bx - 128;
            conv_pass(F, c, F.G - 128);
            sub_barrier((unsigned*)(F.ctl + CW_SUB), (unsigned)(F.G - 128), F.wave_s);
            if (c < 4) {
                unsigned* c4 = (unsigned*)(F.ctl + CW_SUB + 64);
                { SchedList3 S{ws, NMT - 1, c, 4, 0x2310}; Epi3 E{F.out, ws, rstd0}; pg::gemm_phase(F.lds, F.wave_s, D, S, E); }
                sub_barrier(c4, 4u, F.wave_s);
                { SchedOne S{(const char*)ws + WS_R, (const char*)ws + WS_WOUT, NMT - 1, c, D}; Epi4 E{ws, F.in[IN_X_P], F.in[IN_X_S]}; pg::gemm_phase(F.lds, F.wave_s, D, S, E); }
                sub_barrier(c4, 8u, F.wave_s);
                { SchedOne S{(const char*)ws + WS_K, (const char*)ws + WS_WGATE, NMT - 1, c, D}; Epi5a E{ws}; pg::gemm_phase(F.lds, F.wave_s, D, S, E); }
                asm volatile("s_waitcnt vmcnt(0)" ::: "memory"); __syncthreads();
                { SchedOne S{(const char*)ws + WS_PH, (const char*)ws + WS_WPLE, NMT - 1, c, PLE}; Epi5b E{F.out, ws, F.in[IN_GFINAL], F.ctl, F.lds + RING_BYTES}; pg::gemm_phase(F.lds, F.wave_s, PLE, S, E); }
            }
            { SchedH S; S.o.init(NMT - 1, 4, 1, 0); S.ws = ws; S.c = c;
              Epi3 E{F.out, ws, rstd0};
              pg::gemm_phase(F.lds, F.wave_s, D, S, E); }
            sub_barrier((unsigned*)(F.ctl + CW_SUB), 2u * (unsigned)(F.G - 128), F.wave_s);
            merge_queue(F, rstd0, false);
        } }
        if (!(IN(4))) SEAM(2);
    }
    if (IN(4)) {
        p4_queue(F);
        SEAM(4);
    }
    if (IN(5)) {
        REPS(5) { Sched4 S; S.o.init(NMT - 1, 4, F.G, F.bx); S.A = (const char*)ws + WS_K; S.B = (const char*)ws + WS_WGATE;
          Epi5a E{ws}; pg::gemm_phase(F.lds, F.wave_s, D, S, E); }
        asm volatile("s_waitcnt vmcnt(0)" ::: "memory"); __syncthreads();
        { Sched5b S; S.o.init(NMT - 1, 4, F.G, F.bx); S.A = (const char*)ws + WS_PH; S.B = (const char*)ws + WS_WPLE;
          Epi5b E{F.out, ws, F.in[IN_GFINAL], F.ctl, F.lds + RING_BYTES}; pg::gemm_phase(F.lds, F.wave_s, PLE, S, E); }
    }
#undef REPS
#undef IN
#undef SEAM
}

extern "C" void kernel_launch(void* const* d_in, const int* in_sizes, int n_in, void* d_out, int out_size, void* d_ws, size_t ws_size, hipStream_t stream) {
    static int grid = 0;
    if (grid == 0) {
        if (n_in != 27 || ws_size < WS_END) { fprintf(stderr, "kernel_launch: unexpected shapes (n_in %d, ws %zu)\n", n_in, ws_size); grid = -1; return; }
        int dev = 0, cus = 0;
        if (hipGetDevice(&dev) != hipSuccess || hipDeviceGetAttribute(&cus, hipDeviceAttributeMultiprocessorCount, dev) != hipSuccess) { grid = -1; return; }
        if (hipFuncSetAttribute((const void*)mk_fwd, hipFuncAttributeMaxDynamicSharedMemorySize, LDS_BYTES) != hipSuccess) { fprintf(stderr, "kernel_launch: hipFuncSetAttribute failed\n"); grid = -1; return; }
        int per_cu = 0;
        if (hipOccupancyMaxActiveBlocksPerMultiprocessor(&per_cu, (const void*)mk_fwd, NWAVES * 64, LDS_BYTES) != hipSuccess || per_cu < 1) { fprintf(stderr, "kernel_launch: occupancy query says %d\n", per_cu); }
        (void)hipGetLastError();
        if (cus < 256) { fprintf(stderr, "kernel_launch: needs 256 CUs, got %d\n", cus); grid = -1; return; }
        grid = 256;
    }
    if (grid < 0) return;
    (void)hipMemsetAsync((char*)d_ws + WS_CTL, 0, CTL_ZERO_BYTES, stream);
    Args a{};
    for (int i = 0; i < 27; ++i) a.in[i] = (const float*)d_in[i];
    a.out = (float*)d_out; a.ws = (unsigned char*)d_ws;
    if (MK_N_LAUNCHES == 1) { a.ph_lo = 0; a.ph_hi = N_PHASES; a.li = PROBE_PHASE; hipLaunchKernelGGL(mk_fwd, dim3(grid), dim3(NWAVES * 64), LDS_BYTES, stream, a); }
    else for (int li = 0; li < N_PHASES; ++li) { a.ph_lo = li; a.ph_hi = li + 1; a.li = PROBE_PHASE; hipLaunchKernelGGL(mk_fwd, dim3(grid), dim3(NWAVES * 64), LDS_BYTES, stream, a); }
}
```

```cpp
#include <hip/hip_runtime.h>
#include <cstdio>
#include <cstdint>

#ifndef MK_N_LAUNCHES
#define MK_N_LAUNCHES 1
#endif

#ifndef PROBE_PHASE
#define PROBE_PHASE -1
#endif
#define LAS __attribute__((address_space(3)))
#define GAS __attribute__((address_space(1)))
typedef _Float16 h16;
typedef _Float16 h16x8 __attribute__((ext_vector_type(8)));
typedef _Float16 h16x4 __attribute__((ext_vector_type(4)));
typedef float f32x4 __attribute__((ext_vector_type(4)));
typedef float f32x2 __attribute__((ext_vector_type(2)));
typedef unsigned u32x4 __attribute__((ext_vector_type(4)));
typedef GAS unsigned gu32;

constexpr int D = 1024, NP = 32768, NS = 128, MREAL = NP + NS, MP = 33024, NMT = MP / 256;
constexpr int SEQ = 4096, DSEQ = 16, NH = 16, HD = 64, PLE = 256;
constexpr int SHIFT_COLS = 4224, IN_COLS = 10368;
constexpr int W1_ROWS = 8448 + 2048;
constexpr float EPS = 1e-6f, GN_EPS = 64e-5f, DECAY_SCALE = 0.60653065971f;
constexpr size_t OFF_Y = 0, OFF_WKV_P = (size_t)MREAL * D, OFF_SHIFT_P = OFF_WKV_P + 8 * 16 * 64 * 64, OFF_CONV_P = OFF_SHIFT_P + 8 * SHIFT_COLS,
                 OFF_WKV_S = OFF_CONV_P + 8 * 2 * D, OFF_SHIFT_S = OFF_WKV_S + 8 * 16 * 64 * 64, OFF_CONV_S = OFF_SHIFT_S + 8 * SHIFT_COLS;
constexpr size_t MiB = 1u << 20;
constexpr size_t WS_CTL = 0, CTL_ZERO_BYTES = 131072;
static_assert((16384 + 128 * 64) * 4 <= 131072, "control words inside the per-call memset");
constexpr size_t WS_W1T = 1 * MiB, WS_WOA = 22 * MiB, WS_WOB = 24 * MiB, WS_WOUT = 26 * MiB, WS_WGATE = 28 * MiB, WS_WPLE = 30 * MiB;
constexpr size_t WS_W2T = 30 * MiB + 512 * 1024, WS_I2T = WS_W2T + 128 * 1024;
constexpr size_t WS_RSTD0 = 31 * MiB, WS_SIDE = 32 * MiB, WS_SSQ1 = 34 * MiB, WS_XCH = 37 * MiB;
constexpr size_t WS_XH = 40 * MiB, WS_PH = 105 * MiB, WS_R = 122 * MiB, WS_K = 187 * MiB, WS_V = 252 * MiB, WS_Z = 317 * MiB, WS_WA = 382 * MiB, WS_ACTB = 391 * MiB, WS_SIDEU = 456 * MiB, WS_SIDEP = 457 * MiB, WS_SIDEG = 458 * MiB, WS_END = 459 * MiB;
constexpr size_t SIDE_STRIDE = 256 * 1024;
constexpr int CW_BAR = 1024, CW_SUB = 512, CW_PANEL = 5120, CW_RDY = 16384, CW_MQ = 640, CW_P4Q = 768, CW_MRG = 24576;

constexpr int NWAVES = 8;
constexpr int RING_BYTES = 131072, SCAN_LDS_BYTES = 163072, LDSCTL_OFF = SCAN_LDS_BYTES, MISC_OFF = LDSCTL_OFF + 320, LDS_BYTES = 163840;

__device__ __forceinline__ int fresh_tid_w(int wave_s) { int lane; asm volatile("v_mbcnt_lo_u32_b32 %0, -1, 0\n\tv_mbcnt_hi_u32_b32 %0, -1, %0" : "=v"(lane)); return (wave_s << 6) | lane; }
__device__ __forceinline__ float fsigmoid(float x) { return __builtin_amdgcn_rcpf(1.0f + __expf(-x)); }
__device__ __forceinline__ float fsilu(float x) { return x * fsigmoid(x); }
__device__ __forceinline__ float ftanh(float x) { return 1.0f - 2.0f * __builtin_amdgcn_rcpf(__expf(2.0f * x) + 1.0f); }
__device__ __forceinline__ h16x4 cvt4(f32x4 v) { return __builtin_convertvector(v, h16x4); }
__device__ __forceinline__ h16x8 cvt8(f32x4 a, f32x4 b) { h16x4 x = cvt4(a), y = cvt4(b); return __builtin_shufflevector(x, y, 0, 1, 2, 3, 4, 5, 6, 7); }
__device__ __forceinline__ f32x4 up4(h16x4 v) { return __builtin_convertvector(v, f32x4); }

namespace pg {
constexpr int BM = 256, BK = 64, HALF = 128, HTB = HALF * BK * 2, NXCD = 8, WGM = 8;
__host__ __device__ __forceinline__ int lds_byte(int r, int c) { const int st = (r >> 4) * 2 + (c >> 5), rr = r & 15, cc = c & 31, ob = rr * 64 + cc * 2; return st * 1024 + (ob ^ (((ob >> 9) & 1) << 5)); }
__host__ __device__ __forceinline__ void stage_rc(int b, int& R, int& C) { const int st = b / 1024, sb = b % 1024, swz = sb ^ (((sb >> 9) & 1) << 5); R = (st >> 1) * 16 + swz / 64; C = (st & 1) * 32 + (swz % 64) / 2; }
__host__ __device__ __forceinline__ int perm32(int rho) { const int n = rho >> 4, i = rho & 15; return 8 * (i >> 2) + 4 * n + (i & 3); }

struct Unit { int pm, pn, kind; const char* A; const char* B; };

struct TileOrder {
    int nM, nN, nwg, G, c;
    __device__ void init(int nM_, int nN_, int G_, int c_) { nM = nM_; nN = nN_; nwg = nM * nN; G = G_; c = c_; }
    __device__ bool get(int i, int& pm, int& pn) const { return get_linear((long)i * G + c, pm, pn); }
    __device__ bool get_linear(long L, int& pm, int& pn) const {
        if (L >= nwg) return false;
        int wgid = (int)L; { const int q = nwg / NXCD, r = nwg % NXCD, xcd = wgid % NXCD, off = wgid / NXCD; wgid = (xcd < r ? xcd * (q + 1) : r * (q + 1) + (xcd - r) * q) + off; }
        const int nig = WGM * nN, gid = wgid / nig, fm = gid * WGM, gsz = (nM - fm) < WGM ? (nM - fm) : WGM;
        pm = fm + ((wgid % nig) % gsz); pn = (wgid % nig) / gsz; return true;
    }
};

template <class Sched, class Epi, bool APERM = false>
__device__ __forceinline__ void gemm_phase(LAS unsigned char* lds, const int wave_s, const int K, const Sched& S, const Epi& E) {
    const int tid = fresh_tid_w(wave_s), wid = wave_s, lane = tid & 63, wr = wid >> 2, wc = wid & 3, fr = lane & 15, fq = lane >> 4;
    const int nt = K / BK;
    unsigned voffA[2], voffB[2];
#pragma unroll
    for (int i = 0; i < 2; ++i) { int R, C; stage_rc(tid * 16 + i * 8192, R, C); const int Rb = (R & ~31) + perm32(R & 31);
        const int Ra = APERM ? (R & ~63) + 4 * (R & 15) + ((R & 63) >> 4) : R;
        voffA[i] = (unsigned)(Ra * K + C) * 2u; voffB[i] = (unsigned)(Rb * K + C) * 2u; }
    const size_t kstep = (size_t)(BK * 2);
    const size_t hstep = (size_t)HALF * K * 2;
    const unsigned ldsw = (unsigned)wid * 1024u;
    const int aoff = lds_byte(wr * 64 + fr, fq * 8), boff = lds_byte(wc * 32 + fr, fq * 8);
#define PG_SA(b, h) (((b) * 2 + (h)) * HTB)
#define PG_SB(b, h) ((4 + (b) * 2 + (h)) * HTB)
#define PG_STAGE(bufoff, gbase, voff) do { _Pragma("unroll") for (int _i = 0; _i < 2; ++_i) \
        __builtin_amdgcn_global_load_lds((const unsigned*)((const char*)(gbase) + (voff)[_i]), (LAS unsigned*)(lds + (bufoff) + ldsw + _i * 8192), 16, 0, 0); } while (0)
#define PG_LDA(dst, b, h) do { _Pragma("unroll") for (int m = 0; m < 4; ++m) _Pragma("unroll") for (int k = 0; k < 2; ++k) dst[m][k] = *(const LAS h16x8*)(lds + PG_SA(b, h) + aoff + m * 2048 + k * 1024); } while (0)
#define PG_LDB(dst, b, h) do { _Pragma("unroll") for (int n = 0; n < 2; ++n) _Pragma("unroll") for (int k = 0; k < 2; ++k) dst[n][k] = *(const LAS h16x8*)(lds + PG_SB(b, h) + boff + n * 2048 + k * 1024); } while (0)
#define PG_MMA(ai, bj, At, Bt) do { __builtin_amdgcn_s_setprio(1); _Pragma("unroll") for (int m = 0; m < 4; ++m) _Pragma("unroll") for (int n = 0; n < 2; ++n) _Pragma("unroll") for (int k = 0; k < 2; ++k) \
        acc[ai][bj][m][n] = __builtin_amdgcn_mfma_f32_16x16x32_f16(Bt[n][k], At[m][k], acc[ai][bj][m][n], 0, 0, 0); __builtin_amdgcn_s_setprio(0); } while (0)
#define PG_WAIT_V(n) asm volatile("s_waitcnt vmcnt(" #n ")" ::: "memory")
#define PG_WAIT_L(n) asm volatile("s_waitcnt lgkmcnt(" #n ")" ::: "memory")
#define PG_BAR __builtin_amdgcn_s_barrier()
#define PG_SCHED __builtin_amdgcn_sched_barrier(0)
    Unit cur, nxt; int ui = 0;
    if (!S.next(0, cur)) return;
    f32x4 acc[2][2][4][2];
#pragma unroll
    for (int a = 0; a < 2; ++a)
#pragma unroll
        for (int b = 0; b < 2; ++b)
#pragma unroll
            for (int m = 0; m < 4; ++m)
#pragma unroll
                for (int n = 0; n < 2; ++n) acc[a][b][m][n] = (f32x4){0.f, 0.f, 0.f, 0.f};
    h16x8 At[4][2], B0[2][2], B1[2][2];
    const char* cA = cur.A; const char* cB = cur.B;
    PG_STAGE(PG_SB(0, 0), cB, voffB); PG_STAGE(PG_SB(0, 1), cB + hstep, voffB); PG_STAGE(PG_SA(0, 0), cA, voffA); PG_STAGE(PG_SA(0, 1), cA + hstep, voffA);
    PG_STAGE(PG_SB(1, 0), cB + kstep, voffB); PG_STAGE(PG_SA(1, 0), cA + kstep, voffA); PG_STAGE(PG_SB(1, 1), cB + hstep + kstep, voffB);
    if (wr == 1) PG_BAR;
    PG_WAIT_V(8); PG_BAR;
    PG_WAIT_V(6); PG_BAR;
    for (;;) {
        const bool has_next = S.next(ui + 1, nxt);
        const char* nA = has_next ? nxt.A : cA; const char* nB = has_next ? nxt.B : cB;
        for (int t = 0; t < nt; t += 2) {
            const bool last = (t == nt - 2);
            const char* a1 = cA + (size_t)(t + 1) * kstep;
            const char* a2 = last ? nA : cA + (size_t)(t + 2) * kstep; const char* b2 = last ? nB : cB + (size_t)(t + 2) * kstep;
            const char* a3 = a2 + kstep; const char* b3 = b2 + kstep;
            PG_LDB(B0, 0, 0); PG_LDB(B1, 0, 1); PG_SCHED; PG_LDA(At, 0, 0); PG_STAGE(PG_SA(1, 1), a1 + hstep, voffA);
            PG_WAIT_V(8); PG_WAIT_L(0); PG_BAR; PG_MMA(0, 0, At, B0); PG_MMA(0, 1, At, B1); PG_BAR; PG_SCHED;
            PG_LDA(At, 0, 1); PG_STAGE(PG_SB(0, 0), b2, voffB); PG_STAGE(PG_SB(0, 1), b2 + hstep, voffB); PG_STAGE(PG_SA(0, 0), a2, voffA);
            PG_WAIT_V(8); PG_WAIT_L(0); PG_BAR; PG_MMA(1, 0, At, B0); PG_MMA(1, 1, At, B1); PG_BAR; PG_SCHED;
            PG_LDB(B0, 1, 0); PG_LDB(B1, 1, 1); PG_SCHED; PG_LDA(At, 1, 0); PG_STAGE(PG_SA(0, 1), a2 + hstep, voffA);
            PG_WAIT_V(8); PG_WAIT_L(0); PG_BAR; PG_MMA(0, 0, At, B0); PG_MMA(0, 1, At, B1); PG_BAR; PG_SCHED;
            PG_LDA(At, 1, 1); PG_STAGE(PG_SB(1, 0), b3, voffB); PG_STAGE(PG_SB(1, 1), b3 + hstep, voffB); PG_STAGE(PG_SA(1, 0), a3, voffA);
            PG_WAIT_V(8); PG_WAIT_L(0); PG_BAR; PG_MMA(1, 0, At, B0); PG_MMA(1, 1, At, B1); PG_BAR; PG_SCHED;
        }
        if (wr == 0) PG_BAR;
        E(acc, cur, wr, wc, fr, fq);
        if (!has_next) break;
#pragma unroll
        for (int a = 0; a < 2; ++a)
#pragma unroll
            for (int b = 0; b < 2; ++b)
#pragma unroll
                for (int m = 0; m < 4; ++m)
#pragma unroll
                    for (int n = 0; n < 2; ++n) acc[a][b][m][n] = (f32x4){0.f, 0.f, 0.f, 0.f};
        cur = nxt; cA = nA; cB = nB; ++ui;
        if (wr == 1) PG_BAR;
    }
    PG_WAIT_V(0);
    PG_BAR;
#undef PG_SA
#undef PG_SB
#undef PG_STAGE
#undef PG_LDA
#undef PG_LDB
#undef PG_MMA
#undef PG_WAIT_V
#undef PG_WAIT_L
#undef PG_BAR
#undef PG_SCHED
}
}

#define XB_TMO      128
#define XB_XCNT(j)  (256  + 64 * (j))
#define XB_XSUB(j)  (1280 + 64 * (j))
#define XB_XGEN(j)  (2304 + 64 * (j))
#define XB_TOP      3328
#define XB_TOPGEN   3392
#define XCD_BAR_WORDS 3456
#define XB_SPIN_CAP (1u << 22)
__device__ __forceinline__ unsigned xb_ld(unsigned* p)              { return __hip_atomic_load(p, __ATOMIC_RELAXED, __HIP_MEMORY_SCOPE_AGENT); }
__device__ __forceinline__ unsigned xb_add(unsigned* p, unsigned v) { return __hip_atomic_fetch_add(p, v, __ATOMIC_RELAXED, __HIP_MEMORY_SCOPE_AGENT); }
__device__ __forceinline__ unsigned xb_xcc_id() { return (unsigned)__builtin_amdgcn_s_getreg((3 << 11) | 20) & 0xFu; }
#define XB_SPIN(cond, bar) do { unsigned _sp = 0; while (cond) { __builtin_amdgcn_s_sleep(1); \
    if ((++_sp & 255u) == 0u) { if (xb_ld(&(bar)[XB_TMO])) break; if (_sp > XB_SPIN_CAP) { atomicAdd(&(bar)[XB_TMO], 1u); break; } } } } while (0)
struct XcdBarrier { unsigned* bar; unsigned x; volatile LAS unsigned* st; };
__device__ __forceinline__ XcdBarrier xcd_barrier_post(unsigned* bar, volatile LAS unsigned* st, int wave_s) {
    XcdBarrier b; b.bar = bar; b.x = xb_xcc_id(); b.st = st;
    if (fresh_tid_w(wave_s) == 0) (void)xb_add(&bar[XB_XCNT(b.x)], 1u);
    return b;
}
__device__ __forceinline__ void xcd_barrier_complete(unsigned* bar, unsigned x, unsigned& nloc, unsigned& nx) {
    const unsigned G = gridDim.x * gridDim.y * gridDim.z;
    unsigned sum, cnt, mine, sp = 0u;
    for (;;) {
        sum = 0u; cnt = 0u; mine = 0u;
#pragma unroll
        for (unsigned j = 0; j < 16; ++j) { const unsigned c = xb_ld(&bar[XB_XCNT(j)]); sum += c; cnt += (c > 0u) ? 1u : 0u; mine = (j == x) ? c : mine; }
        if (sum == G) break;
        __builtin_amdgcn_s_sleep(1);
        if ((++sp & 255u) == 0u) { if (xb_ld(&bar[XB_TMO])) break; if (sp > XB_SPIN_CAP) { atomicAdd(&bar[XB_TMO], 1u); break; } }
    }
    nloc = mine > 0u ? mine : 1u; nx = cnt > 0u ? cnt : 1u;
}
__device__ __forceinline__ void xcd_barrier(const XcdBarrier& b, int wave_s) {
    asm volatile("s_waitcnt vmcnt(0)" ::: "memory");
    __syncthreads();
    if (fresh_tid_w(wave_s) == 0) {
        unsigned* bar = b.bar;
        __builtin_amdgcn_s_waitcnt(0);
        unsigned nloc = b.st[0], nx = b.st[1];
        if (nloc == 0u) { xcd_barrier_complete(bar, b.x, nloc, nx); b.st[0] = nloc; b.st[1] = nx; }
        const unsigned old = xb_add(&bar[XB_XSUB(b.x)], 1u);
        const unsigned gen = old / nloc;
        if (old + 1u == (gen + 1u) * nloc) {
            __builtin_amdgcn_fence(__ATOMIC_RELEASE, "agent");
            asm volatile("s_waitcnt vmcnt(0)" ::: "memory");
            const unsigned og = xb_add(&bar[XB_TOP], 1u);
            const unsigned tg = og / nx;
            if (og + 1u == (tg + 1u) * nx) xb_add(&bar[XB_TOPGEN], 1u);
            else XB_SPIN(xb_ld(&bar[XB_TOPGEN]) == tg, bar);
            __builtin_amdgcn_fence(__ATOMIC_ACQUIRE, "agent");
            xb_add(&bar[XB_XGEN(b.x)], 1u);
            asm volatile("s_waitcnt vmcnt(0)" ::: "memory");
        } else {
            XB_SPIN(xb_ld(&bar[XB_XGEN(b.x)]) == gen, bar);
            __builtin_amdgcn_fence(__ATOMIC_ACQUIRE, "agent");
            asm volatile("s_waitcnt vmcnt(0)" ::: "memory");
        }
    }
    __syncthreads();
}

struct Args { const float* in[27]; float* out; unsigned char* ws; int ph_lo, ph_hi, li, pad; };
struct Frame {
    LAS unsigned char* lds; volatile LAS unsigned* MISC; gu32* ctl;
    int G, bx, wave_s;
    const float* const* in; float* out; unsigned char* ws;
};
#define IN_X_P 0
#define IN_X_S 1
#define IN_ST_WKV 2
#define IN_ST_SHIFT 3
#define IN_ST_CONV 4
#define IN_P_P 5
#define IN_P_S 6
#define IN_G_NORM 7
#define IN_W_IN 8
#define IN_MU 9
#define IN_WDEC0 10
#define IN_WDEC2 11
#define IN_WICL0 12
#define IN_WICL2 13
#define IN_KREM 14
#define IN_KREP 15
#define IN_RBONUS 16
#define IN_GNW 17
#define IN_GNB 18
#define IN_CONVW 19
#define IN_WOA 20
#define IN_WOB 21
#define IN_WOUT 22
#define IN_GPLE 23
#define IN_WPLEG 24
#define IN_WPLE 25
#define IN_GFINAL 26

__device__ __forceinline__ float wave_sum(float v) {
#pragma unroll
    for (int o = 1; o < 64; o <<= 1) v += __shfl_xor(v, o);
    return v;
}
__device__ __forceinline__ h16* rowptr16(float* out, unsigned char* ws, int slot, int row) {
    return row < NP ? (h16*)out + (size_t)slot * NP * D + (size_t)row * D : (h16*)(ws + WS_SIDE) + (size_t)slot * SIDE_STRIDE + (size_t)(row - NP) * D;
}

__device__ __forceinline__ int w1_src_col(int n) {
    const int tile = n >> 8, c = n & 255;
    if (tile < 16) { const int plane = tile >> 2; return (plane == 3 ? 3200 : plane * 1024) + (tile & 3) * 256 + c; }
    if (tile == 16) return c < 128 ? 3072 + c : -1;
    if (tile < 33) { const int tb = tile - 17, kind = 2 * (c >> 7) + ((c >> 2) & 1), ch = 64 * tb + 16 * ((c >> 5) & 3) + 4 * ((c >> 3) & 3) + (c & 3); return SHIFT_COLS + kind * 1024 + ch; }
    return SHIFT_COLS + 4096 + (n - 8448);
}
template <bool MAP>
__device__ __forceinline__ void p0_transpose_item(const float* W, int Nsrc, int K, h16* WT, const float* kscale, LAS float* scr, int kb, int nb, int lane) {
    const int k0 = 64 * kb, n0 = 32 * nb, n4 = (lane & 7) * 4;
    const int src = MAP ? w1_src_col(n0 + n4) : n0 + n4;
    f32x4 v[8];
#pragma unroll
    for (int i = 0; i < 8; ++i) { const int kk = 8 * i + (lane >> 3); v[i] = (f32x4){0.f, 0.f, 0.f, 0.f}; if (src >= 0) { v[i] = *(const f32x4*)(W + (size_t)(k0 + kk) * Nsrc + src); if (kscale) v[i] = v[i] * kscale[k0 + kk]; } }
#pragma unroll
    for (int i = 0; i < 8; ++i) { const int kk = 8 * i + (lane >> 3); LAS float* d = scr + kk * 33 + n4; d[0] = v[i].x; d[1] = v[i].y; d[2] = v[i].z; d[3] = v[i].w; }
    asm volatile("s_waitcnt lgkmcnt(0)" ::: "memory");
    const int c = lane & 7;
#pragma unroll
    for (int j = 0; j < 4; ++j) { const int nn = (lane >> 3) + 8 * j; const LAS float* s = scr + (8 * c) * 33 + nn;
        h16x8 o;
#pragma unroll
        for (int e = 0; e < 8; ++e) o[e] = (h16)s[e * 33];
        *(h16x8*)(WT + (size_t)(n0 + nn) * K + k0 + 8 * c) = o; }
    asm volatile("s_waitcnt lgkmcnt(0)" ::: "memory");
}
__device__ __forceinline__ void p0_prologue(Frame& F) {
    const int tid_ = fresh_tid_w(F.wave_s), lane_ = tid_ & 63, wave_ = F.wave_s;
    LAS float* scr = (LAS float*)(F.lds + wave_ * 16384);
    const int gw = F.bx * NWAVES + wave_, NGW = F.G * NWAVES;
    unsigned char* ws = F.ws;
    constexpr int I_W1 = (D / 64) * (W1_ROWS / 32), I_SQ = (D / 64) * (D / 32), I_PLE = (PLE / 64) * (D / 32);
    constexpr int NITEMS = I_W1 + 4 * I_SQ + I_PLE;
    for (int it = gw; it < I_W1; it += NGW)
        p0_transpose_item<true>(F.in[IN_W_IN], IN_COLS, D, (h16*)(ws + WS_W1T), F.in[IN_G_NORM], scr, it / (W1_ROWS / 32), it % (W1_ROWS / 32), lane_);
    (void)NITEMS;
    for (int i = F.bx * 512 + tid_; i < 65536; i += F.G * 512) { const int n = i >> 6, j = i & 63;
        ((h16*)(ws + WS_W2T))[i] = (h16)(-1.4426950408889634f * F.in[IN_WDEC2][(size_t)j * D + n]); ((h16*)(ws + WS_I2T))[i] = (h16)(-1.4426950408889634f * F.in[IN_WICL2][(size_t)j * D + n]); }
    h16* XH = (h16*)(ws + WS_XH); float* rstd0 = (float*)(ws + WS_RSTD0);
    for (int m0 = 4 * gw; m0 < MP; m0 += 4 * NGW) {
        f32x4 v[4][4]; float s[4];
#pragma unroll
        for (int r = 0; r < 4; ++r) { const int m = m0 + r;
            if (m < MREAL) {
                const float* xrow = m < NP ? F.in[IN_X_P] + (size_t)m * D : F.in[IN_X_S] + (size_t)(m - NP) * D;
#pragma unroll
                for (int j = 0; j < 4; ++j) v[r][j] = __builtin_nontemporal_load((const f32x4*)xrow + lane_ + 64 * j);
            } else {
#pragma unroll
                for (int j = 0; j < 4; ++j) v[r][j] = (f32x4){0.f, 0.f, 0.f, 0.f};
            } }
#pragma unroll
        for (int r = 0; r < 4; ++r) { float t = 0.f;
#pragma unroll
            for (int j = 0; j < 4; ++j) t += (v[r][j].x * v[r][j].x + v[r][j].y * v[r][j].y) + (v[r][j].z * v[r][j].z + v[r][j].w * v[r][j].w);
            s[r] = wave_sum(t); }
#pragma unroll
        for (int r = 0; r < 4; ++r) { const int m = m0 + r;
            const float ms = s[r] * (1.0f / D) + EPS, rstd = __builtin_amdgcn_rsqf(ms);
            if (lane_ == 0) rstd0[m] = m < MREAL ? ms * rstd : 0.f;
            h16x4* o = (h16x4*)(XH + (size_t)m * D) + lane_;
#pragma unroll
            for (int j = 0; j < 4; ++j) o[64 * j] = cvt4(v[r][j] * rstd); }
    }
}
__device__ __forceinline__ void p0_deferred(Frame& F, int c, int nw) {
    const int tid_ = fresh_tid_w(F.wave_s), lane_ = tid_ & 63, wave_ = F.wave_s;
    LAS float* scr = (LAS float*)(F.lds + wave_ * 16384);
    const int gw = c * NWAVES + wave_, NGW = nw * NWAVES;
    unsigned char* ws = F.ws;
    constexpr int I_SQ = (D / 64) * (D / 32), I_PLE = (PLE / 64) * (D / 32);
    for (int it = gw; it < 4 * I_SQ + I_PLE; it += NGW) {
        int r = it;
        if (r < I_SQ) { p0_transpose_item<false>(F.in[IN_WOA], D, D, (h16*)(ws + WS_WOA), nullptr, scr, r / 32, r % 32, lane_); continue; } r -= I_SQ;
        if (r < I_SQ) { p0_transpose_item<false>(F.in[IN_WOB], D, D, (h16*)(ws + WS_WOB), nullptr, scr, r / 32, r % 32, lane_); continue; } r -= I_SQ;
        if (r < I_SQ) { p0_transpose_item<false>(F.in[IN_WOUT], D, D, (h16*)(ws + WS_WOUT), nullptr, scr, r / 32, r % 32, lane_); continue; } r -= I_SQ;
        if (r < I_SQ) { p0_transpose_item<false>(F.in[IN_WPLEG], D, D, (h16*)(ws + WS_WGATE), F.in[IN_GPLE], scr, r / 32, r % 32, lane_); continue; } r -= I_SQ;
        p0_transpose_item<false>(F.in[IN_WPLE], D, PLE, (h16*)(ws + WS_WPLE), nullptr, scr, r / 32, r % 32, lane_);
    }
    h16* PH = (h16*)(ws + WS_PH);
    for (int m0 = 8 * gw; m0 < MP; m0 += 8 * NGW) {
        f32x4 pv[8];
#pragma unroll
        for (int r = 0; r < 8; ++r) { const int m = m0 + r; pv[r] = (f32x4){0.f, 0.f, 0.f, 0.f};
            if (m < MREAL) pv[r] = __builtin_nontemporal_load((const f32x4*)(m < NP ? F.in[IN_P_P] + (size_t)m * PLE : F.in[IN_P_S] + (size_t)(m - NP) * PLE) + lane_); }
#pragma unroll
        for (int r = 0; r < 8; ++r) ((h16x4*)(PH + (size_t)(m0 + r) * PLE))[lane_] = cvt4(pv[r]);
    }
    asm volatile("s_waitcnt vmcnt(0)" ::: "memory");
    __syncthreads();
}

__device__ __forceinline__ char* slotbase(float* out, unsigned char* ws, int slot, bool prompt_tile) {
    return prompt_tile ? (char*)out + (size_t)slot * NP * D * 2 : (char*)(ws + WS_SIDE) + (size_t)slot * SIDE_STRIDE * 2 - (size_t)NP * D * 2;
}
__device__ __forceinline__ float dpp_row_shr1(float x) { return __builtin_bit_cast(float, __builtin_amdgcn_update_dpp(0, __builtin_bit_cast(int, x), 0x111, 0xf, 0xf, true)); }
struct Epi1 {
    float* out; unsigned char* ws; const float* rstd0; const float* cw; LAS unsigned char* lx;
    __device__ __forceinline__ void conv_tile(const f32x4 (&acc)[2][2][4][2], const pg::Unit& u, int wr, int wc, int fr, int fq) const {
        const int ch = 64 * (u.pn - 17) + 16 * wc + 4 * fq;
        f32x4 uu[2][4], gz[2][4];
#pragma unroll
        for (int ai = 0; ai < 2; ++ai)
#pragma unroll
            for (int m = 0; m < 4; ++m) {
                const int row = u.pm * 256 + ai * 128 + wr * 64 + fr * 4 + m;
                const f32x4 gb = acc[ai][0][m][0], gc = acc[ai][0][m][1], xb = acc[ai][1][m][0], zb = acc[ai][1][m][1];
                uu[ai][m] = gc * xb;
#pragma unroll
                for (int j = 0; j < 4; ++j) gz[ai][m][j] = gb[j] * fsilu(zb[j]);
                const int t = row & (SEQ - 1);
                if (t >= SEQ - 2) *(f32x4*)(out + OFF_CONV_P + ((size_t)(row >> 12) * 2 + (t - (SEQ - 2))) * D + ch) = uu[ai][m];
            }
        LAS float* X = (LAS float*)lx;
        if (fr == 15) {
#pragma unroll
            for (int ai = 0; ai < 2; ++ai) { *(LAS f32x4*)(X + ((2 * ai + wr) * 2 + 0) * 64 + 16 * wc + 4 * fq) = uu[ai][2]; *(LAS f32x4*)(X + ((2 * ai + wr) * 2 + 1) * 64 + 16 * wc + 4 * fq) = uu[ai][3]; }
            if (wr == 1) { float* su = (float*)(ws + WS_SIDEU) + (size_t)u.pm * 2048 + ch; *(f32x4*)su = uu[1][2]; *(f32x4*)(su + 1024) = uu[1][3]; }
        }
        asm volatile("s_waitcnt lgkmcnt(0)" ::: "memory"); __builtin_amdgcn_s_barrier(); asm volatile("" ::: "memory");
        const f32x4 c0 = *(const f32x4*)(cw + ch), c1 = *(const f32x4*)(cw + D + ch), c2 = *(const f32x4*)(cw + 2 * D + ch);
        const bool first = (u.pm & 15) == 0;
#pragma unroll
        for (int ai = 0; ai < 2; ++ai) {
            f32x4 q1, q2;
#pragma unroll
            for (int j = 0; j < 4; ++j) { q1[j] = dpp_row_shr1(uu[ai][3][j]); q2[j] = dpp_row_shr1(uu[ai][2][j]); }
            const int blk = 2 * ai + wr;
            if (fr == 0) {
                if (blk > 0) { q2 = *(const LAS f32x4*)(X + ((blk - 1) * 2 + 0) * 64 + 16 * wc + 4 * fq); q1 = *(const LAS f32x4*)(X + ((blk - 1) * 2 + 1) * 64 + 16 * wc + 4 * fq); }
                else { q2 = (f32x4){0.f, 0.f, 0.f, 0.f}; q1 = q2; }
            }
#pragma unroll
            for (int m = 0; m < 4; ++m) {
                const int row = u.pm * 256 + ai * 128 + wr * 64 + fr * 4 + m;
                const f32x4 p1 = m >= 1 ? uu[ai][m - 1] : q1, p2 = m >= 2 ? uu[ai][m - 2] : (m == 1 ? q1 : q2);
                const f32x4 cv = c2 * uu[ai][m] + c1 * p1 + c0 * p2;
                if (blk == 0 && fr == 0 && m < 2 && !first) {
                    float* sp = (float*)(ws + WS_SIDEP) + (size_t)u.pm * 2048 + m * 1024 + ch; float* sg = (float*)(ws + WS_SIDEG) + (size_t)u.pm * 2048 + m * 1024 + ch;
                    *(f32x4*)sp = gz[ai][m] * cv; *(f32x4*)sg = gz[ai][m];
                } else *(h16x4*)((char*)ws + WS_ACTB + (unsigned)(row * D + ch) * 2u) = cvt4(gz[ai][m] * cv);
            }
        }
    }
    __device__ __forceinline__ void operator()(const f32x4 (&acc)[2][2][4][2], const pg::Unit& u, int wr, int wc, int fr, int fq) const {
        const int tile = u.pn; const bool ptile = u.pm < NMT - 1;
        if (tile >= 17 && ptile) { conv_tile(acc, u, wr, wc, fr, fq); return; }
        const int plane = tile >> 2;
        char* pbase = (char*)ws + (plane == 0 ? WS_R : plane == 1 ? WS_K : plane == 2 ? WS_V : WS_Z);
        char* ub = slotbase(out, ws, 0, ptile); char* gzb = slotbase(out, ws, 1, ptile);
#pragma unroll
        for (int ai = 0; ai < 2; ++ai)
#pragma unroll
            for (int m = 0; m < 4; ++m) {
                const int row = u.pm * 256 + ai * 128 + wr * 64 + fr * 4 + m;
                int endj = -1, bidx = 0; bool samp = false;
                if (row < NP) { const int t = row & (SEQ - 1); if (t >= SEQ - 2) { endj = t - (SEQ - 2); bidx = row >> 12; } }
                else if (row < MREAL) { const int rr = row - NP, t = rr & (DSEQ - 1); if (t >= DSEQ - 2) { endj = t - (DSEQ - 2); bidx = rr >> 4; samp = true; } }
                if (tile < 17) {
#pragma unroll
                    for (int bj = 0; bj < 2; ++bj) {
                        const int cl = bj * 128 + wc * 32 + 8 * fq;
                        const f32x4 v0 = acc[ai][bj][m][0], v1 = acc[ai][bj][m][1];
                        int scol;
                        if (tile < 16) { *(h16x8*)(pbase + (unsigned)(row * D + (tile & 3) * 256 + cl) * 2u) = cvt8(v0, v1); scol = (plane == 3 ? 3200 : plane * 1024) + (tile & 3) * 256 + cl; }
                        else { if (bj == 1) continue; *(h16x8*)((char*)ws + WS_WA + (unsigned)(row * 128 + cl) * 2u) = cvt8(v0, v1); scol = 3072 + cl; }
                        if (endj == 1) { float* o = out + (samp ? OFF_SHIFT_S : OFF_SHIFT_P) + (size_t)bidx * SHIFT_COLS + scol; *(f32x4*)o = v0; *(f32x4*)(o + 4) = v1; }
                    }
                } else {
                    const int ch = 64 * (tile - 17) + 16 * wc + 4 * fq;
                    const f32x4 gb = acc[ai][0][m][0], gc = acc[ai][0][m][1], xb = acc[ai][1][m][0], zb = acc[ai][1][m][1];
                    f32x4 uu = gc * xb, gz;
#pragma unroll
                    for (int j = 0; j < 4; ++j) gz[j] = gb[j] * fsilu(zb[j]);
                    const unsigned o = (unsigned)(row * D + ch) * 2u;
                    *(h16x4*)(ub + o) = cvt4(uu);
                    *(h16x4*)(gzb + o) = cvt4(gz);
                    if (endj >= 0) *(f32x4*)(out + (samp ? OFF_CONV_S : OFF_CONV_P) + ((size_t)bidx * 2 + endj) * D + ch) = uu;
                }
            }
    }
};
struct Sched1 {
    pg::TileOrder o; const char* A; const char* B;
    __device__ bool next(int i, pg::Unit& u) const { int pm, pn; if (!o.get(i, pm, pn)) return false; u.pm = pm; u.pn = pn; u.kind = 0;
        u.A = A + (size_t)pm * 256 * D * 2; u.B = B + (size_t)pn * 256 * D * 2; return true; }
};

struct Epi3 {
    float* out; unsigned char* ws; const float* rstd0;
    __device__ __forceinline__ void operator()(const f32x4 (&acc)[2][2][4][2], const pg::Unit& u, int wr, int wc, int fr, int fq) const {
        const bool ptile = u.pm < NMT - 1;
        char* ga = slotbase(out, ws, 0, ptile); char* gb = slotbase(out, ws, 1, ptile); char* mb = (char*)ws + WS_R;
#pragma unroll
        for (int ai = 0; ai < 2; ++ai)
#pragma unroll
            for (int m = 0; m < 4; ++m) {
                const int row = u.pm * 256 + ai * 128 + wr * 64 + m * 16 + fr;
#pragma unroll
                for (int bj = 0; bj < 2; ++bj) {
                    const unsigned o = (unsigned)(row * D + u.pn * 256 + bj * 128 + wc * 32 + 8 * fq) * 2u;
                    const f32x4 a0 = acc[ai][bj][m][0], a1 = acc[ai][bj][m][1];
                    if (u.kind < 2) {
                        const float rs = -1.4426950408889634f; f32x4 g0, g1;
#pragma unroll
                        for (int j = 0; j < 4; ++j) { g0[j] = __builtin_amdgcn_rcpf(1.0f + __builtin_amdgcn_exp2f(a0[j] * rs)); g1[j] = __builtin_amdgcn_rcpf(1.0f + __builtin_amdgcn_exp2f(a1[j] * rs)); }
                        *(h16x8*)((u.kind == 0 ? ga : gb) + o) = cvt8(g0, g1);
                    } else if (u.kind == 3) {
                        const h16x8 g = *(const h16x8*)(gb + o);
                        const f32x4 g0 = up4(__builtin_shufflevector(g, g, 0, 1, 2, 3)), g1 = up4(__builtin_shufflevector(g, g, 4, 5, 6, 7));
                        *(h16x8*)(gb + o) = cvt8(g0 * a0, g1 * a1);
                    } else {
                        const h16x8 g = *(const h16x8*)(ga + o), t = *(const h16x8*)(gb + o);
                        const f32x4 t0 = up4(__builtin_shufflevector(t, t, 0, 1, 2, 3)), t1 = up4(__builtin_shufflevector(t, t, 4, 5, 6, 7));
                        const f32x4 g0 = up4(__builtin_shufflevector(g, g, 0, 1, 2, 3)), g1 = up4(__builtin_shufflevector(g, g, 4, 5, 6, 7));
                        { const u32x4 mv = __builtin_bit_cast(u32x4, cvt8(t0 + g0 * a0, t1 + g1 * a1)); char* mp = mb + o;
                          asm volatile("global_store_dwordx4 %0, %1, off sc1\n\ts_nop 1" :: "v"(mp), "v"(mv) : "memory"); }
                    }
                }
            }
    }
};
struct Sched3 {
    pg::TileOrder o; unsigned char* ws; int nk; int kinds;
    __device__ bool next(int i, pg::Unit& u) const { int pm, pn; const int q = i / nk, kind = (kinds >> (4 * (i - q * nk))) & 15; if (!o.get(q, pm, pn)) return false; u.pm = pm; u.pn = pn; u.kind = kind;
        const size_t aoff = kind < 2 ? WS_XH : kind == 2 ? WS_Z : WS_ACTB;
        const size_t boff = kind == 0 ? WS_W1T + (size_t)8448 * D * 2 : kind == 1 ? WS_W1T + (size_t)(8448 + 1024) * D * 2 : kind == 2 ? WS_WOA : WS_WOB;
        u.A = (const char*)ws + aoff + (size_t)pm * 256 * D * 2; u.B = (const char*)ws + boff + (size_t)pn * 256 * D * 2; return true; }
};
__device__ __forceinline__ void unit3(pg::Unit& u, unsigned char* ws, int pm, int pn, int kind) {
    u.pm = pm; u.pn = pn; u.kind = kind;
    const size_t aoff = kind < 2 ? WS_XH : kind == 2 ? WS_Z : WS_ACTB;
    const size_t boff = kind == 0 ? WS_W1T + (size_t)8448 * D * 2 : kind == 1 ? WS_W1T + (size_t)(8448 + 1024) * D * 2 : kind == 2 ? WS_WOA : WS_WOB;
    u.A = (const char*)ws + aoff + (size_t)pm * 256 * D * 2; u.B = (const char*)ws + boff + (size_t)pn * 256 * D * 2;
}
struct SchedH {
    pg::TileOrder o; unsigned char* ws; int c;
    __device__ bool next(int i, pg::Unit& u) const {
        const int nreg = c < 4 ? 2 : 4; int q, kind;
        if (i < 3 * nreg) { const int r = i / 3, kk = i - 3 * r; q = c + 128 * r; kind = kk == 2 ? 3 : kk; }
        else { const int e = i - 3 * nreg;
            if (c >= 4 && c < 12 && e == 0) { const int ob = c - 4; q = (ob & 3) + 128 * (2 + (ob >> 2)); kind = 0; }
            else if (c >= 12 && c < 20 && e < 2) { const int ob = c - 12; q = (ob & 3) + 128 * (2 + (ob >> 2)); kind = e == 0 ? 1 : 3; }
            else return false; }
        int pm, pn; if (!o.get_linear(q, pm, pn)) return false;
        unit3(u, ws, pm, pn, kind); return true; }
};
struct SchedList3 { unsigned char* ws; int pm, pn, n, kinds;
    __device__ bool next(int i, pg::Unit& u) const { if (i >= n) return false; unit3(u, ws, pm, pn, (kinds >> (4 * i)) & 15); return true; } };
struct SchedOne { const char* A; const char* B; int pm, pn, K;
    __device__ bool next(int i, pg::Unit& u) const { if (i >= 1) return false; u.pm = pm; u.pn = pn; u.kind = 0; u.A = A + (size_t)pm * 256 * K * 2; u.B = B + (size_t)pn * 256 * K * 2; return true; } };
__device__ __forceinline__ void sub_barrier(unsigned* cnt, unsigned n, int wave_s) {
    asm volatile("s_waitcnt vmcnt(0)" ::: "memory");
    __syncthreads();
    if (fresh_tid_w(wave_s) == 0) {
        __builtin_amdgcn_fence(__ATOMIC_RELEASE, "agent");
        asm volatile("s_waitcnt vmcnt(0)" ::: "memory");
        xb_add(cnt, 1u);
        unsigned sp = 0; while (xb_ld(cnt) < n) {     __builtin_amdgcn_s_sleep(2); if (++sp > (1u << 24)) break; }
        __builtin_amdgcn_fence(__ATOMIC_ACQUIRE, "agent");
        asm volatile("s_waitcnt vmcnt(0)" ::: "memory");
    }
    __syncthreads();
}

__device__ __forceinline__ float ssq_total(const float* ssq, int row, int fq) {
    const f32x4 v = *(const f32x4*)(ssq + (size_t)row * 16 + 4 * fq); float s = (v.x + v.y) + (v.z + v.w);
    s += __shfl_xor(s, 16); s += __shfl_xor(s, 32); return s;
}
struct Epi4 {
    unsigned char* ws; const float* xp; const float* xs;
    __device__ __forceinline__ void operator()(const f32x4 (&acc)[2][2][4][2], const pg::Unit& u, int wr, int wc, int fr, int fq) const {
        float* ssq = (float*)(ws + WS_SSQ1);
        const char* xb = (const char*)ws + WS_XH; char* hb = (char*)ws + WS_K;
#pragma unroll
        for (int ai = 0; ai < 2; ++ai)
#pragma unroll
            for (int m = 0; m < 4; ++m) {
                const int row = u.pm * 256 + ai * 128 + wr * 64 + m * 16 + fr;
                const bool ok = row < MREAL; float s = 0.f;
                const float rms = ((const float*)(ws + WS_RSTD0))[ok ? row : 0];
#pragma unroll
                for (int bj = 0; bj < 2; ++bj) {
                    const unsigned e = (unsigned)(row * D + u.pn * 256 + bj * 128 + wc * 32 + 8 * fq);
                    if (ok) {
                        const h16x8 xh = *(const h16x8*)(xb + e * 2u);
                        const f32x4 x0 = up4(__builtin_shufflevector(xh, xh, 0, 1, 2, 3)) * rms + acc[ai][bj][m][0], x1 = up4(__builtin_shufflevector(xh, xh, 4, 5, 6, 7)) * rms + acc[ai][bj][m][1];
                        *(h16x8*)(hb + e * 2u) = cvt8(x0, x1);
                        s += (x0.x * x0.x + x0.y * x0.y) + (x0.z * x0.z + x0.w * x0.w) + (x1.x * x1.x + x1.y * x1.y) + (x1.z * x1.z + x1.w * x1.w);
                    }
                }
                s += __shfl_xor(s, 16); s += __shfl_xor(s, 32);
                if (ok && fq == 0) ssq[(unsigned)(row * 16 + u.pn * 4 + wc)] = s;
            }
    }
};
struct Sched4 { pg::TileOrder o; const char* A; const char* B;
    __device__ bool next(int i, pg::Unit& u) const { int pm, pn; if (!o.get(i, pm, pn)) return false; u.pm = pm; u.pn = pn; u.kind = 0;
        u.A = A + (size_t)pm * 256 * D * 2; u.B = B + (size_t)pn * 256 * D * 2; return true; } };
struct Epi5a {
    unsigned char* ws;
    __device__ __forceinline__ void operator()(const f32x4 (&acc)[2][2][4][2], const pg::Unit& u, int wr, int wc, int fr, int fq) const {
        const float* ssq = (const float*)(ws + WS_SSQ1); char* gbp = (char*)ws + WS_V;
#pragma unroll
        for (int ai = 0; ai < 2; ++ai)
#pragma unroll
            for (int m = 0; m < 4; ++m) {
                const int row = u.pm * 256 + ai * 128 + wr * 64 + m * 16 + fr;
                const int rowc = row < MREAL ? row : MREAL - 1;
                const float rs = -1.4426950408889634f * __builtin_amdgcn_rsqf(ssq_total(ssq, rowc, fq) * (1.0f / D) + EPS);
#pragma unroll
                for (int bj = 0; bj < 2; ++bj) {
                    const unsigned e = (unsigned)(row * D + u.pn * 256 + bj * 128 + wc * 32 + 8 * fq); f32x4 g0, g1;
#pragma unroll
                    for (int j = 0; j < 4; ++j) { g0[j] = __builtin_amdgcn_rcpf(1.0f + __builtin_amdgcn_exp2f(acc[ai][bj][m][0][j] * rs)); g1[j] = __builtin_amdgcn_rcpf(1.0f + __builtin_amdgcn_exp2f(acc[ai][bj][m][1][j] * rs)); }
                    *(h16x8*)(gbp + e * 2u) = cvt8(g0, g1);
                }
            }
    }
};
struct Epi5b {
    float* out; unsigned char* ws; const float* gfinal; gu32* ctl; LAS unsigned char* lx;
    __device__ __forceinline__ void operator()(f32x4 (&acc)[2][2][4][2], const pg::Unit& u, int wr, int wc, int fr_in, int fq_in) const {
        int fr = fr_in, fq = fq_in; asm volatile("" : "+v"(fr), "+v"(fq));
        const char* gbp = (const char*)ws + WS_V; const char* xhp = (const char*)ws + WS_K; char* ob = (char*)out;
        LAS float* P = (LAS float*)lx; LAS float* S = (LAS float*)(lx + 4096);
        const int wid = wr * 4 + wc, lane = fq * 16 + fr;
        LAS float* Pb = P + (wr * 64 + fr) * 4 + wc; const LAS float* Sb = S + wr * 64 + fr;
#pragma unroll
        for (int ai = 0; ai < 2; ++ai)
#pragma unroll
            for (int m = 0; m < 4; ++m) {
                const int rl = ai * 128 + wr * 64 + m * 16 + fr, row = u.pm * 256 + rl;
                const bool ok = row < MREAL; float s = 0.f;
#pragma unroll
                for (int bj = 0; bj < 2; ++bj) {
                    const unsigned e = (unsigned)(row * D + u.pn * 256 + bj * 128 + wc * 32 + 8 * fq);
                    if (ok) {
                        const h16x8 g = *(const h16x8*)(gbp + e * 2u), xh = *(const h16x8*)(xhp + e * 2u);
                        const f32x4 g0 = up4(__builtin_shufflevector(g, g, 0, 1, 2, 3)), g1 = up4(__builtin_shufflevector(g, g, 4, 5, 6, 7));
                        const f32x4 x0 = up4(__builtin_shufflevector(xh, xh, 0, 1, 2, 3)) + g0 * acc[ai][bj][m][0], x1 = up4(__builtin_shufflevector(xh, xh, 4, 5, 6, 7)) + g1 * acc[ai][bj][m][1];
                        acc[ai][bj][m][0] = x0; acc[ai][bj][m][1] = x1;
                        s += (x0.x * x0.x + x0.y * x0.y) + (x0.z * x0.z + x0.w * x0.w) + (x1.x * x1.x + x1.y * x1.y) + (x1.z * x1.z + x1.w * x1.w);
                    }
                }
                s += __shfl_xor(s, 16); s += __shfl_xor(s, 32);
                if (fq == 0) Pb[(ai * 128 + m * 16) * 4] = s;
                if (m & 1) asm volatile("" ::: "memory");
            }
        asm volatile("s_waitcnt lgkmcnt(0)" ::: "memory"); __builtin_amdgcn_s_barrier(); asm volatile("" ::: "memory");
        const int rrow = wid * 32 + (lane & 31);
        float* slots = (float*)(ws + WS_XCH) + ((size_t)u.pm * 256 + rrow) * 4;
        if (lane < 32) { const f32x4 p4 = *(const LAS f32x4*)(P + rrow * 4); __hip_atomic_store(slots + u.pn, (p4.x + p4.y) + (p4.z + p4.w), __ATOMIC_RELAXED, __HIP_MEMORY_SCOPE_AGENT); }
        asm volatile("s_waitcnt vmcnt(0)" ::: "memory");
        unsigned* cnt = (unsigned*)(ctl + CW_PANEL + 64 * u.pm);
        if (lane == 0) __hip_atomic_fetch_add(cnt, 1u, __ATOMIC_RELAXED, __HIP_MEMORY_SCOPE_AGENT);
        if (wid == 0) {
            unsigned sp = 0;
            while ((unsigned)__builtin_amdgcn_readfirstlane((int)__hip_atomic_load(cnt, __ATOMIC_RELAXED, __HIP_MEMORY_SCOPE_AGENT)) < 32u) { __builtin_amdgcn_s_sleep(2); if (++sp > (1u << 22)) break; }
            __builtin_amdgcn_fence(__ATOMIC_ACQUIRE, "agent");
        }
        asm volatile("s_waitcnt vmcnt(0) lgkmcnt(0)" ::: "memory"); __builtin_amdgcn_s_barrier(); asm volatile("" ::: "memory");
        if (lane < 32) { float t = 0.f;
#pragma unroll
            for (int q = 0; q < 4; ++q) t += __hip_atomic_load(slots + q, __ATOMIC_RELAXED, __HIP_MEMORY_SCOPE_AGENT);
            S[rrow] = __builtin_amdgcn_rsqf(t * (1.0f / D) + EPS); }
        asm volatile("s_waitcnt vmcnt(0) lgkmcnt(0)" ::: "memory"); __builtin_amdgcn_s_barrier(); asm volatile("" ::: "memory");
#pragma unroll
        for (int ai = 0; ai < 2; ++ai)
#pragma unroll
            for (int m = 0; m < 4; ++m) {
                const int rl = ai * 128 + wr * 64 + m * 16 + fr, row = u.pm * 256 + rl;
                const float rs = Sb[ai * 128 + m * 16];
                if (row < MREAL) {
#pragma unroll
                    for (int bj = 0; bj < 2; ++bj) {
                        const int col = u.pn * 256 + bj * 128 + wc * 32 + 8 * fq; const unsigned e = (unsigned)(row * D + col);
                        *(f32x4*)(ob + e * 4u) = acc[ai][bj][m][0] * rs * *(const f32x4*)(gfinal + col); *(f32x4*)(ob + e * 4u + 16) = acc[ai][bj][m][1] * rs * *(const f32x4*)(gfinal + col + 4);
                    }
                }
            }
        asm volatile("s_waitcnt lgkmcnt(0)" ::: "memory"); __builtin_amdgcn_s_barrier(); asm volatile("" ::: "memory");
    }
};
struct Sched5b { pg::TileOrder o; const char* A; const char* B;
    __device__ bool next(int i, pg::Unit& u) const { int pm, pn; if (!o.get(i, pm, pn)) return false; u.pm = pm; u.pn = pn; u.kind = 0;
        u.A = A + (size_t)pm * 256 * PLE * 2; u.B = B + (size_t)pn * 256 * PLE * 2; return true; } };

namespace s2 {
constexpr int RS = 72, MAT_B = 16 * RS * 2;
constexpr int CH_QT = 0, CH_RT = MAT_B, CH_BT = 2 * MAT_B, CH_KT = 3 * MAT_B, CH_VT = 4 * MAT_B, CH_MK = 5 * MAT_B, CH_NK = CH_MK + 512, CH_NB = CH_NK + 512, CH_TI = CH_NB + 512,
              CH_E8 = CH_TI + 512, CH_E16 = CH_E8 + 256, CH_BYTES = CH_E16 + 256;
constexpr int OFF_TW = 4 * CH_BYTES, OFF_AL = OFF_TW + 64 * RS * 2, OFF_YY = OFF_TW  , OFF_BON = OFF_AL + 64 * RS * 2, OFF_N2 = OFF_BON + 512, OFF_SZ = OFF_N2 + 512,
              OFF_CT = OFF_SZ + 8192, OFF_W2L = OFF_CT + 25 * 256, OFF_I2L = OFF_W2L + 64 * RS * 2, OFF_RAW = OFF_I2L + 64 * RS * 2;
constexpr int RAW_PLANE = 9216, RAW_R = 0, RAW_K = RAW_PLANE, RAW_V = 2 * RAW_PLANE, RAW_Z = 3 * RAW_PLANE, RAW_W = 4 * RAW_PLANE, RAW_BYTES = 4 * RAW_PLANE + 17408, OFF_END = OFF_RAW + RAW_BYTES;
static_assert(OFF_END <= SCAN_LDS_BYTES && 16384 <= 2 * 64 * RS * 2 && (OFF_RAW % 16) == 0, "scan LDS");
typedef short v4i16_t __attribute__((ext_vector_type(4)));
__device__ __forceinline__ f32x4 mm16(h16x4 a, h16x4 b, f32x4 c) {
    const h16x4 z = (h16x4){(h16)0.f, (h16)0.f, (h16)0.f, (h16)0.f};
    return __builtin_amdgcn_mfma_f32_16x16x32_f16(__builtin_shufflevector(a, z, 0, 1, 2, 3, 4, 5, 6, 7), __builtin_shufflevector(b, z, 0, 1, 2, 3, 4, 5, 6, 7), c, 0, 0, 0); }
__device__ __forceinline__ h16x4 ldtr(const LAS unsigned char* p) { return __builtin_bit_cast(h16x4, __builtin_amdgcn_ds_read_tr16_b64_v4i16((LAS v4i16_t*)p)); }
__device__ __forceinline__ h16x4 ldR(const LAS unsigned char* m, int row, int col) { return *(const LAS h16x4*)(m + (row * RS + col) * 2); }
__device__ __forceinline__ h16x4 ldS(const LAS unsigned char* m, int row, int col) { return *(const LAS h16x4*)(m + (row * 16 + col) * 2); }
template <int CTRL> __device__ __forceinline__ float dppf(float x) { return __builtin_bit_cast(float, __builtin_amdgcn_update_dpp(0, __builtin_bit_cast(int, x), CTRL, 0xf, 0xf, true)); }
__device__ __forceinline__ f32x4 mix4_(h16x4 c, h16x4 d, f32x4 mu) {
    return (f32x4){ __builtin_fmaf((float)d[0], mu[0], (float)c[0]), __builtin_fmaf((float)d[1], mu[1], (float)c[1]), __builtin_fmaf((float)d[2], mu[2], (float)c[2]), __builtin_fmaf((float)d[3], mu[3], (float)c[3]) }; }
typedef _Float16 h16x2 __attribute__((ext_vector_type(2)));
typedef unsigned u32x2 __attribute__((ext_vector_type(2)));
typedef _Float16 h16x2 __attribute__((ext_vector_type(2)));
#define HMUL(hv, i, b) __builtin_fmaf((float)(hv)[i], (b), 0.0f)
#define HFMA(hv, i, b, c) __builtin_fmaf((float)(hv)[i], (b), (c))
__device__ __forceinline__ float rowscan16(float x) { x += dppf<0x111>(x); x += dppf<0x112>(x); x += dppf<0x114>(x); x += dppf<0x118>(x); return x; }
}
__device__ __forceinline__ void scan_prefetch(LAS unsigned char* L, const unsigned char* ws, int wave, int lane, int h, int rr, bool skip0) {
    using namespace s2;
    for (int q = wave; q < 53; q += NWAVES) {
        if (q < 36) { const int p = q / 9, qq = q - 9 * p, r0 = 8 * qq + (lane >> 3), c = (lane & 7) ^ (r0 & 7);
            int r = r0 > 64 ? 64 : r0; if (skip0 && r == 0) r = 1;
            const size_t pb = p == 0 ? WS_R : p == 1 ? WS_K : p == 2 ? WS_V : WS_Z;
            __builtin_amdgcn_global_load_lds((const unsigned*)(ws + pb + (size_t)(rr + r) * 2048 + 128 * h + 16 * c), (LAS unsigned*)(L + OFF_RAW + p * RAW_PLANE + qq * 1024), 16, 0, 0);
        } else { const int qq = q - 36, r0 = 4 * qq + (lane >> 4), c = lane & 15, cs = (c & 8) | ((c & 7) ^ (r0 & 7));
            int r = r0 > 64 ? 64 : r0; if (skip0 && r == 0) r = 1;
            __builtin_amdgcn_global_load_lds((const unsigned*)(ws + WS_WA + (size_t)(rr + r) * 256 + 16 * cs), (LAS unsigned*)(L + OFF_RAW + RAW_W + qq * 1024), 16, 0, 0);
        }
    }
}
__device__ __forceinline__ void scan_prefetch_fast(LAS unsigned char* L, const unsigned char* ws, int wave, int lane, int h, int rr) {
    using namespace s2;
    if (wave < 4) {
        const int r_l = lane >> 3, cx = (lane & 7) ^ r_l;
        const size_t pb = wave == 0 ? WS_R : wave == 1 ? WS_K : wave == 2 ? WS_V : WS_Z;
        const unsigned char* base = ws + pb + 128 * h + 16 * cx;
        const unsigned char* a = base + (size_t)(rr + r_l) * 2048;
        LAS unsigned char* d = L + OFF_RAW + wave * RAW_PLANE;
#pragma unroll
        for (int qq = 0; qq < 8; ++qq) __builtin_amdgcn_global_load_lds((const unsigned*)(a + qq * 16384), (LAS unsigned*)(d + qq * 1024), 16, 0, 0);
        __builtin_amdgcn_global_load_lds((const unsigned*)(base + (size_t)(rr + 64) * 2048), (LAS unsigned*)(d + 8 * 1024), 16, 0, 0);
    } else {
        const int w4 = wave - 4, r_l = lane >> 4, c = lane & 15;
#pragma unroll
        for (int i = 0; i < 5; ++i) { const int qq = w4 + 4 * i;
            if (qq < 17) { const int r0 = 4 * qq + r_l, r = qq == 16 ? 64 : r0, cs = (c & 8) | ((c & 7) ^ (r0 & 7));
                __builtin_amdgcn_global_load_lds((const unsigned*)(ws + WS_WA + (size_t)(rr + r) * 256 + 16 * cs), (LAS unsigned*)(L + OFF_RAW + RAW_W + qq * 1024), 16, 0, 0); } }
    }
}
#define SBAR() do { asm volatile("s_waitcnt lgkmcnt(0)" ::: "memory"); __builtin_amdgcn_s_barrier(); asm volatile("" ::: "memory"); } while (0)
__device__ __forceinline__ void scan_head_v2(Frame& F, int bh, bool dry) {
    using namespace s2;
    const bool samp = bh >= 128; const int b = (bh & 127) >> 4, h = bh & 15;
    const int T = samp ? DSEQ : SEQ, row0 = samp ? NP + DSEQ * b : SEQ * b;
    unsigned char* ws = F.ws; float* out = F.out;
    char* Zb = (char*)(ws + WS_Z);
    LAS unsigned char* L = F.lds;
    const int tid = fresh_tid_w(F.wave_s), lane = tid & 63, wave = F.wave_s, c15 = lane & 15, g = lane >> 4;
    const int cw = wave & 3, hf = wave >> 2;
    scan_prefetch(L, ws, wave, lane, h, row0 - 1, true);
    for (int i = tid; i < 25 * 64; i += NWAVES * 64) { const int kind = i >> 6, k = i & 63, hk = 64 * h + k; float v;
        const float* mu = F.in[IN_MU]; const float* sh = F.in[IN_ST_SHIFT] + (size_t)b * SHIFT_COLS;
        switch (kind) { case 0: v = mu[hk]; break; case 1: v = mu[1024 + hk]; break; case 2: v = mu[2048 + hk]; break; case 3: v = mu[3200 + hk]; break;
            case 4: v = F.in[IN_KREM][hk]; break; case 5: v = F.in[IN_KREP][hk]; break; case 6: v = -1.4426950408889634f * F.in[IN_WDEC0][hk]; break; case 7: v = -1.4426950408889634f * F.in[IN_WICL0][hk]; break;
            case 8: v = F.in[IN_RBONUS][hk]; break; case 9: v = F.in[IN_GNW][hk]; break; case 10: v = F.in[IN_GNB][hk]; break; case 11: v = mu[3072 + k]; break; case 12: v = mu[3136 + k]; break;
            case 13: v = samp ? sh[hk] : 0.f; break; case 14: v = samp ? sh[1024 + hk] : 0.f; break; case 15: v = samp ? sh[2048 + hk] : 0.f; break; case 16: v = samp ? sh[3200 + hk] : 0.f; break;
            case 17: v = samp ? sh[3072 + k] : 0.f; break; case 18: v = samp ? sh[3136 + k] : 0.f; break;
            case 19: v = 1.f - F.in[IN_KREP][hk]; break; case 20: v = 1.f - mu[1024 + hk]; break; case 21: v = 1.f - mu[2048 + hk]; break; case 22: v = 1.f - mu[3200 + hk]; break;
            case 23: v = 1.f - mu[3072 + k]; break; default: v = 1.f - mu[3136 + k]; break; }
        *(LAS float*)(L + OFF_CT + i * 4) = v; }
    __syncthreads();
    for (int i = tid; i < 8 * 64; i += NWAVES * 64) { const int kind = i >> 6, k = i & 63;
        const int src = kind == 0 ? 0 : kind == 1 ? 1 : kind == 2 ? 2 : kind == 3 ? 3 : kind == 4 ? 4 : kind == 5 ? 8 : kind == 6 ? 11 : 12;
        const float v = *(const LAS float*)(L + OFF_CT + (src * 64 + k) * 4);
        asm volatile("" ::: "memory");
        *(LAS h16*)(L + OFF_CT + 20 * 256 + i * 2) = (h16)v; }
    { const int k = tid >> 3, ch = tid & 7;
      *(LAS h16x8*)(L + OFF_W2L + (k * RS + 8 * ch) * 2) = *(const h16x8*)((const h16*)(ws + WS_W2T) + (size_t)(64 * h + k) * 64 + 8 * ch);
      *(LAS h16x8*)(L + OFF_I2L + (k * RS + 8 * ch) * 2) = *(const h16x8*)((const h16*)(ws + WS_I2T) + (size_t)(64 * h + k) * 64 + 8 * ch); }
#define CT4(kind, k) (*(const LAS f32x4*)(L + OFF_CT + ((kind) * 64 + (k)) * 4))
#define CTH4(kind, k) (*(const LAS h16x4*)(L + OFF_CT + 20 * 256 + ((kind) * 64 + (k)) * 2))
#define CTH8(kind, k) (*(const LAS h16x8*)(L + OFF_CT + 20 * 256 + ((kind) * 64 + (k)) * 2))
#define CT1(kind, k) (*(const LAS float*)(L + OFF_CT + ((kind) * 64 + (k)) * 4))
#define RAW8(p, row, kc) (*(const LAS h16x4*)(L + OFF_RAW + (p) * RAW_PLANE + (row) * 128 + ((((kc) >> 3) ^ ((row) & 7)) << 4) + ((kc) & 7) * 2))
#define RAWW8(row, hc) (*(const LAS h16x4*)(L + OFF_RAW + RAW_W + (row) * 256 + (((((hc) >> 3) & 8) | ((((hc) >> 3) & 7) ^ ((row) & 7))) << 4) + ((hc) & 7) * 2))
    f32x4 S[4];
#pragma unroll
    for (int kt = 0; kt < 4; ++kt) { S[kt] = (f32x4){0.f, 0.f, 0.f, 0.f};
        if (samp && wave < 4) S[kt] = *(const f32x4*)(F.in[IN_ST_WKV] + ((size_t)(b * 16 + h) * 64 + 16 * wave + c15) * 64 + 16 * kt + 4 * g); }
    asm volatile("s_waitcnt vmcnt(0)" ::: "memory");
    SBAR();
    if (tid < 96) { const int kind = tid >> 4, c4 = (tid & 15) * 4;
        const int ctk = kind < 3 ? 13 + kind : kind == 3 ? 16 : 13 + kind; const h16x4 v = cvt4(CT4(ctk, c4));
        if (kind < 4) *(LAS h16x4*)(L + OFF_RAW + kind * RAW_PLANE + (((c4 >> 3) ^ 0) << 4) + (c4 & 7) * 2) = v;
        else { const int hc = (kind - 4) * 64 + c4; *(LAS h16x4*)(L + OFF_RAW + RAW_W + ((((hc >> 3) & 8) | (((hc >> 3) & 7) ^ 0)) << 4) + (hc & 7) * 2) = v; } }
    SBAR();
    for (int t0 = 0; t0 < T; t0 += 64) {
        const int nb = (T - t0) < 64 ? (T - t0) : 64, nch = nb >> 4;
        const bool cact = cw < nch;
        const int tl = 16 * cw + c15;
        LAS unsigned char* CB = L + cw * CH_BYTES;
        h16x4 rm[2], km[2], kapm[2], rbm[2]; float n2 = 0.f;
#define MIX4(c, p, mu4) mix4_((c), (p) - (c), (mu4))
        if (cact) {
#pragma unroll
            for (int kt = 0; kt < 2; ++kt) {
                const int kc = 32 * hf + 16 * kt + 4 * g;
                const h16x4 rc = RAW8(0, tl + 1, kc), kc4 = RAW8(1, tl + 1, kc), vc = RAW8(2, tl + 1, kc), wlc = RAWW8(tl + 1, kc), alc = RAWW8(tl + 1, 64 + kc);
                const h16x4 rp = RAW8(0, tl, kc), kp = RAW8(1, tl, kc), vp = RAW8(2, tl, kc), wlp = RAWW8(tl, kc), alp = RAWW8(tl, 64 + kc);
                const h16x4 r16 = rc + CTH4(0, kc) * (rp - rc), k16 = kc4 + CTH4(1, kc) * (kp - kc4), v16 = vc + CTH4(2, kc) * (vp - vc);
                const h16x4 wl16 = wlc + CTH4(6, kc) * (wlp - wlc), al16 = alc + CTH4(7, kc) * (alp - alc);
                const h16x4 kap16 = k16 * CTH4(4, kc), rb16 = r16 * CTH4(5, kc);
                rm[kt] = r16; km[kt] = k16; kapm[kt] = kap16; rbm[kt] = rb16;
                n2 = __builtin_amdgcn_fdot2(__builtin_shufflevector(kap16, kap16, 0, 1), __builtin_shufflevector(kap16, kap16, 0, 1), n2, false);
                n2 = __builtin_amdgcn_fdot2(__builtin_shufflevector(kap16, kap16, 2, 3), __builtin_shufflevector(kap16, kap16, 2, 3), n2, false);
                f32x4 tw;
#pragma unroll
                for (int i = 0; i < 4; ++i) tw[i] = __builtin_fmaf(-2.0f, __builtin_amdgcn_rcpf(1.0f + __builtin_amdgcn_exp2f(HMUL(wl16, i, 2.0f * 1.4426950408889634f))), 1.0f);
                *(LAS h16x4*)(L + OFF_TW + (tl * RS + kc) * 2) = cvt4(tw); *(LAS h16x4*)(L + OFF_AL + (tl * RS + kc) * 2) = al16;
                *(LAS h16x4*)(CB + CH_VT + (c15 * RS + kc) * 2) = v16;
            }
            n2 += __shfl_xor(n2, 16); n2 += __shfl_xor(n2, 32);
            if (g == 0) *(LAS float*)(L + OFF_N2 + (hf * 64 + tl) * 4) = n2;
        }
        {
            const int t = tid >> 3, vg = tid & 7, v0 = 8 * vg;
            if (t < nb) {
                const h16x8 zc8 = *(const LAS h16x8*)(L + OFF_RAW + RAW_Z + (t + 1) * 128 + ((vg ^ ((t + 1) & 7)) << 4));
                const h16x8 zp8 = *(const LAS h16x8*)(L + OFF_RAW + RAW_Z + t * 128 + ((vg ^ (t & 7)) << 4));
                const h16x8 z8 = zc8 + CTH8(3, v0) * (zp8 - zc8);
                float sv[8];
#pragma unroll
                for (int j = 0; j < 8; ++j) sv[j] = HMUL(z8, j, __builtin_amdgcn_rcpf(1.0f + __builtin_amdgcn_exp2f(HMUL(z8, j, -1.4426950408889634f))));
                *(LAS h16x8*)(L + OFF_SZ + (t * 64 + v0) * 2) = cvt8((f32x4){sv[0], sv[1], sv[2], sv[3]}, (f32x4){sv[4], sv[5], sv[6], sv[7]});
            }
        }
        SBAR();
        if (t0 + 64 < T) scan_prefetch_fast(L, ws, wave, lane, h, row0 + t0 + 63);
        if (cact) {
            f32x4 dacc[2], aacc[2];
#pragma unroll
            for (int kt = 0; kt < 2; ++kt) { dacc[kt] = CT4(6, 32 * hf + 16 * kt + 4 * g); aacc[kt] = CT4(7, 32 * hf + 16 * kt + 4 * g); }
#pragma unroll
            for (int jp = 0; jp < 2; ++jp) {
                const h16x4 tw0 = *(const LAS h16x4*)(L + OFF_TW + (tl * RS + 32 * jp + 4 * g) * 2), tw1 = *(const LAS h16x4*)(L + OFF_TW + (tl * RS + 32 * jp + 16 + 4 * g) * 2);
                const h16x4 al0 = *(const LAS h16x4*)(L + OFF_AL + (tl * RS + 32 * jp + 4 * g) * 2), al1 = *(const LAS h16x4*)(L + OFF_AL + (tl * RS + 32 * jp + 16 + 4 * g) * 2);
                const h16x8 twf = __builtin_shufflevector(tw0, tw1, 0, 1, 2, 3, 4, 5, 6, 7), alf = __builtin_shufflevector(al0, al1, 0, 1, 2, 3, 4, 5, 6, 7);
#pragma unroll
                for (int kt = 0; kt < 2; ++kt) { const int o = ((32 * hf + 16 * kt + c15) * RS + 32 * jp + 4 * g) * 2;
                    const h16x8 wf = __builtin_shufflevector(*(const LAS h16x4*)(L + OFF_W2L + o), *(const LAS h16x4*)(L + OFF_W2L + o + 32), 0, 1, 2, 3, 4, 5, 6, 7);
                    const h16x8 jf = __builtin_shufflevector(*(const LAS h16x4*)(L + OFF_I2L + o), *(const LAS h16x4*)(L + OFF_I2L + o + 32), 0, 1, 2, 3, 4, 5, 6, 7);
                    dacc[kt] = __builtin_amdgcn_mfma_f32_16x16x32_f16(wf, twf, dacc[kt], 0, 0, 0); aacc[kt] = __builtin_amdgcn_mfma_f32_16x16x32_f16(jf, alf, aacc[kt], 0, 0, 0); }
            }
            const float rn = __builtin_amdgcn_rsqf(fmaxf(*(const LAS float*)(L + OFF_N2 + tl * 4) + *(const LAS float*)(L + OFF_N2 + (64 + tl) * 4), 1e-24f));
            float bs = 0.f;
#pragma unroll
            for (int kt = 0; kt < 2; ++kt) {
                const int kc = 32 * hf + 16 * kt + 4 * g;
                const f32x4 krep = CT4(5, kc), omk = CT4(19, kc);
                f32x4 qt, rt, bt, kt4, e8v, e16v, khv, ktvv, bbv, Lcv, Lpv, refv;
#pragma unroll
                for (int i = 0; i < 4; ++i) {
                    const float lam = __builtin_amdgcn_rcpf(__builtin_fmaf(__builtin_amdgcn_exp2f(dacc[kt][i]), -1.0f / (DECAY_SCALE * 1.4426950408889634f), -1.0f / (DECAY_SCALE * 1.4426950408889634f))), a = __builtin_amdgcn_rcpf(1.0f + __builtin_amdgcn_exp2f(aacc[kt][i]));
                    khv[i] = HMUL(kapm[kt], i, rn); ktvv[i] = HMUL(km[kt], i, __builtin_fmaf(a, krep[i], omk[i])); bbv[i] = a * khv[i];
                    bs = HFMA(rbm[kt], i, ktvv[i], bs);
                    Lcv[i] = rowscan16(lam); Lpv[i] = Lcv[i] - lam;
                }
#pragma unroll
                for (int i = 0; i < 4; ++i) { refv[i] = __shfl(Lcv[i], (lane & 48) | 7); e16v[i] = __shfl(Lcv[i], (lane & 48) | 15); }
#pragma unroll
                for (int i = 0; i < 4; ++i) {
                    const float ea = __builtin_amdgcn_exp2f(Lpv[i] - refv[i]), eb = __builtin_amdgcn_exp2f(Lcv[i] - refv[i]), ec = __builtin_amdgcn_rcpf(eb);
                    qt[i] = khv[i] * ea; rt[i] = HMUL(rm[kt], i, eb); bt[i] = bbv[i] * ec; kt4[i] = ktvv[i] * ec; e8v[i] = refv[i];
                }
                const int o = (c15 * RS + kc) * 2;
                *(LAS h16x4*)(CB + CH_QT + o) = cvt4(qt); *(LAS h16x4*)(CB + CH_RT + o) = cvt4(rt); *(LAS h16x4*)(CB + CH_BT + o) = cvt4(bt); *(LAS h16x4*)(CB + CH_KT + o) = cvt4(kt4);
                if (c15 == 0) { *(LAS f32x4*)(CB + CH_E8 + kc * 4) = e8v; *(LAS f32x4*)(CB + CH_E16 + kc * 4) = e16v; }
            }
            bs += __shfl_xor(bs, 16); bs += __shfl_xor(bs, 32);
            if (g == 0) *(LAS float*)(L + OFF_BON + (hf * 64 + tl) * 4) = bs;
        }
        SBAR();
        if (cact) {
            h16x8 qf[2], bf[2];
#pragma unroll
            for (int p = 0; p < 2; ++p) { qf[p] = __builtin_shufflevector(ldR(CB + CH_QT, c15, 32 * p + 4 * g), ldR(CB + CH_QT, c15, 32 * p + 16 + 4 * g), 0, 1, 2, 3, 4, 5, 6, 7);
                bf[p] = __builtin_shufflevector(ldR(CB + CH_BT, c15, 32 * p + 4 * g), ldR(CB + CH_BT, c15, 32 * p + 16 + 4 * g), 0, 1, 2, 3, 4, 5, 6, 7); }
            const f32x4 z4 = (f32x4){0.f, 0.f, 0.f, 0.f};
            if (hf == 0) {
                f32x4 Dr = z4, Dc = z4;
#pragma unroll
                for (int p = 0; p < 2; ++p) { Dr = __builtin_amdgcn_mfma_f32_16x16x32_f16(bf[p], qf[p], Dr, 0, 0, 0); Dc = __builtin_amdgcn_mfma_f32_16x16x32_f16(qf[p], bf[p], Dc, 0, 0, 0); }
                f32x4 Xr, Xc, Id;
#pragma unroll
                for (int i = 0; i < 4; ++i) { const int u = 4 * g + i; Xr[i] = u < c15 ? -Dr[i] : 0.f; Xc[i] = c15 < u ? -Dc[i] : 0.f; Id[i] = u == c15 ? 1.f : 0.f; }
                const h16x4 hXr = cvt4(Xr), hXc = cvt4(Xc);
                const f32x4 X2c = mm16(hXr, hXc, z4), X2r = mm16(hXc, hXr, z4);
                const f32x4 S1c = Id + Xc, S1r = Id + Xr;
                const h16x4 hX2r = cvt4(X2r), hX2c = cvt4(X2c), hS1c = cvt4(S1c);
                const f32x4 S2c = mm16(hX2r, hS1c, S1c), S2r = mm16(hS1c, hX2r, S1r);
                const f32x4 X4c = mm16(hX2r, hX2c, z4), X4r = mm16(hX2c, hX2r, z4);
                const h16x4 hX4r = cvt4(X4r), hX4c = cvt4(X4c), hS2c = cvt4(S2c);
                const f32x4 S4c = mm16(hX4r, hS2c, S2c), S4r = mm16(hS2c, hX4r, S2r);
                const f32x4 X8r = mm16(hX4c, hX4r, z4);
                const f32x4 TIr = mm16(cvt4(S4c), cvt4(X8r), S4r);
                *(LAS h16x4*)(CB + CH_TI + (c15 * 16 + 4 * g) * 2) = cvt4(TIr);
            } else {
                h16x8 kf[2], rf[2];
#pragma unroll
                for (int p = 0; p < 2; ++p) { kf[p] = __builtin_shufflevector(ldR(CB + CH_KT, c15, 32 * p + 4 * g), ldR(CB + CH_KT, c15, 32 * p + 16 + 4 * g), 0, 1, 2, 3, 4, 5, 6, 7);
                    rf[p] = __builtin_shufflevector(ldR(CB + CH_RT, c15, 32 * p + 4 * g), ldR(CB + CH_RT, c15, 32 * p + 16 + 4 * g), 0, 1, 2, 3, 4, 5, 6, 7); }
                f32x4 mk = z4, nk = z4, nbm = z4;
#pragma unroll
                for (int p = 0; p < 2; ++p) { mk = __builtin_amdgcn_mfma_f32_16x16x32_f16(kf[p], qf[p], mk, 0, 0, 0); nk = __builtin_amdgcn_mfma_f32_16x16x32_f16(kf[p], rf[p], nk, 0, 0, 0); nbm = __builtin_amdgcn_mfma_f32_16x16x32_f16(bf[p], rf[p], nbm, 0, 0, 0); }
#pragma unroll
                for (int i = 0; i < 4; ++i) { const int u = 4 * g + i; if (!(u < c15)) mk[i] = 0.f; if (!(u <= c15)) { nk[i] = 0.f; nbm[i] = 0.f; } }
                const int o = (c15 * 16 + 4 * g) * 2;
                *(LAS h16x4*)(CB + CH_MK + o) = cvt4(mk); *(LAS h16x4*)(CB + CH_NK + o) = cvt4(nk); *(LAS h16x4*)(CB + CH_NB + o) = cvt4(nbm);
                { LAS float* e8 = (LAS float*)(CB + CH_E8) + lane; LAS float* e16 = (LAS float*)(CB + CH_E16) + lane; const float rf = *e8; *e8 = __builtin_amdgcn_exp2f(rf); *e16 = __builtin_amdgcn_exp2f(*e16 - rf); }
            }
        }
        SBAR();
        if (wave < 4) {
            const int troff = ((4 * g + (c15 >> 2)) * RS + 4 * (c15 & 3)) * 2;
            for (int c = 0; c < nch; ++c) {
                const LAS unsigned char* B = L + c * CH_BYTES;
                f32x4 e8[4], e16[4]; h16x4 q[4], r[4], ktr[4], btr[4];
#pragma unroll
                for (int kt = 0; kt < 4; ++kt) { e8[kt] = *(const LAS f32x4*)(B + CH_E8 + (16 * kt + 4 * g) * 4); q[kt] = ldR(B + CH_QT, c15, 16 * kt + 4 * g); }
                const h16x4 vh = ldtr(B + CH_VT + troff + 16 * wave * 2), mk = ldS(B + CH_MK, c15, 4 * g), ti = ldS(B + CH_TI, c15, 4 * g), nk = ldS(B + CH_NK, c15, 4 * g), nbm = ldS(B + CH_NB, c15, 4 * g);
#pragma unroll
                for (int kt = 0; kt < 4; ++kt) { r[kt] = ldR(B + CH_RT, c15, 16 * kt + 4 * g); ktr[kt] = ldtr(B + CH_KT + troff + 16 * kt * 2); btr[kt] = ldtr(B + CH_BT + troff + 16 * kt * 2);
                    e16[kt] = *(const LAS f32x4*)(B + CH_E16 + (16 * kt + 4 * g) * 4); }
                f32x4 S8[4]; h16x4 s8h[4];
#pragma unroll
                for (int kt = 0; kt < 4; ++kt) { S8[kt] = S[kt] * e8[kt]; s8h[kt] = cvt4(S8[kt]); }
                const f32x4 z4 = (f32x4){0.f, 0.f, 0.f, 0.f};
                const h16x8 s01 = __builtin_shufflevector(s8h[0], s8h[1], 0, 1, 2, 3, 4, 5, 6, 7), s23 = __builtin_shufflevector(s8h[2], s8h[3], 0, 1, 2, 3, 4, 5, 6, 7);
                f32x4 Pa = mm16(mk, vh, z4);
                Pa = __builtin_amdgcn_mfma_f32_16x16x32_f16(__builtin_shufflevector(q[0], q[1], 0, 1, 2, 3, 4, 5, 6, 7), s01, Pa, 0, 0, 0);
                const f32x4 Pb = __builtin_amdgcn_mfma_f32_16x16x32_f16(__builtin_shufflevector(q[2], q[3], 0, 1, 2, 3, 4, 5, 6, 7), s23, z4, 0, 0, 0);
                const f32x4 sg = mm16(ti, cvt4(Pa + Pb), z4);
                const h16x4 sn = -cvt4(sg);
                f32x4 Ya = mm16(nk, vh, z4);
                Ya = __builtin_amdgcn_mfma_f32_16x16x32_f16(__builtin_shufflevector(r[0], r[1], 0, 1, 2, 3, 4, 5, 6, 7), s01, Ya, 0, 0, 0);
                f32x4 Yb = __builtin_amdgcn_mfma_f32_16x16x32_f16(__builtin_shufflevector(r[2], r[3], 0, 1, 2, 3, 4, 5, 6, 7), s23, z4, 0, 0, 0);
#pragma unroll
                for (int kt = 0; kt < 4; ++kt) S8[kt] = mm16(ktr[kt], vh, S8[kt]);
                Yb = mm16(nbm, sn, Yb);
#pragma unroll
                for (int kt = 0; kt < 4; ++kt) S[kt] = mm16(btr[kt], sn, S8[kt]) * e16[kt];
                const f32x4 Y = Ya + Yb;
#pragma unroll
                for (int i = 0; i < 4; ++i) *(LAS float*)(L + OFF_YY + ((16 * c + 4 * g + i) * 64 + 16 * wave + c15) * 4) = Y[i];
            }
        }
        asm volatile("s_waitcnt vmcnt(0)" ::: "memory");
        SBAR();
        {
            const int t = tid >> 3, vg = tid & 7, v0 = 8 * vg;
            if (t < nb) {
                const f32x4 y0 = *(const LAS f32x4*)(L + OFF_YY + (t * 64 + v0) * 4), y1 = *(const LAS f32x4*)(L + OFF_YY + (t * 64 + v0 + 4) * 4);
                float y[8] = {y0.x, y0.y, y0.z, y0.w, y1.x, y1.y, y1.z, y1.w};
                float s = 0.f;
#pragma unroll
                for (int j = 0; j < 8; ++j) s += y[j];
                s += dppf<0xB1>(s); s += dppf<0x4E>(s); s += dppf<0x141>(s);
                const float mean = s * (1.0f / 64.0f); float q = 0.f;
#pragma unroll
                for (int j = 0; j < 8; ++j) { y[j] -= mean; q += y[j] * y[j]; }
                q += dppf<0xB1>(q); q += dppf<0x4E>(q); q += dppf<0x141>(q);
                const float rstd = __builtin_amdgcn_rsqf(q * (1.0f / 64.0f) + GN_EPS);
                const float bonus = *(const LAS float*)(L + OFF_BON + t * 4) + *(const LAS float*)(L + OFF_BON + (64 + t) * 4);
                const h16x8 vv = *(const LAS h16x8*)(L + (t >> 4) * CH_BYTES + CH_VT + ((t & 15) * RS + v0) * 2);
                const h16x8 sz = *(const LAS h16x8*)(L + OFF_SZ + (t * 64 + v0) * 2);
                const f32x4 gw0 = CT4(9, v0), gw1 = CT4(9, v0 + 4), gb0 = CT4(10, v0), gb1 = CT4(10, v0 + 4);
                h16x8 o;
#pragma unroll
                for (int j = 0; j < 8; ++j) o[j] = (h16)((y[j] * rstd * (j < 4 ? gw0[j & 3] : gw1[j & 3]) + (j < 4 ? gb0[j & 3] : gb1[j & 3]) + bonus * (float)vv[j]) * (float)sz[j]);
                if (!dry) { char* zp = Zb + (size_t)(row0 + t0 + t) * 2048 + 128 * h + 16 * vg; const u32x4 ov = __builtin_bit_cast(u32x4, o);
                    asm volatile("global_store_dwordx4 %0, %1, off sc1\n\ts_nop 1" :: "v"(zp), "v"(ov) : "memory"); }
            }
        }
        if (!samp && (t0 & 255) == 192) {
            asm volatile("s_waitcnt vmcnt(0)" ::: "memory");
            SBAR();
            if (tid == 0 && !dry) __hip_atomic_fetch_add((unsigned*)(F.ctl + CW_RDY) + 64 * (b * 16 + (t0 >> 8)), 1u, __ATOMIC_RELAXED, __HIP_MEMORY_SCOPE_AGENT);
        } else SBAR();
    }
#undef CT4
#undef CT1
#undef RAW8
#undef RAWW8
    if (wave < 4 && !dry) {
#pragma unroll
        for (int kt = 0; kt < 4; ++kt) *(f32x4*)(out + (samp ? OFF_WKV_S : OFF_WKV_P) + ((size_t)(b * 16 + h) * 64 + 16 * wave + c15) * 64 + 16 * kt + 4 * g) = S[kt];
    }
    asm volatile("s_waitcnt vmcnt(0)" ::: "memory");
    __syncthreads();
}
__device__ __forceinline__ void conv_pass(Frame& F, int part, int nparts) {
    const int tid_ = fresh_tid_w(F.wave_s);
    float* out = F.out; unsigned char* ws = F.ws; const float* cw = F.in[IN_CONVW]; h16* AB = (h16*)(ws + WS_ACTB);
    for (int it = part * 512 + tid_; it < (NMT - 1) * 2 * 128; it += nparts * 512) {
        const int c8 = (it & 127) * 8, m = (it >> 7) & 1, pm = it >> 8;
        if ((pm & 15) == 0) continue;
        const float* sp = (const float*)(ws + WS_SIDEP) + (size_t)pm * 2048 + m * 1024 + c8; const float* sg = (const float*)(ws + WS_SIDEG) + (size_t)pm * 2048 + m * 1024 + c8;
        const float* su = (const float*)(ws + WS_SIDEU) + (size_t)(pm - 1) * 2048 + c8;
        h16x8 o;
#pragma unroll
        for (int j = 0; j < 8; ++j) { const float um2 = su[j], um1 = su[1024 + j];
            const float extra = m == 0 ? cw[c8 + j] * um2 + cw[D + c8 + j] * um1 : cw[c8 + j] * um1;
            o[j] = (h16)(sp[j] + sg[j] * extra); }
        *(h16x8*)(AB + ((size_t)pm * 256 + m) * D + c8) = o;
    }
    for (int it = part * 512 + tid_; it < NS * 128; it += nparts * 512) {
        const int row = NP + (it >> 7), c8 = (it & 127) * 8, rr = row - NP, t = rr & (DSEQ - 1), b = rr >> 4;
        const h16x8 u0 = *(const h16x8*)(rowptr16(out, ws, 0, row) + c8), gz = *(const h16x8*)(rowptr16(out, ws, 1, row) + c8);
        float um1[8], um2[8];
        if (t >= 1) { const h16x8 v = *(const h16x8*)(rowptr16(out, ws, 0, row - 1) + c8);
#pragma unroll
            for (int j = 0; j < 8; ++j) um1[j] = (float)v[j]; }
        else {
#pragma unroll
            for (int j = 0; j < 8; ++j) um1[j] = F.in[IN_ST_CONV][((size_t)b * 2 + 1) * D + c8 + j]; }
        if (t >= 2) { const h16x8 v = *(const h16x8*)(rowptr16(out, ws, 0, row - 2) + c8);
#pragma unroll
            for (int j = 0; j < 8; ++j) um2[j] = (float)v[j]; }
        else {
#pragma unroll
            for (int j = 0; j < 8; ++j) um2[j] = F.in[IN_ST_CONV][((size_t)b * 2 + t) * D + c8 + j]; }
        h16x8 o;
#pragma unroll
        for (int j = 0; j < 8; ++j) { const float cv = cw[c8 + j] * um2[j] + cw[D + c8 + j] * um1[j] + cw[2 * D + c8 + j] * (float)u0[j]; o[j] = (h16)((float)gz[j] * cv); }
        *(h16x8*)(AB + (size_t)row * D + c8) = o;
    }
    for (int i = part * 512 + tid_; i < (MP - MREAL) * 128; i += nparts * 512) { h16x8 z;
#pragma unroll
        for (int j = 0; j < 8; ++j) z[j] = (h16)0.f;
        *(h16x8*)(AB + (size_t)MREAL * D + (size_t)i * 8) = z; }
}

constexpr int N_PHASES = 6;
__device__ __forceinline__ void merge_queue(Frame& F, const float* rstd0, bool wait_helpers) {
    unsigned char* ws = F.ws;
    for (;;) {
        if (fresh_tid_w(F.wave_s) == 0) {
            unsigned sp = 0;
            if (wait_helpers) { unsigned* hd = (unsigned*)(F.ctl + CW_SUB); while (xb_ld(hd) < 2u * (unsigned)(F.G - 128)) { __builtin_amdgcn_s_sleep(8); if (++sp > (1u << 24)) break; } }
            const unsigned idx = xb_add((unsigned*)(F.ctl + CW_MQ), 1u);
            if (idx < 512u) {
                unsigned* rdy = (unsigned*)(F.ctl + CW_RDY) + 64 * (((idx >> 2) & 7) * 16 + (idx >> 5)); sp = 0;
                while (xb_ld(rdy) < 16u) { __builtin_amdgcn_s_sleep(8); if (++sp > (1u << 24)) break; }
                __builtin_amdgcn_fence(__ATOMIC_ACQUIRE, "agent");
                asm volatile("s_waitcnt vmcnt(0)" ::: "memory");
            }
            F.MISC[0] = idx;
        }
        __syncthreads();
        const unsigned idx = (unsigned)__builtin_amdgcn_readfirstlane((int)F.MISC[0]);
        if (idx >= 512u) break;
        const int pm = (int)(((idx >> 2) & 7) * 16 + (idx >> 5));
        SchedList3 S{ws, pm, (int)(idx & 3), 1, 0x2}; Epi3 E{F.out, ws, rstd0};
        pg::gemm_phase(F.lds, F.wave_s, D, S, E);
        if (fresh_tid_w(F.wave_s) == 0) xb_add((unsigned*)(F.ctl + CW_MRG) + 64 * pm, 1u);
    }
}
__device__ __forceinline__ void p4_queue(Frame& F) {
    unsigned char* ws = F.ws;
    int qi = 0;
    for (;;) {
        if (fresh_tid_w(F.wave_s) == 0) {
            unsigned got = 0xFFFFFFFFu;
            while (qi < 8) { const unsigned x = (unsigned)((F.bx + qi) & 7); const unsigned idx = xb_add((unsigned*)(F.ctl + CW_P4Q) + 32 * x, 1u); if (idx < 64u) { got = x * 64u + idx; break; } ++qi; }
            if (got != 0xFFFFFFFFu) {
                unsigned* m = (unsigned*)(F.ctl + CW_MRG) + 64 * (16 * (got >> 6) + ((got & 63u) >> 2)); unsigned sp = 0;
                while (xb_ld(m) < 4u) { __builtin_amdgcn_s_sleep(8); if (++sp > (1u << 24)) break; }
                __builtin_amdgcn_fence(__ATOMIC_ACQUIRE, "agent");
                asm volatile("s_waitcnt vmcnt(0)" ::: "memory");
            }
            F.MISC[0] = got;
        }
        __syncthreads();
        const unsigned got = (unsigned)__builtin_amdgcn_readfirstlane((int)F.MISC[0]);
        if (got == 0xFFFFFFFFu) break;
        SchedOne S{(const char*)ws + WS_R, (const char*)ws + WS_WOUT, (int)(16 * (got >> 6) + ((got & 63u) >> 2)), (int)(got & 3u), D}; Epi4 E{ws, F.in[IN_X_P], F.in[IN_X_S]};
        pg::gemm_phase(F.lds, F.wave_s, D, S, E);
    }
}
__global__ void __launch_bounds__(NWAVES * 64, 2) mk_fwd(Args args) {
    extern __shared__ __attribute__((aligned(16))) unsigned char lds[];
    Frame F;
    F.lds = (LAS unsigned char*)lds; F.MISC = (volatile LAS unsigned*)(F.lds + MISC_OFF);
    F.wave_s = __builtin_amdgcn_readfirstlane((int)threadIdx.x >> 6);
    F.G = gridDim.x; F.bx = blockIdx.x; F.in = args.in; F.out = args.out; F.ws = args.ws;
    F.ctl = (gu32*)(args.ws + WS_CTL);
    for (int u = fresh_tid_w(F.wave_s); u < (LDS_BYTES - LDSCTL_OFF) / 4; u += NWAVES * 64) ((LAS unsigned*)(F.lds + LDSCTL_OFF))[u] = 0u;
    __syncthreads();
    XcdBarrier bar; bar.bar = (unsigned*)(F.ctl + CW_BAR); bar.x = 0; bar.st = nullptr;
    const int lo = args.ph_lo, hi = args.ph_hi;
    if (hi - lo > 1) bar = xcd_barrier_post((unsigned*)(F.ctl + CW_BAR), F.MISC + 8, F.wave_s);
#define IN(k) (lo <= (k) && (k) < hi)
#define SEAM(k) do { if (IN(k) && IN((k) + 1)) xcd_barrier(bar, F.wave_s); } while (0)
    unsigned char* ws = args.ws;
    const float* rstd0 = (const float*)(ws + WS_RSTD0);
#define REPS(k) _Pragma("unroll") for (int _r = (PROBE_PHASE == (k)) ? 0 : 1; _r < 2; ++_r)
    if (IN(0)) { REPS(0) { p0_prologue(F); asm volatile("s_waitcnt vmcnt(0)" ::: "memory"); __syncthreads(); } SEAM(0); }
    if (IN(1)) {
        REPS(1) {
        Sched1 S; S.o.init(NMT, 33, F.G, F.bx); S.A = (const char*)ws + WS_XH; S.B = (const char*)ws + WS_W1T;
        Epi1 E{F.out, ws, rstd0, F.in[IN_CONVW], F.lds + RING_BYTES};
        pg::gemm_phase<Sched1, Epi1, true>(F.lds, F.wave_s, D, S, E);
        { constexpr int NLAST = NMT * 33 - 16 * 256;
          if (_r == 1 && F.bx >= NLAST) p0_deferred(F, F.bx - NLAST, 256 - NLAST); } }
        SEAM(1);
    }
    if (IN(2)) {
        REPS(2) {
        scan_head_v2(F, F.bx, _r == 0);
        if (F.bx < 128 && _r == 1) merge_queue(F, rstd0, true);
        if (F.bx >= 128 && _r == 1) {
            const int c = F.bx - 128;
            conv_pass(F, c, F.G - 128);
            sub_barrier((unsigned*)(F.ctl + CW_SUB), (unsigned)(F.G - 128), F.wave_s);
            if (c < 4) {
                unsigned* c4 = (unsigned*)(F.ctl + CW_SUB + 64);
                { SchedList3 S{ws, NMT - 1, c, 4, 0x2310}; Epi3 E{F.out, ws, rstd0}; pg::gemm_phase(F.lds, F.wave_s, D, S, E); }
                sub_barrier(c4, 4u, F.wave_s);
                { SchedOne S{(const char*)ws + WS_R, (const char*)ws + WS_WOUT, NMT - 1, c, D}; Epi4 E{ws, F.in[IN_X_P], F.in[IN_X_S]}; pg::gemm_phase(F.lds, F.wave_s, D, S, E); }
                sub_barrier(c4, 8u, F.wave_s);
                { SchedOne S{(const char*)ws + WS_K, (const char*)ws + WS_WGATE, NMT - 1, c, D}; Epi5a E{ws}; pg::gemm_phase(F.lds, F.wave_s, D, S, E); }
                asm volatile("s_waitcnt vmcnt(0)" ::: "memory"); __syncthreads();
                { SchedOne S{(const char*)ws + WS_PH, (const char*)ws + WS_WPLE, NMT - 1, c, PLE}; Epi5b E{F.out, ws, F.in[IN_GFINAL], F.ctl, F.lds + RING_BYTES}; pg::gemm_phase(F.lds, F.wave_s, PLE, S, E); }
            }
            { SchedH S; S.o.init(NMT - 1, 4, 1, 0); S.ws = ws; S.c = c;
              Epi3 E{F.out, ws, rstd0};
              pg::gemm_phase(F.lds, F.wave_s, D, S, E); }
            sub_barrier((unsigned*)(F.ctl + CW_SUB), 2u * (unsigned)(F.G - 128), F.wave_s);
            merge_queue(F, rstd0, false);
        } }
        if (!(IN(4))) SEAM(2);
    }
    if (IN(4)) {
        p4_queue(F);
        SEAM(4);
    }
    if (IN(5)) {
        REPS(5) { Sched4 S; S.o.init(NMT - 1, 4, F.G, F.bx); S.A = (const char*)ws + WS_K; S.B = (const char*)ws + WS_WGATE;
          Epi5a E{ws}; pg::gemm_phase(F.lds, F.wave_s, D, S, E); }
        asm volatile("s_waitcnt vmcnt(0)" ::: "memory"); __syncthreads();
        { Sched5b S; S.o.init(NMT - 1, 4, F.G, F.bx); S.A = (const char*)ws + WS_PH; S.B = (const char*)ws + WS_WPLE;
          Epi5b E{F.out, ws, F.in[IN_GFINAL], F.ctl, F.lds + RING_BYTES}; pg::gemm_phase(F.lds, F.wave_s, PLE, S, E); }
    }
#undef REPS
#undef IN
#undef SEAM
}

extern "C" void kernel_launch(void* const* d_in, const int* in_sizes, int n_in, void* d_out, int out_size, void* d_ws, size_t ws_size, hipStream_t stream) {
    static int grid = 0;
    if (grid == 0) {
        if (n_in != 27 || ws_size < WS_END) { fprintf(stderr, "kernel_launch: unexpected shapes (n_in %d, ws %zu)\n", n_in, ws_size); grid = -1; return; }
        int dev = 0, cus = 0;
        if (hipGetDevice(&dev) != hipSuccess || hipDeviceGetAttribute(&cus, hipDeviceAttributeMultiprocessorCount, dev) != hipSuccess) { grid = -1; return; }
        if (hipFuncSetAttribute((const void*)mk_fwd, hipFuncAttributeMaxDynamicSharedMemorySize, LDS_BYTES) != hipSuccess) { fprintf(stderr, "kernel_launch: hipFuncSetAttribute failed\n"); grid = -1; return; }
        int per_cu = 0;
        if (hipOccupancyMaxActiveBlocksPerMultiprocessor(&per_cu, (const void*)mk_fwd, NWAVES * 64, LDS_BYTES) != hipSuccess || per_cu < 1) { fprintf(stderr, "kernel_launch: occupancy query says %d\n", per_cu); }
        (void)hipGetLastError();
        if (cus < 256) { fprintf(stderr, "kernel_launch: needs 256 CUs, got %d\n", cus); grid = -1; return; }
        grid = 256;
    }
    if (grid < 0) return;
    (void)hipMemsetAsync((char*)d_ws + WS_CTL, 0, CTL_ZERO_BYTES, stream);
    Args a{};
    for (int i = 0; i < 27; ++i) a.in[i] = (const float*)d_in[i];
    a.out = (float*)d_out; a.ws = (unsigned char*)d_ws;
    if (MK_N_LAUNCHES == 1) { a.ph_lo = 0; a.ph_hi = N_PHASES; a.li = PROBE_PHASE; hipLaunchKernelGGL(mk_fwd, dim3(grid), dim3(NWAVES * 64), LDS_BYTES, stream, a); }
    else for (int li = 0; li < N_PHASES; ++li) { a.ph_lo = li; a.ph_hi = li + 1; a.li = PROBE_PHASE; hipLaunchKernelGGL(mk_fwd, dim3(grid), dim3(NWAVES * 64), LDS_BYTES, stream, a); }
}
```

```cpp
#include <hip/hip_runtime.h>
#include <cstdio>
#include <cstdint>

#ifndef MK_N_LAUNCHES
#define MK_N_LAUNCHES 1
#endif

#ifndef PROBE_PHASE
#define PROBE_PHASE -1
#endif
#define LAS __attribute__((address_space(3)))
#define GAS __attribute__((address_space(1)))
typedef _Float16 h16;
typedef _Float16 h16x8 __attribute__((ext_vector_type(8)));
typedef _Float16 h16x4 __attribute__((ext_vector_type(4)));
typedef float f32x4 __attribute__((ext_vector_type(4)));
typedef float f32x2 __attribute__((ext_vector_type(2)));
typedef unsigned u32x4 __attribute__((ext_vector_type(4)));
typedef GAS unsigned gu32;

constexpr int D = 1024, NP = 32768, NS = 128, MREAL = NP + NS, MP = 33024, NMT = MP / 256;
constexpr int SEQ = 4096, DSEQ = 16, NH = 16, HD = 64, PLE = 256;
constexpr int SHIFT_COLS = 4224, IN_COLS = 10368;
constexpr int W1_ROWS = 8448 + 2048;
constexpr float EPS = 1e-6f, GN_EPS = 64e-5f, DECAY_SCALE = 0.60653065971f;
constexpr size_t OFF_Y = 0, OFF_WKV_P = (size_t)MREAL * D, OFF_SHIFT_P = OFF_WKV_P + 8 * 16 * 64 * 64, OFF_CONV_P = OFF_SHIFT_P + 8 * SHIFT_COLS,
                 OFF_WKV_S = OFF_CONV_P + 8 * 2 * D, OFF_SHIFT_S = OFF_WKV_S + 8 * 16 * 64 * 64, OFF_CONV_S = OFF_SHIFT_S + 8 * SHIFT_COLS;
constexpr size_t MiB = 1u << 20;
constexpr size_t WS_CTL = 0, CTL_ZERO_BYTES = 163840;
static_assert((16384 + 128 * 64) * 4 <= 131072, "control words inside the per-call memset");
constexpr size_t WS_W1T = 1 * MiB, WS_WOA = 22 * MiB, WS_WOB = 24 * MiB, WS_WOUT = 26 * MiB, WS_WGATE = 28 * MiB, WS_WPLE = 30 * MiB;
constexpr size_t WS_W2T = 30 * MiB + 512 * 1024, WS_I2T = WS_W2T + 128 * 1024;
constexpr size_t WS_RSTD0 = 31 * MiB, WS_SIDE = 32 * MiB, WS_SSQ1 = 34 * MiB, WS_XCH = 37 * MiB;
constexpr size_t WS_XH = 40 * MiB, WS_PH = 105 * MiB, WS_R = 122 * MiB, WS_K = 187 * MiB, WS_V = 252 * MiB, WS_Z = 317 * MiB, WS_WA = 382 * MiB, WS_ACTB = 391 * MiB, WS_SIDEU = 456 * MiB, WS_SIDEP = 457 * MiB, WS_SIDEG = 458 * MiB, WS_END = 459 * MiB;
constexpr size_t SIDE_STRIDE = 256 * 1024;
constexpr int CW_BAR = 1024, CW_SUB = 512, CW_PANEL = 5120, CW_RDY = 16384, CW_MQ = 640, CW_P4Q = 768, CW_MRG = 24576, CW_P4D = 32768, CW_MALL = 704;

constexpr int NWAVES = 8;
constexpr int RING_BYTES = 131072, SCAN_LDS_BYTES = 163072, LDSCTL_OFF = SCAN_LDS_BYTES, MISC_OFF = LDSCTL_OFF + 320, LDS_BYTES = 163840;

__device__ __forceinline__ int fresh_tid_w(int wave_s) { int lane; asm volatile("v_mbcnt_lo_u32_b32 %0, -1, 0\n\tv_mbcnt_hi_u32_b32 %0, -1, %0" : "=v"(lane)); return (wave_s << 6) | lane; }
__device__ __forceinline__ float fsigmoid(float x) { return __builtin_amdgcn_rcpf(1.0f + __expf(-x)); }
__device__ __forceinline__ float fsilu(float x) { return x * fsigmoid(x); }
__device__ __forceinline__ float ftanh(float x) { return 1.0f - 2.0f * __builtin_amdgcn_rcpf(__expf(2.0f * x) + 1.0f); }
__device__ __forceinline__ h16x4 cvt4(f32x4 v) { return __builtin_convertvector(v, h16x4); }
__device__ __forceinline__ h16x8 cvt8(f32x4 a, f32x4 b) { h16x4 x = cvt4(a), y = cvt4(b); return __builtin_shufflevector(x, y, 0, 1, 2, 3, 4, 5, 6, 7); }
__device__ __forceinline__ f32x4 up4(h16x4 v) { return __builtin_convertvector(v, f32x4); }

namespace pg {
constexpr int BM = 256, BK = 64, HALF = 128, HTB = HALF * BK * 2, NXCD = 8, WGM = 8;
__host__ __device__ __forceinline__ int lds_byte(int r, int c) { const int st = (r >> 4) * 2 + (c >> 5), rr = r & 15, cc = c & 31, ob = rr * 64 + cc * 2; return st * 1024 + (ob ^ (((ob >> 9) & 1) << 5)); }
__host__ __device__ __forceinline__ void stage_rc(int b, int& R, int& C) { const int st = b / 1024, sb = b % 1024, swz = sb ^ (((sb >> 9) & 1) << 5); R = (st >> 1) * 16 + swz / 64; C = (st & 1) * 32 + (swz % 64) / 2; }
__host__ __device__ __forceinline__ int perm32(int rho) { const int n = rho >> 4, i = rho & 15; return 8 * (i >> 2) + 4 * n + (i & 3); }

struct Unit { int pm, pn, kind; const char* A; const char* B; };

struct TileOrder {
    int nM, nN, nwg, G, c;
    __device__ void init(int nM_, int nN_, int G_, int c_) { nM = nM_; nN = nN_; nwg = nM * nN; G = G_; c = c_; }
    __device__ bool get(int i, int& pm, int& pn) const { return get_linear((long)i * G + c, pm, pn); }
    __device__ bool get_linear(long L, int& pm, int& pn) const {
        if (L >= nwg) return false;
        int wgid = (int)L; { const int q = nwg / NXCD, r = nwg % NXCD, xcd = wgid % NXCD, off = wgid / NXCD; wgid = (xcd < r ? xcd * (q + 1) : r * (q + 1) + (xcd - r) * q) + off; }
        const int nig = WGM * nN, gid = wgid / nig, fm = gid * WGM, gsz = (nM - fm) < WGM ? (nM - fm) : WGM;
        pm = fm + ((wgid % nig) % gsz); pn = (wgid % nig) / gsz; return true;
    }
};

template <class Sched, class Epi, bool APERM = false>
__device__ __forceinline__ void gemm_phase(LAS unsigned char* lds, const int wave_s, const int K, const Sched& S, const Epi& E) {
    const int tid = fresh_tid_w(wave_s), wid = wave_s, lane = tid & 63, wr = wid >> 2, wc = wid & 3, fr = lane & 15, fq = lane >> 4;
    const int nt = K / BK;
    unsigned voffA[2], voffB[2];
#pragma unroll
    for (int i = 0; i < 2; ++i) { int R, C; stage_rc(tid * 16 + i * 8192, R, C); const int Rb = (R & ~31) + perm32(R & 31);
        const int Ra = APERM ? (R & ~63) + 4 * (R & 15) + ((R & 63) >> 4) : R;
        voffA[i] = (unsigned)(Ra * K + C) * 2u; voffB[i] = (unsigned)(Rb * K + C) * 2u; }
    const size_t kstep = (size_t)(BK * 2);
    const size_t hstep = (size_t)HALF * K * 2;
    const unsigned ldsw = (unsigned)wid * 1024u;
    const int aoff = lds_byte(wr * 64 + fr, fq * 8), boff = lds_byte(wc * 32 + fr, fq * 8);
#define PG_SA(b, h) (((b) * 2 + (h)) * HTB)
#define PG_SB(b, h) ((4 + (b) * 2 + (h)) * HTB)
#define PG_STAGE(bufoff, gbase, voff) do { _Pragma("unroll") for (int _i = 0; _i < 2; ++_i) \
        __builtin_amdgcn_global_load_lds((const unsigned*)((const char*)(gbase) + (voff)[_i]), (LAS unsigned*)(lds + (bufoff) + ldsw + _i * 8192), 16, 0, 0); } while (0)
#define PG_LDA(dst, b, h) do { _Pragma("unroll") for (int m = 0; m < 4; ++m) _Pragma("unroll") for (int k = 0; k < 2; ++k) dst[m][k] = *(const LAS h16x8*)(lds + PG_SA(b, h) + aoff + m * 2048 + k * 1024); } while (0)
#define PG_LDB(dst, b, h) do { _Pragma("unroll") for (int n = 0; n < 2; ++n) _Pragma("unroll") for (int k = 0; k < 2; ++k) dst[n][k] = *(const LAS h16x8*)(lds + PG_SB(b, h) + boff + n * 2048 + k * 1024); } while (0)
#define PG_MMA(ai, bj, At, Bt) do { __builtin_amdgcn_s_setprio(1); _Pragma("unroll") for (int m = 0; m < 4; ++m) _Pragma("unroll") for (int n = 0; n < 2; ++n) _Pragma("unroll") for (int k = 0; k < 2; ++k) \
        acc[ai][bj][m][n] = __builtin_amdgcn_mfma_f32_16x16x32_f16(Bt[n][k], At[m][k], acc[ai][bj][m][n], 0, 0, 0); __builtin_amdgcn_s_setprio(0); } while (0)
#define PG_WAIT_V(n) asm volatile("s_waitcnt vmcnt(" #n ")" ::: "memory")
#define PG_WAIT_L(n) asm volatile("s_waitcnt lgkmcnt(" #n ")" ::: "memory")
#define PG_BAR __builtin_amdgcn_s_barrier()
#define PG_SCHED __builtin_amdgcn_sched_barrier(0)
    Unit cur, nxt; int ui = 0;
    if (!S.next(0, cur)) return;
    f32x4 acc[2][2][4][2];
#pragma unroll
    for (int a = 0; a < 2; ++a)
#pragma unroll
        for (int b = 0; b < 2; ++b)
#pragma unroll
            for (int m = 0; m < 4; ++m)
#pragma unroll
                for (int n = 0; n < 2; ++n) acc[a][b][m][n] = (f32x4){0.f, 0.f, 0.f, 0.f};
    h16x8 At[4][2], B0[2][2], B1[2][2];
    const char* cA = cur.A; const char* cB = cur.B;
    PG_STAGE(PG_SB(0, 0), cB, voffB); PG_STAGE(PG_SB(0, 1), cB + hstep, voffB); PG_STAGE(PG_SA(0, 0), cA, voffA); PG_STAGE(PG_SA(0, 1), cA + hstep, voffA);
    PG_STAGE(PG_SB(1, 0), cB + kstep, voffB); PG_STAGE(PG_SA(1, 0), cA + kstep, voffA); PG_STAGE(PG_SB(1, 1), cB + hstep + kstep, voffB);
    if (wr == 1) PG_BAR;
    PG_WAIT_V(8); PG_BAR;
    PG_WAIT_V(6); PG_BAR;
    for (;;) {
        const bool has_next = S.next(ui + 1, nxt);
        const char* nA = has_next ? nxt.A : cA; const char* nB = has_next ? nxt.B : cB;
        for (int t = 0; t < nt; t += 2) {
            const bool last = (t == nt - 2);
            const char* a1 = cA + (size_t)(t + 1) * kstep;
            const char* a2 = last ? nA : cA + (size_t)(t + 2) * kstep; const char* b2 = last ? nB : cB + (size_t)(t + 2) * kstep;
            const char* a3 = a2 + kstep; const char* b3 = b2 + kstep;
            PG_LDB(B0, 0, 0); PG_LDB(B1, 0, 1); PG_SCHED; PG_LDA(At, 0, 0); PG_STAGE(PG_SA(1, 1), a1 + hstep, voffA);
            PG_WAIT_V(8); PG_WAIT_L(0); PG_BAR; PG_MMA(0, 0, At, B0); PG_MMA(0, 1, At, B1); PG_BAR; PG_SCHED;
            PG_LDA(At, 0, 1); PG_STAGE(PG_SB(0, 0), b2, voffB); PG_STAGE(PG_SB(0, 1), b2 + hstep, voffB); PG_STAGE(PG_SA(0, 0), a2, voffA);
            PG_WAIT_V(8); PG_WAIT_L(0); PG_BAR; PG_MMA(1, 0, At, B0); PG_MMA(1, 1, At, B1); PG_BAR; PG_SCHED;
            PG_LDB(B0, 1, 0); PG_LDB(B1, 1, 1); PG_SCHED; PG_LDA(At, 1, 0); PG_STAGE(PG_SA(0, 1), a2 + hstep, voffA);
            PG_WAIT_V(8); PG_WAIT_L(0); PG_BAR; PG_MMA(0, 0, At, B0); PG_MMA(0, 1, At, B1); PG_BAR; PG_SCHED;
            PG_LDA(At, 1, 1); PG_STAGE(PG_SB(1, 0), b3, voffB); PG_STAGE(PG_SB(1, 1), b3 + hstep, voffB); PG_STAGE(PG_SA(1, 0), a3, voffA);
            PG_WAIT_V(8); PG_WAIT_L(0); PG_BAR; PG_MMA(1, 0, At, B0); PG_MMA(1, 1, At, B1); PG_BAR; PG_SCHED;
        }
        if (wr == 0) PG_BAR;
        E(acc, cur, wr, wc, fr, fq);
        if (!has_next) break;
#pragma unroll
        for (int a = 0; a < 2; ++a)
#pragma unroll
            for (int b = 0; b < 2; ++b)
#pragma unroll
                for (int m = 0; m < 4; ++m)
#pragma unroll
                    for (int n = 0; n < 2; ++n) acc[a][b][m][n] = (f32x4){0.f, 0.f, 0.f, 0.f};
        cur = nxt; cA = nA; cB = nB; ++ui;
        if (wr == 1) PG_BAR;
    }
    PG_WAIT_V(0);
    PG_BAR;
#undef PG_SA
#undef PG_SB
#undef PG_STAGE
#undef PG_LDA
#undef PG_LDB
#undef PG_MMA
#undef PG_WAIT_V
#undef PG_WAIT_L
#undef PG_BAR
#undef PG_SCHED
}
}

#define XB_TMO      128
#define XB_XCNT(j)  (256  + 64 * (j))
#define XB_XSUB(j)  (1280 + 64 * (j))
#define XB_XGEN(j)  (2304 + 64 * (j))
#define XB_TOP      3328
#define XB_TOPGEN   3392
#define XCD_BAR_WORDS 3456
#define XB_SPIN_CAP (1u << 22)
__device__ __forceinline__ unsigned xb_ld(unsigned* p)              { return __hip_atomic_load(p, __ATOMIC_RELAXED, __HIP_MEMORY_SCOPE_AGENT); }
__device__ __forceinline__ unsigned xb_add(unsigned* p, unsigned v) { return __hip_atomic_fetch_add(p, v, __ATOMIC_RELAXED, __HIP_MEMORY_SCOPE_AGENT); }
__device__ __forceinline__ unsigned xb_xcc_id() { return (unsigned)__builtin_amdgcn_s_getreg((3 << 11) | 20) & 0xFu; }
#define XB_SPIN(cond, bar) do { unsigned _sp = 0; while (cond) { __builtin_amdgcn_s_sleep(1); \
    if ((++_sp & 255u) == 0u) { if (xb_ld(&(bar)[XB_TMO])) break; if (_sp > XB_SPIN_CAP) { atomicAdd(&(bar)[XB_TMO], 1u); break; } } } } while (0)
struct XcdBarrier { unsigned* bar; unsigned x; volatile LAS unsigned* st; };
__device__ __forceinline__ XcdBarrier xcd_barrier_post(unsigned* bar, volatile LAS unsigned* st, int wave_s) {
    XcdBarrier b; b.bar = bar; b.x = xb_xcc_id(); b.st = st;
    if (fresh_tid_w(wave_s) == 0) (void)xb_add(&bar[XB_XCNT(b.x)], 1u);
    return b;
}
__device__ __forceinline__ void xcd_barrier_complete(unsigned* bar, unsigned x, unsigned& nloc, unsigned& nx) {
    const unsigned G = gridDim.x * gridDim.y * gridDim.z;
    unsigned sum, cnt, mine, sp = 0u;
    for (;;) {
        sum = 0u; cnt = 0u; mine = 0u;
#pragma unroll
        for (unsigned j = 0; j < 16; ++j) { const unsigned c = xb_ld(&bar[XB_XCNT(j)]); sum += c; cnt += (c > 0u) ? 1u : 0u; mine = (j == x) ? c : mine; }
        if (sum == G) break;
        __builtin_amdgcn_s_sleep(1);
        if ((++sp & 255u) == 0u) { if (xb_ld(&bar[XB_TMO])) break; if (sp > XB_SPIN_CAP) { atomicAdd(&bar[XB_TMO], 1u); break; } }
    }
    nloc = mine > 0u ? mine : 1u; nx = cnt > 0u ? cnt : 1u;
}
__device__ __forceinline__ void xcd_barrier(const XcdBarrier& b, int wave_s) {
    asm volatile("s_waitcnt vmcnt(0)" ::: "memory");
    __syncthreads();
    if (fresh_tid_w(wave_s) == 0) {
        unsigned* bar = b.bar;
        __builtin_amdgcn_s_waitcnt(0);
        unsigned nloc = b.st[0], nx = b.st[1];
        if (nloc == 0u) { xcd_barrier_complete(bar, b.x, nloc, nx); b.st[0] = nloc; b.st[1] = nx; }
        const unsigned old = xb_add(&bar[XB_XSUB(b.x)], 1u);
        const unsigned gen = old / nloc;
        if (old + 1u == (gen + 1u) * nloc) {
            __builtin_amdgcn_fence(__ATOMIC_RELEASE, "agent");
            asm volatile("s_waitcnt vmcnt(0)" ::: "memory");
            const unsigned og = xb_add(&bar[XB_TOP], 1u);
            const unsigned tg = og / nx;
            if (og + 1u == (tg + 1u) * nx) xb_add(&bar[XB_TOPGEN], 1u);
            else XB_SPIN(xb_ld(&bar[XB_TOPGEN]) == tg, bar);
            __builtin_amdgcn_fence(__ATOMIC_ACQUIRE, "agent");
            xb_add(&bar[XB_XGEN(b.x)], 1u);
            asm volatile("s_waitcnt vmcnt(0)" ::: "memory");
        } else {
            XB_SPIN(xb_ld(&bar[XB_XGEN(b.x)]) == gen, bar);
            __builtin_amdgcn_fence(__ATOMIC_ACQUIRE, "agent");
            asm volatile("s_waitcnt vmcnt(0)" ::: "memory");
        }
    }
    __syncthreads();
}

struct Args { const float* in[27]; float* out; unsigned char* ws; int ph_lo, ph_hi, li, pad; };
struct Frame {
    LAS unsigned char* lds; volatile LAS unsigned* MISC; gu32* ctl;
    int G, bx, wave_s;
    const float* const* in; float* out; unsigned char* ws;
};
#define IN_X_P 0
#define IN_X_S 1
#define IN_ST_WKV 2
#define IN_ST_SHIFT 3
#define IN_ST_CONV 4
#define IN_P_P 5
#define IN_P_S 6
#define IN_G_NORM 7
#define IN_W_IN 8
#define IN_MU 9
#define IN_WDEC0 10
#define IN_WDEC2 11
#define IN_WICL0 12
#define IN_WICL2 13
#define IN_KREM 14
#define IN_KREP 15
#define IN_RBONUS 16
#define IN_GNW 17
#define IN_GNB 18
#define IN_CONVW 19
#define IN_WOA 20
#define IN_WOB 21
#define IN_WOUT 22
#define IN_GPLE 23
#define IN_WPLEG 24
#define IN_WPLE 25
#define IN_GFINAL 26

__device__ __forceinline__ float wave_sum(float v) {
#pragma unroll
    for (int o = 1; o < 64; o <<= 1) v += __shfl_xor(v, o);
    return v;
}
__device__ __forceinline__ h16* rowptr16(float* out, unsigned char* ws, int slot, int row) {
    return row < NP ? (h16*)out + (size_t)slot * NP * D + (size_t)row * D : (h16*)(ws + WS_SIDE) + (size_t)slot * SIDE_STRIDE + (size_t)(row - NP) * D;
}

__device__ __forceinline__ int w1_src_col(int n) {
    const int tile = n >> 8, c = n & 255;
    if (tile < 16) { const int plane = tile >> 2; return (plane == 3 ? 3200 : plane * 1024) + (tile & 3) * 256 + c; }
    if (tile == 16) return c < 128 ? 3072 + c : -1;
    if (tile < 33) { const int tb = tile - 17, kind = 2 * (c >> 7) + ((c >> 2) & 1), ch = 64 * tb + 16 * ((c >> 5) & 3) + 4 * ((c >> 3) & 3) + (c & 3); return SHIFT_COLS + kind * 1024 + ch; }
    return SHIFT_COLS + 4096 + (n - 8448);
}
template <bool MAP>
__device__ __forceinline__ void p0_transpose_item(const float* W, int Nsrc, int K, h16* WT, const float* kscale, LAS float* scr, int kb, int nb, int lane) {
    const int k0 = 64 * kb, n0 = 32 * nb, n4 = (lane & 7) * 4;
    const int src = MAP ? w1_src_col(n0 + n4) : n0 + n4;
    f32x4 v[8];
#pragma unroll
    for (int i = 0; i < 8; ++i) { const int kk = 8 * i + (lane >> 3); v[i] = (f32x4){0.f, 0.f, 0.f, 0.f}; if (src >= 0) { v[i] = *(const f32x4*)(W + (size_t)(k0 + kk) * Nsrc + src); if (kscale) v[i] = v[i] * kscale[k0 + kk]; } }
#pragma unroll
    for (int i = 0; i < 8; ++i) { const int kk = 8 * i + (lane >> 3); LAS float* d = scr + kk * 33 + n4; d[0] = v[i].x; d[1] = v[i].y; d[2] = v[i].z; d[3] = v[i].w; }
    asm volatile("s_waitcnt lgkmcnt(0)" ::: "memory");
    const int c = lane & 7;
#pragma unroll
    for (int j = 0; j < 4; ++j) { const int nn = (lane >> 3) + 8 * j; const LAS float* s = scr + (8 * c) * 33 + nn;
        h16x8 o;
#pragma unroll
        for (int e = 0; e < 8; ++e) o[e] = (h16)s[e * 33];
        *(h16x8*)(WT + (size_t)(n0 + nn) * K + k0 + 8 * c) = o; }
    asm volatile("s_waitcnt lgkmcnt(0)" ::: "memory");
}
__device__ __forceinline__ void p0_prologue(Frame& F) {
    const int tid_ = fresh_tid_w(F.wave_s), lane_ = tid_ & 63, wave_ = F.wave_s;
    LAS float* scr = (LAS float*)(F.lds + wave_ * 16384);
    const int gw = F.bx * NWAVES + wave_, NGW = F.G * NWAVES;
    unsigned char* ws = F.ws;
    constexpr int I_W1 = (D / 64) * (W1_ROWS / 32), I_SQ = (D / 64) * (D / 32), I_PLE = (PLE / 64) * (D / 32);
    constexpr int NITEMS = I_W1 + 4 * I_SQ + I_PLE;
    for (int it = gw; it < I_W1; it += NGW)
        p0_transpose_item<true>(F.in[IN_W_IN], IN_COLS, D, (h16*)(ws + WS_W1T), F.in[IN_G_NORM], scr, it / (W1_ROWS / 32), it % (W1_ROWS / 32), lane_);
    (void)NITEMS;
    for (int i = F.bx * 512 + tid_; i < 65536; i += F.G * 512) { const int n = i >> 6, j = i & 63;
        ((h16*)(ws + WS_W2T))[i] = (h16)(-1.4426950408889634f * F.in[IN_WDEC2][(size_t)j * D + n]); ((h16*)(ws + WS_I2T))[i] = (h16)(-1.4426950408889634f * F.in[IN_WICL2][(size_t)j * D + n]); }
    h16* XH = (h16*)(ws + WS_XH); float* rstd0 = (float*)(ws + WS_RSTD0);
    for (int m0 = 4 * gw; m0 < MP; m0 += 4 * NGW) {
        f32x4 v[4][4]; float s[4];
#pragma unroll
        for (int r = 0; r < 4; ++r) { const int m = m0 + r;
            if (m < MREAL) {
                const float* xrow = m < NP ? F.in[IN_X_P] + (size_t)m * D : F.in[IN_X_S] + (size_t)(m - NP) * D;
#pragma unroll
                for (int j = 0; j < 4; ++j) v[r][j] = __builtin_nontemporal_load((const f32x4*)xrow + lane_ + 64 * j);
            } else {
#pragma unroll
                for (int j = 0; j < 4; ++j) v[r][j] = (f32x4){0.f, 0.f, 0.f, 0.f};
            } }
#pragma unroll
        for (int r = 0; r < 4; ++r) { float t = 0.f;
#pragma unroll
            for (int j = 0; j < 4; ++j) t += (v[r][j].x * v[r][j].x + v[r][j].y * v[r][j].y) + (v[r][j].z * v[r][j].z + v[r][j].w * v[r][j].w);
            s[r] = wave_sum(t); }
#pragma unroll
        for (int r = 0; r < 4; ++r) { const int m = m0 + r;
            const float ms = s[r] * (1.0f / D) + EPS, rstd = __builtin_amdgcn_rsqf(ms);
            if (lane_ == 0) rstd0[m] = m < MREAL ? ms * rstd : 0.f;
            h16x4* o = (h16x4*)(XH + (size_t)m * D) + lane_;
#pragma unroll
            for (int j = 0; j < 4; ++j) o[64 * j] = cvt4(v[r][j] * rstd); }
    }
}
__device__ __forceinline__ void p0_deferred(Frame& F, int c, int nw) {
    const int tid_ = fresh_tid_w(F.wave_s), lane_ = tid_ & 63, wave_ = F.wave_s;
    LAS float* scr = (LAS float*)(F.lds + wave_ * 16384);
    const int gw = c * NWAVES + wave_, NGW = nw * NWAVES;
    unsigned char* ws = F.ws;
    constexpr int I_SQ = (D / 64) * (D / 32), I_PLE = (PLE / 64) * (D / 32);
    for (int it = gw; it < 4 * I_SQ + I_PLE; it += NGW) {
        int r = it;
        if (r < I_SQ) { p0_transpose_item<false>(F.in[IN_WOA], D, D, (h16*)(ws + WS_WOA), nullptr, scr, r / 32, r % 32, lane_); continue; } r -= I_SQ;
        if (r < I_SQ) { p0_transpose_item<false>(F.in[IN_WOB], D, D, (h16*)(ws + WS_WOB), nullptr, scr, r / 32, r % 32, lane_); continue; } r -= I_SQ;
        if (r < I_SQ) { p0_transpose_item<false>(F.in[IN_WOUT], D, D, (h16*)(ws + WS_WOUT), nullptr, scr, r / 32, r % 32, lane_); continue; } r -= I_SQ;
        if (r < I_SQ) { p0_transpose_item<false>(F.in[IN_WPLEG], D, D, (h16*)(ws + WS_WGATE), F.in[IN_GPLE], scr, r / 32, r % 32, lane_); continue; } r -= I_SQ;
        p0_transpose_item<false>(F.in[IN_WPLE], D, PLE, (h16*)(ws + WS_WPLE), nullptr, scr, r / 32, r % 32, lane_);
    }
    h16* PH = (h16*)(ws + WS_PH);
    for (int m0 = 8 * gw; m0 < MP; m0 += 8 * NGW) {
        f32x4 pv[8];
#pragma unroll
        for (int r = 0; r < 8; ++r) { const int m = m0 + r; pv[r] = (f32x4){0.f, 0.f, 0.f, 0.f};
            if (m < MREAL) pv[r] = __builtin_nontemporal_load((const f32x4*)(m < NP ? F.in[IN_P_P] + (size_t)m * PLE : F.in[IN_P_S] + (size_t)(m - NP) * PLE) + lane_); }
#pragma unroll
        for (int r = 0; r < 8; ++r) ((h16x4*)(PH + (size_t)(m0 + r) * PLE))[lane_] = cvt4(pv[r]);
    }
    asm volatile("s_waitcnt vmcnt(0)" ::: "memory");
    __syncthreads();
}

__device__ __forceinline__ char* slotbase(float* out, unsigned char* ws, int slot, bool prompt_tile) {
    return prompt_tile ? (char*)out + (size_t)slot * NP * D * 2 : (char*)(ws + WS_SIDE) + (size_t)slot * SIDE_STRIDE * 2 - (size_t)NP * D * 2;
}
__device__ __forceinline__ float dpp_row_shr1(float x) { return __builtin_bit_cast(float, __builtin_amdgcn_update_dpp(0, __builtin_bit_cast(int, x), 0x111, 0xf, 0xf, true)); }
struct Epi1 {
    float* out; unsigned char* ws; const float* rstd0; const float* cw; LAS unsigned char* lx;
    __device__ __forceinline__ void conv_tile(const f32x4 (&acc)[2][2][4][2], const pg::Unit& u, int wr, int wc, int fr, int fq) const {
        const int ch = 64 * (u.pn - 17) + 16 * wc + 4 * fq;
        f32x4 uu[2][4], gz[2][4];
#pragma unroll
        for (int ai = 0; ai < 2; ++ai)
#pragma unroll
            for (int m = 0; m < 4; ++m) {
                const int row = u.pm * 256 + ai * 128 + wr * 64 + fr * 4 + m;
                const f32x4 gb = acc[ai][0][m][0], gc = acc[ai][0][m][1], xb = acc[ai][1][m][0], zb = acc[ai][1][m][1];
                uu[ai][m] = gc * xb;
#pragma unroll
                for (int j = 0; j < 4; ++j) gz[ai][m][j] = gb[j] * fsilu(zb[j]);
                const int t = row & (SEQ - 1);
                if (t >= SEQ - 2) *(f32x4*)(out + OFF_CONV_P + ((size_t)(row >> 12) * 2 + (t - (SEQ - 2))) * D + ch) = uu[ai][m];
            }
        LAS float* X = (LAS float*)lx;
        if (fr == 15) {
#pragma unroll
            for (int ai = 0; ai < 2; ++ai) { *(LAS f32x4*)(X + ((2 * ai + wr) * 2 + 0) * 64 + 16 * wc + 4 * fq) = uu[ai][2]; *(LAS f32x4*)(X + ((2 * ai + wr) * 2 + 1) * 64 + 16 * wc + 4 * fq) = uu[ai][3]; }
            if (wr == 1) { float* su = (float*)(ws + WS_SIDEU) + (size_t)u.pm * 2048 + ch; *(f32x4*)su = uu[1][2]; *(f32x4*)(su + 1024) = uu[1][3]; }
        }
        asm volatile("s_waitcnt lgkmcnt(0)" ::: "memory"); __builtin_amdgcn_s_barrier(); asm volatile("" ::: "memory");
        const f32x4 c0 = *(const f32x4*)(cw + ch), c1 = *(const f32x4*)(cw + D + ch), c2 = *(const f32x4*)(cw + 2 * D + ch);
        const bool first = (u.pm & 15) == 0;
#pragma unroll
        for (int ai = 0; ai < 2; ++ai) {
            f32x4 q1, q2;
#pragma unroll
            for (int j = 0; j < 4; ++j) { q1[j] = dpp_row_shr1(uu[ai][3][j]); q2[j] = dpp_row_shr1(uu[ai][2][j]); }
            const int blk = 2 * ai + wr;
            if (fr == 0) {
                if (blk > 0) { q2 = *(const LAS f32x4*)(X + ((blk - 1) * 2 + 0) * 64 + 16 * wc + 4 * fq); q1 = *(const LAS f32x4*)(X + ((blk - 1) * 2 + 1) * 64 + 16 * wc + 4 * fq); }
                else { q2 = (f32x4){0.f, 0.f, 0.f, 0.f}; q1 = q2; }
            }
#pragma unroll
            for (int m = 0; m < 4; ++m) {
                const int row = u.pm * 256 + ai * 128 + wr * 64 + fr * 4 + m;
                const f32x4 p1 = m >= 1 ? uu[ai][m - 1] : q1, p2 = m >= 2 ? uu[ai][m - 2] : (m == 1 ? q1 : q2);
                const f32x4 cv = c2 * uu[ai][m] + c1 * p1 + c0 * p2;
                if (blk == 0 && fr == 0 && m < 2 && !first) {
                    float* sp = (float*)(ws + WS_SIDEP) + (size_t)u.pm * 2048 + m * 1024 + ch; float* sg = (float*)(ws + WS_SIDEG) + (size_t)u.pm * 2048 + m * 1024 + ch;
                    *(f32x4*)sp = gz[ai][m] * cv; *(f32x4*)sg = gz[ai][m];
                } else *(h16x4*)((char*)ws + WS_ACTB + (unsigned)(row * D + ch) * 2u) = cvt4(gz[ai][m] * cv);
            }
        }
    }
    __device__ __forceinline__ void operator()(const f32x4 (&acc)[2][2][4][2], const pg::Unit& u, int wr, int wc, int fr, int fq) const {
        const int tile = u.pn; const bool ptile = u.pm < NMT - 1;
        if (tile >= 17 && ptile) { conv_tile(acc, u, wr, wc, fr, fq); return; }
        const int plane = tile >> 2;
        char* pbase = (char*)ws + (plane == 0 ? WS_R : plane == 1 ? WS_K : plane == 2 ? WS_V : WS_Z);
        char* ub = slotbase(out, ws, 0, ptile); char* gzb = slotbase(out, ws, 1, ptile);
#pragma unroll
        for (int ai = 0; ai < 2; ++ai)
#pragma unroll
            for (int m = 0; m < 4; ++m) {
                const int row = u.pm * 256 + ai * 128 + wr * 64 + fr * 4 + m;
                int endj = -1, bidx = 0; bool samp = false;
                if (row < NP) { const int t = row & (SEQ - 1); if (t >= SEQ - 2) { endj = t - (SEQ - 2); bidx = row >> 12; } }
                else if (row < MREAL) { const int rr = row - NP, t = rr & (DSEQ - 1); if (t >= DSEQ - 2) { endj = t - (DSEQ - 2); bidx = rr >> 4; samp = true; } }
                if (tile < 17) {
#pragma unroll
                    for (int bj = 0; bj < 2; ++bj) {
                        const int cl = bj * 128 + wc * 32 + 8 * fq;
                        const f32x4 v0 = acc[ai][bj][m][0], v1 = acc[ai][bj][m][1];
                        int scol;
                        if (tile < 16) { *(h16x8*)(pbase + (unsigned)(row * D + (tile & 3) * 256 + cl) * 2u) = cvt8(v0, v1); scol = (plane == 3 ? 3200 : plane * 1024) + (tile & 3) * 256 + cl; }
                        else { if (bj == 1) continue; *(h16x8*)((char*)ws + WS_WA + (unsigned)(row * 128 + cl) * 2u) = cvt8(v0, v1); scol = 3072 + cl; }
                        if (endj == 1) { float* o = out + (samp ? OFF_SHIFT_S : OFF_SHIFT_P) + (size_t)bidx * SHIFT_COLS + scol; *(f32x4*)o = v0; *(f32x4*)(o + 4) = v1; }
                    }
                } else {
                    const int ch = 64 * (tile - 17) + 16 * wc + 4 * fq;
                    const f32x4 gb = acc[ai][0][m][0], gc = acc[ai][0][m][1], xb = acc[ai][1][m][0], zb = acc[ai][1][m][1];
                    f32x4 uu = gc * xb, gz;
#pragma unroll
                    for (int j = 0; j < 4; ++j) gz[j] = gb[j] * fsilu(zb[j]);
                    const unsigned o = (unsigned)(row * D + ch) * 2u;
                    *(h16x4*)(ub + o) = cvt4(uu);
                    *(h16x4*)(gzb + o) = cvt4(gz);
                    if (endj >= 0) *(f32x4*)(out + (samp ? OFF_CONV_S : OFF_CONV_P) + ((size_t)bidx * 2 + endj) * D + ch) = uu;
                }
            }
    }
};
struct Sched1 {
    pg::TileOrder o; const char* A; const char* B;
    __device__ bool next(int i, pg::Unit& u) const { int pm, pn; if (!o.get(i, pm, pn)) return false; u.pm = pm; u.pn = pn; u.kind = 0;
        u.A = A + (size_t)pm * 256 * D * 2; u.B = B + (size_t)pn * 256 * D * 2; return true; }
};

struct Epi3 {
    float* out; unsigned char* ws; const float* rstd0;
    __device__ __forceinline__ void operator()(const f32x4 (&acc)[2][2][4][2], const pg::Unit& u, int wr, int wc, int fr, int fq) const {
        const bool ptile = u.pm < NMT - 1;
        char* ga = slotbase(out, ws, 0, ptile); char* gb = slotbase(out, ws, 1, ptile); char* mb = (char*)ws + WS_R;
#pragma unroll
        for (int ai = 0; ai < 2; ++ai)
#pragma unroll
            for (int m = 0; m < 4; ++m) {
                const int row = u.pm * 256 + ai * 128 + wr * 64 + m * 16 + fr;
#pragma unroll
                for (int bj = 0; bj < 2; ++bj) {
                    const unsigned o = (unsigned)(row * D + u.pn * 256 + bj * 128 + wc * 32 + 8 * fq) * 2u;
                    const f32x4 a0 = acc[ai][bj][m][0], a1 = acc[ai][bj][m][1];
                    if (u.kind < 2) {
                        const float rs = -1.4426950408889634f; f32x4 g0, g1;
#pragma unroll
                        for (int j = 0; j < 4; ++j) { g0[j] = __builtin_amdgcn_rcpf(1.0f + __builtin_amdgcn_exp2f(a0[j] * rs)); g1[j] = __builtin_amdgcn_rcpf(1.0f + __builtin_amdgcn_exp2f(a1[j] * rs)); }
                        *(h16x8*)((u.kind == 0 ? ga : gb) + o) = cvt8(g0, g1);
                    } else if (u.kind == 3) {
                        const h16x8 g = *(const h16x8*)(gb + o);
                        const f32x4 g0 = up4(__builtin_shufflevector(g, g, 0, 1, 2, 3)), g1 = up4(__builtin_shufflevector(g, g, 4, 5, 6, 7));
                        *(h16x8*)(gb + o) = cvt8(g0 * a0, g1 * a1);
                    } else {
                        const h16x8 g = *(const h16x8*)(ga + o), t = *(const h16x8*)(gb + o);
                        const f32x4 t0 = up4(__builtin_shufflevector(t, t, 0, 1, 2, 3)), t1 = up4(__builtin_shufflevector(t, t, 4, 5, 6, 7));
                        const f32x4 g0 = up4(__builtin_shufflevector(g, g, 0, 1, 2, 3)), g1 = up4(__builtin_shufflevector(g, g, 4, 5, 6, 7));
                        { const u32x4 mv = __builtin_bit_cast(u32x4, cvt8(t0 + g0 * a0, t1 + g1 * a1)); char* mp = mb + o;
                          asm volatile("global_store_dwordx4 %0, %1, off sc1\n\ts_nop 1" :: "v"(mp), "v"(mv) : "memory"); }
                    }
                }
            }
    }
};
struct Sched3 {
    pg::TileOrder o; unsigned char* ws; int nk; int kinds;
    __device__ bool next(int i, pg::Unit& u) const { int pm, pn; const int q = i / nk, kind = (kinds >> (4 * (i - q * nk))) & 15; if (!o.get(q, pm, pn)) return false; u.pm = pm; u.pn = pn; u.kind = kind;
        const size_t aoff = kind < 2 ? WS_XH : kind == 2 ? WS_Z : WS_ACTB;
        const size_t boff = kind == 0 ? WS_W1T + (size_t)8448 * D * 2 : kind == 1 ? WS_W1T + (size_t)(8448 + 1024) * D * 2 : kind == 2 ? WS_WOA : WS_WOB;
        u.A = (const char*)ws + aoff + (size_t)pm * 256 * D * 2; u.B = (const char*)ws + boff + (size_t)pn * 256 * D * 2; return true; }
};
__device__ __forceinline__ void unit3(pg::Unit& u, unsigned char* ws, int pm, int pn, int kind) {
    u.pm = pm; u.pn = pn; u.kind = kind;
    const size_t aoff = kind < 2 ? WS_XH : kind == 2 ? WS_Z : WS_ACTB;
    const size_t boff = kind == 0 ? WS_W1T + (size_t)8448 * D * 2 : kind == 1 ? WS_W1T + (size_t)(8448 + 1024) * D * 2 : kind == 2 ? WS_WOA : WS_WOB;
    u.A = (const char*)ws + aoff + (size_t)pm * 256 * D * 2; u.B = (const char*)ws + boff + (size_t)pn * 256 * D * 2;
}
struct SchedH {
    pg::TileOrder o; unsigned char* ws; int c;
    __device__ bool next(int i, pg::Unit& u) const {
        const int nreg = c < 4 ? 2 : 4; int q, kind;
        if (i < 3 * nreg) { const int r = i / 3, kk = i - 3 * r; q = c + 128 * r; kind = kk == 2 ? 3 : kk; }
        else { const int e = i - 3 * nreg;
            if (c >= 4 && c < 12 && e == 0) { const int ob = c - 4; q = (ob & 3) + 128 * (2 + (ob >> 2)); kind = 0; }
            else if (c >= 12 && c < 20 && e < 2) { const int ob = c - 12; q = (ob & 3) + 128 * (2 + (ob >> 2)); kind = e == 0 ? 1 : 3; }
            else return false; }
        int pm, pn; if (!o.get_linear(q, pm, pn)) return false;
        unit3(u, ws, pm, pn, kind); return true; }
};
struct SchedList3 { unsigned char* ws; int pm, pn, n, kinds;
    __device__ bool next(int i, pg::Unit& u) const { if (i >= n) return false; unit3(u, ws, pm, pn, (kinds >> (4 * i)) & 15); return true; } };
struct SchedOne { const char* A; const char* B; int pm, pn, K;
    __device__ bool next(int i, pg::Unit& u) const { if (i >= 1) return false; u.pm = pm; u.pn = pn; u.kind = 0; u.A = A + (size_t)pm * 256 * K * 2; u.B = B + (size_t)pn * 256 * K * 2; return true; } };
__device__ __forceinline__ void sub_barrier(unsigned* cnt, unsigned n, int wave_s) {
    asm volatile("s_waitcnt vmcnt(0)" ::: "memory");
    __syncthreads();
    if (fresh_tid_w(wave_s) == 0) {
        __builtin_amdgcn_fence(__ATOMIC_RELEASE, "agent");
        asm volatile("s_waitcnt vmcnt(0)" ::: "memory");
        xb_add(cnt, 1u);
        unsigned sp = 0; while (xb_ld(cnt) < n) {     __builtin_amdgcn_s_sleep(2); if (++sp > (1u << 24)) break; }
        __builtin_amdgcn_fence(__ATOMIC_ACQUIRE, "agent");
        asm volatile("s_waitcnt vmcnt(0)" ::: "memory");
    }
    __syncthreads();
}

__device__ __forceinline__ float ssq_total(const float* ssq, int row, int fq) {
    const f32x4 v = *(const f32x4*)(ssq + (size_t)row * 16 + 4 * fq); float s = (v.x + v.y) + (v.z + v.w);
    s += __shfl_xor(s, 16); s += __shfl_xor(s, 32); return s;
}
__device__ __forceinline__ void st16_wt(char* p, h16x8 v) { const u32x4 d = __builtin_bit_cast(u32x4, v); asm volatile("global_store_dwordx4 %0, %1, off sc1\n\ts_nop 1" :: "v"(p), "v"(d) : "memory"); }
struct Epi4 {
    unsigned char* ws; const float* xp; const float* xs;
    __device__ __forceinline__ void operator()(const f32x4 (&acc)[2][2][4][2], const pg::Unit& u, int wr, int wc, int fr, int fq) const {
        float* ssq = (float*)(ws + WS_SSQ1);
        const char* xb = (const char*)ws + WS_XH; char* hb = (char*)ws + WS_K;
#pragma unroll
        for (int ai = 0; ai < 2; ++ai)
#pragma unroll
            for (int m = 0; m < 4; ++m) {
                const int row = u.pm * 256 + ai * 128 + wr * 64 + m * 16 + fr;
                const bool ok = row < MREAL; float s = 0.f;
                const float rms = ((const float*)(ws + WS_RSTD0))[ok ? row : 0];
#pragma unroll
                for (int bj = 0; bj < 2; ++bj) {
                    const unsigned e = (unsigned)(row * D + u.pn * 256 + bj * 128 + wc * 32 + 8 * fq);
                    if (ok) {
                        const h16x8 xh = *(const h16x8*)(xb + e * 2u);
                        const f32x4 x0 = up4(__builtin_shufflevector(xh, xh, 0, 1, 2, 3)) * rms + acc[ai][bj][m][0], x1 = up4(__builtin_shufflevector(xh, xh, 4, 5, 6, 7)) * rms + acc[ai][bj][m][1];
                        st16_wt(hb + e * 2u, cvt8(x0, x1));
                        s += (x0.x * x0.x + x0.y * x0.y) + (x0.z * x0.z + x0.w * x0.w) + (x1.x * x1.x + x1.y * x1.y) + (x1.z * x1.z + x1.w * x1.w);
                    }
                }
                s += __shfl_xor(s, 16); s += __shfl_xor(s, 32);
                if (ok && fq == 0) __hip_atomic_store(ssq + (unsigned)(row * 16 + u.pn * 4 + wc), s, __ATOMIC_RELAXED, __HIP_MEMORY_SCOPE_AGENT);
            }
    }
};
struct Sched4 { pg::TileOrder o; const char* A; const char* B;
    __device__ bool next(int i, pg::Unit& u) const { int pm, pn; if (!o.get(i, pm, pn)) return false; u.pm = pm; u.pn = pn; u.kind = 0;
        u.A = A + (size_t)pm * 256 * D * 2; u.B = B + (size_t)pn * 256 * D * 2; return true; } };
struct Epi5a {
    unsigned char* ws;
    __device__ __forceinline__ void operator()(const f32x4 (&acc)[2][2][4][2], const pg::Unit& u, int wr, int wc, int fr, int fq) const {
        const float* ssq = (const float*)(ws + WS_SSQ1); char* gbp = (char*)ws + WS_V;
#pragma unroll
        for (int ai = 0; ai < 2; ++ai)
#pragma unroll
            for (int m = 0; m < 4; ++m) {
                const int row = u.pm * 256 + ai * 128 + wr * 64 + m * 16 + fr;
                const int rowc = row < MREAL ? row : MREAL - 1;
                const float rs = -1.4426950408889634f * __builtin_amdgcn_rsqf(ssq_total(ssq, rowc, fq) * (1.0f / D) + EPS);
#pragma unroll
                for (int bj = 0; bj < 2; ++bj) {
                    const unsigned e = (unsigned)(row * D + u.pn * 256 + bj * 128 + wc * 32 + 8 * fq); f32x4 g0, g1;
#pragma unroll
                    for (int j = 0; j < 4; ++j) { g0[j] = __builtin_amdgcn_rcpf(1.0f + __builtin_amdgcn_exp2f(acc[ai][bj][m][0][j] * rs)); g1[j] = __builtin_amdgcn_rcpf(1.0f + __builtin_amdgcn_exp2f(acc[ai][bj][m][1][j] * rs)); }
                    *(h16x8*)(gbp + e * 2u) = cvt8(g0, g1);
                }
            }
    }
};
struct Epi5b {
    float* out; unsigned char* ws; const float* gfinal; gu32* ctl; LAS unsigned char* lx;
    __device__ __forceinline__ void operator()(f32x4 (&acc)[2][2][4][2], const pg::Unit& u, int wr, int wc, int fr_in, int fq_in) const {
        int fr = fr_in, fq = fq_in; asm volatile("" : "+v"(fr), "+v"(fq));
        const char* gbp = (const char*)ws + WS_V; const char* xhp = (const char*)ws + WS_K; char* ob = (char*)out;
        LAS float* P = (LAS float*)lx; LAS float* S = (LAS float*)(lx + 4096);
        const int wid = wr * 4 + wc, lane = fq * 16 + fr;
        LAS float* Pb = P + (wr * 64 + fr) * 4 + wc; const LAS float* Sb = S + wr * 64 + fr;
#pragma unroll
        for (int ai = 0; ai < 2; ++ai)
#pragma unroll
            for (int m = 0; m < 4; ++m) {
                const int rl = ai * 128 + wr * 64 + m * 16 + fr, row = u.pm * 256 + rl;
                const bool ok = row < MREAL; float s = 0.f;
#pragma unroll
                for (int bj = 0; bj < 2; ++bj) {
                    const unsigned e = (unsigned)(row * D + u.pn * 256 + bj * 128 + wc * 32 + 8 * fq);
                    if (ok) {
                        const h16x8 g = *(const h16x8*)(gbp + e * 2u), xh = *(const h16x8*)(xhp + e * 2u);
                        const f32x4 g0 = up4(__builtin_shufflevector(g, g, 0, 1, 2, 3)), g1 = up4(__builtin_shufflevector(g, g, 4, 5, 6, 7));
                        const f32x4 x0 = up4(__builtin_shufflevector(xh, xh, 0, 1, 2, 3)) + g0 * acc[ai][bj][m][0], x1 = up4(__builtin_shufflevector(xh, xh, 4, 5, 6, 7)) + g1 * acc[ai][bj][m][1];
                        acc[ai][bj][m][0] = x0; acc[ai][bj][m][1] = x1;
                        s += (x0.x * x0.x + x0.y * x0.y) + (x0.z * x0.z + x0.w * x0.w) + (x1.x * x1.x + x1.y * x1.y) + (x1.z * x1.z + x1.w * x1.w);
                    }
                }
                s += __shfl_xor(s, 16); s += __shfl_xor(s, 32);
                if (fq == 0) Pb[(ai * 128 + m * 16) * 4] = s;
                if (m & 1) asm volatile("" ::: "memory");
            }
        asm volatile("s_waitcnt lgkmcnt(0)" ::: "memory"); __builtin_amdgcn_s_barrier(); asm volatile("" ::: "memory");
        const int rrow = wid * 32 + (lane & 31);
        float* slots = (float*)(ws + WS_XCH) + ((size_t)u.pm * 256 + rrow) * 4;
        if (lane < 32) { const f32x4 p4 = *(const LAS f32x4*)(P + rrow * 4); __hip_atomic_store(slots + u.pn, (p4.x + p4.y) + (p4.z + p4.w), __ATOMIC_RELAXED, __HIP_MEMORY_SCOPE_AGENT); }
        asm volatile("s_waitcnt vmcnt(0)" ::: "memory");
        unsigned* cnt = (unsigned*)(ctl + CW_PANEL + 64 * u.pm);
        if (lane == 0) __hip_atomic_fetch_add(cnt, 1u, __ATOMIC_RELAXED, __HIP_MEMORY_SCOPE_AGENT);
        if (wid == 0) {
            unsigned sp = 0;
            while ((unsigned)__builtin_amdgcn_readfirstlane((int)__hip_atomic_load(cnt, __ATOMIC_RELAXED, __HIP_MEMORY_SCOPE_AGENT)) < 32u) { __builtin_amdgcn_s_sleep(2); if (++sp > (1u << 22)) break; }
            __builtin_amdgcn_fence(__ATOMIC_ACQUIRE, "agent");
        }
        asm volatile("s_waitcnt vmcnt(0) lgkmcnt(0)" ::: "memory"); __builtin_amdgcn_s_barrier(); asm volatile("" ::: "memory");
        if (lane < 32) { float t = 0.f;
#pragma unroll
            for (int q = 0; q < 4; ++q) t += __hip_atomic_load(slots + q, __ATOMIC_RELAXED, __HIP_MEMORY_SCOPE_AGENT);
            S[rrow] = __builtin_amdgcn_rsqf(t * (1.0f / D) + EPS); }
        asm volatile("s_waitcnt vmcnt(0) lgkmcnt(0)" ::: "memory"); __builtin_amdgcn_s_barrier(); asm volatile("" ::: "memory");
#pragma unroll
        for (int ai = 0; ai < 2; ++ai)
#pragma unroll
            for (int m = 0; m < 4; ++m) {
                const int rl = ai * 128 + wr * 64 + m * 16 + fr, row = u.pm * 256 + rl;
                const float rs = Sb[ai * 128 + m * 16];
                if (row < MREAL) {
#pragma unroll
                    for (int bj = 0; bj < 2; ++bj) {
                        const int col = u.pn * 256 + bj * 128 + wc * 32 + 8 * fq; const unsigned e = (unsigned)(row * D + col);
                        *(f32x4*)(ob + e * 4u) = acc[ai][bj][m][0] * rs * *(const f32x4*)(gfinal + col); *(f32x4*)(ob + e * 4u + 16) = acc[ai][bj][m][1] * rs * *(const f32x4*)(gfinal + col + 4);
                    }
                }
            }
        asm volatile("s_waitcnt lgkmcnt(0)" ::: "memory"); __builtin_amdgcn_s_barrier(); asm volatile("" ::: "memory");
    }
};
struct Sched5b { pg::TileOrder o; const char* A; const char* B;
    __device__ bool next(int i, pg::Unit& u) const { int pm, pn; if (!o.get(i, pm, pn)) return false; u.pm = pm; u.pn = pn; u.kind = 0;
        u.A = A + (size_t)pm * 256 * PLE * 2; u.B = B + (size_t)pn * 256 * PLE * 2; return true; } };

namespace s2 {
constexpr int RS = 72, MAT_B = 16 * RS * 2;
constexpr int CH_QT = 0, CH_RT = MAT_B, CH_BT = 2 * MAT_B, CH_KT = 3 * MAT_B, CH_VT = 4 * MAT_B, CH_MK = 5 * MAT_B, CH_NK = CH_MK + 512, CH_NB = CH_NK + 512, CH_TI = CH_NB + 512,
              CH_E8 = CH_TI + 512, CH_E16 = CH_E8 + 256, CH_BYTES = CH_E16 + 256;
constexpr int OFF_TW = 4 * CH_BYTES, OFF_AL = OFF_TW + 64 * RS * 2, OFF_YY = OFF_TW  , OFF_BON = OFF_AL + 64 * RS * 2, OFF_N2 = OFF_BON + 512, OFF_SZ = OFF_N2 + 512,
              OFF_CT = OFF_SZ + 8192, OFF_W2L = OFF_CT + 25 * 256, OFF_I2L = OFF_W2L + 64 * RS * 2, OFF_RAW = OFF_I2L + 64 * RS * 2;
constexpr int RAW_PLANE = 9216, RAW_R = 0, RAW_K = RAW_PLANE, RAW_V = 2 * RAW_PLANE, RAW_Z = 3 * RAW_PLANE, RAW_W = 4 * RAW_PLANE, RAW_BYTES = 4 * RAW_PLANE + 17408, OFF_END = OFF_RAW + RAW_BYTES;
static_assert(OFF_END <= SCAN_LDS_BYTES && 16384 <= 2 * 64 * RS * 2 && (OFF_RAW % 16) == 0, "scan LDS");
typedef short v4i16_t __attribute__((ext_vector_type(4)));
__device__ __forceinline__ f32x4 mm16(h16x4 a, h16x4 b, f32x4 c) {
    const h16x4 z = (h16x4){(h16)0.f, (h16)0.f, (h16)0.f, (h16)0.f};
    return __builtin_amdgcn_mfma_f32_16x16x32_f16(__builtin_shufflevector(a, z, 0, 1, 2, 3, 4, 5, 6, 7), __builtin_shufflevector(b, z, 0, 1, 2, 3, 4, 5, 6, 7), c, 0, 0, 0); }
__device__ __forceinline__ h16x4 ldtr(const LAS unsigned char* p) { return __builtin_bit_cast(h16x4, __builtin_amdgcn_ds_read_tr16_b64_v4i16((LAS v4i16_t*)p)); }
__device__ __forceinline__ h16x4 ldR(const LAS unsigned char* m, int row, int col) { return *(const LAS h16x4*)(m + (row * RS + col) * 2); }
__device__ __forceinline__ h16x4 ldS(const LAS unsigned char* m, int row, int col) { return *(const LAS h16x4*)(m + (row * 16 + col) * 2); }
template <int CTRL> __device__ __forceinline__ float dppf(float x) { return __builtin_bit_cast(float, __builtin_amdgcn_update_dpp(0, __builtin_bit_cast(int, x), CTRL, 0xf, 0xf, true)); }
__device__ __forceinline__ f32x4 mix4_(h16x4 c, h16x4 d, f32x4 mu) {
    return (f32x4){ __builtin_fmaf((float)d[0], mu[0], (float)c[0]), __builtin_fmaf((float)d[1], mu[1], (float)c[1]), __builtin_fmaf((float)d[2], mu[2], (float)c[2]), __builtin_fmaf((float)d[3], mu[3], (float)c[3]) }; }
typedef _Float16 h16x2 __attribute__((ext_vector_type(2)));
typedef unsigned u32x2 __attribute__((ext_vector_type(2)));
typedef _Float16 h16x2 __attribute__((ext_vector_type(2)));
#define HMUL(hv, i, b) __builtin_fmaf((float)(hv)[i], (b), 0.0f)
#define HFMA(hv, i, b, c) __builtin_fmaf((float)(hv)[i], (b), (c))
__device__ __forceinline__ float rowscan16(float x) { x += dppf<0x111>(x); x += dppf<0x112>(x); x += dppf<0x114>(x); x += dppf<0x118>(x); return x; }
}
__device__ __forceinline__ void scan_prefetch(LAS unsigned char* L, const unsigned char* ws, int wave, int lane, int h, int rr, bool skip0) {
    using namespace s2;
    for (int q = wave; q < 53; q += NWAVES) {
        if (q < 36) { const int p = q / 9, qq = q - 9 * p, r0 = 8 * qq + (lane >> 3), c = (lane & 7) ^ (r0 & 7);
            int r = r0 > 64 ? 64 : r0; if (skip0 && r == 0) r = 1;
            const size_t pb = p == 0 ? WS_R : p == 1 ? WS_K : p == 2 ? WS_V : WS_Z;
            __builtin_amdgcn_global_load_lds((const unsigned*)(ws + pb + (size_t)(rr + r) * 2048 + 128 * h + 16 * c), (LAS unsigned*)(L + OFF_RAW + p * RAW_PLANE + qq * 1024), 16, 0, 0);
        } else { const int qq = q - 36, r0 = 4 * qq + (lane >> 4), c = lane & 15, cs = (c & 8) | ((c & 7) ^ (r0 & 7));
            int r = r0 > 64 ? 64 : r0; if (skip0 && r == 0) r = 1;
            __builtin_amdgcn_global_load_lds((const unsigned*)(ws + WS_WA + (size_t)(rr + r) * 256 + 16 * cs), (LAS unsigned*)(L + OFF_RAW + RAW_W + qq * 1024), 16, 0, 0);
        }
    }
}
__device__ __forceinline__ void scan_prefetch_fast(LAS unsigned char* L, const unsigned char* ws, int wave, int lane, int h, int rr) {
    using namespace s2;
    if (wave < 4) {
        const int r_l = lane >> 3, cx = (lane & 7) ^ r_l;
        const size_t pb = wave == 0 ? WS_R : wave == 1 ? WS_K : wave == 2 ? WS_V : WS_Z;
        const unsigned char* base = ws + pb + 128 * h + 16 * cx;
        const unsigned char* a = base + (size_t)(rr + r_l) * 2048;
        LAS unsigned char* d = L + OFF_RAW + wave * RAW_PLANE;
#pragma unroll
        for (int qq = 0; qq < 8; ++qq) __builtin_amdgcn_global_load_lds((const unsigned*)(a + qq * 16384), (LAS unsigned*)(d + qq * 1024), 16, 0, 0);
        __builtin_amdgcn_global_load_lds((const unsigned*)(base + (size_t)(rr + 64) * 2048), (LAS unsigned*)(d + 8 * 1024), 16, 0, 0);
    } else {
        const int w4 = wave - 4, r_l = lane >> 4, c = lane & 15;
#pragma unroll
        for (int i = 0; i < 5; ++i) { const int qq = w4 + 4 * i;
            if (qq < 17) { const int r0 = 4 * qq + r_l, r = qq == 16 ? 64 : r0, cs = (c & 8) | ((c & 7) ^ (r0 & 7));
                __builtin_amdgcn_global_load_lds((const unsigned*)(ws + WS_WA + (size_t)(rr + r) * 256 + 16 * cs), (LAS unsigned*)(L + OFF_RAW + RAW_W + qq * 1024), 16, 0, 0); } }
    }
}
#define SBAR() do { asm volatile("s_waitcnt lgkmcnt(0)" ::: "memory"); __builtin_amdgcn_s_barrier(); asm volatile("" ::: "memory"); } while (0)
__device__ __forceinline__ void scan_head_v2(Frame& F, int bh, bool dry) {
    using namespace s2;
    const bool samp = bh >= 128; const int b = (bh & 127) >> 4, h = bh & 15;
    const int T = samp ? DSEQ : SEQ, row0 = samp ? NP + DSEQ * b : SEQ * b;
    unsigned char* ws = F.ws; float* out = F.out;
    char* Zb = (char*)(ws + WS_Z);
    LAS unsigned char* L = F.lds;
    const int tid = fresh_tid_w(F.wave_s), lane = tid & 63, wave = F.wave_s, c15 = lane & 15, g = lane >> 4;
    const int cw = wave & 3, hf = wave >> 2;
    scan_prefetch(L, ws, wave, lane, h, row0 - 1, true);
    for (int i = tid; i < 25 * 64; i += NWAVES * 64) { const int kind = i >> 6, k = i & 63, hk = 64 * h + k; float v;
        const float* mu = F.in[IN_MU]; const float* sh = F.in[IN_ST_SHIFT] + (size_t)b * SHIFT_COLS;
        switch (kind) { case 0: v = mu[hk]; break; case 1: v = mu[1024 + hk]; break; case 2: v = mu[2048 + hk]; break; case 3: v = mu[3200 + hk]; break;
            case 4: v = F.in[IN_KREM][hk]; break; case 5: v = F.in[IN_KREP][hk]; break; case 6: v = -1.4426950408889634f * F.in[IN_WDEC0][hk]; break; case 7: v = -1.4426950408889634f * F.in[IN_WICL0][hk]; break;
            case 8: v = F.in[IN_RBONUS][hk]; break; case 9: v = F.in[IN_GNW][hk]; break; case 10: v = F.in[IN_GNB][hk]; break; case 11: v = mu[3072 + k]; break; case 12: v = mu[3136 + k]; break;
            case 13: v = samp ? sh[hk] : 0.f; break; case 14: v = samp ? sh[1024 + hk] : 0.f; break; case 15: v = samp ? sh[2048 + hk] : 0.f; break; case 16: v = samp ? sh[3200 + hk] : 0.f; break;
            case 17: v = samp ? sh[3072 + k] : 0.f; break; case 18: v = samp ? sh[3136 + k] : 0.f; break;
            case 19: v = 1.f - F.in[IN_KREP][hk]; break; case 20: v = 1.f - mu[1024 + hk]; break; case 21: v = 1.f - mu[2048 + hk]; break; case 22: v = 1.f - mu[3200 + hk]; break;
            case 23: v = 1.f - mu[3072 + k]; break; default: v = 1.f - mu[3136 + k]; break; }
        *(LAS float*)(L + OFF_CT + i * 4) = v; }
    __syncthreads();
    for (int i = tid; i < 8 * 64; i += NWAVES * 64) { const int kind = i >> 6, k = i & 63;
        const int src = kind == 0 ? 0 : kind == 1 ? 1 : kind == 2 ? 2 : kind == 3 ? 3 : kind == 4 ? 4 : kind == 5 ? 8 : kind == 6 ? 11 : 12;
        const float v = *(const LAS float*)(L + OFF_CT + (src * 64 + k) * 4);
        asm volatile("" ::: "memory");
        *(LAS h16*)(L + OFF_CT + 20 * 256 + i * 2) = (h16)v; }
    { const int k = tid >> 3, ch = tid & 7;
      *(LAS h16x8*)(L + OFF_W2L + (k * RS + 8 * ch) * 2) = *(const h16x8*)((const h16*)(ws + WS_W2T) + (size_t)(64 * h + k) * 64 + 8 * ch);
      *(LAS h16x8*)(L + OFF_I2L + (k * RS + 8 * ch) * 2) = *(const h16x8*)((const h16*)(ws + WS_I2T) + (size_t)(64 * h + k) * 64 + 8 * ch); }
#define CT4(kind, k) (*(const LAS f32x4*)(L + OFF_CT + ((kind) * 64 + (k)) * 4))
#define CTH4(kind, k) (*(const LAS h16x4*)(L + OFF_CT + 20 * 256 + ((kind) * 64 + (k)) * 2))
#define CTH8(kind, k) (*(const LAS h16x8*)(L + OFF_CT + 20 * 256 + ((kind) * 64 + (k)) * 2))
#define CT1(kind, k) (*(const LAS float*)(L + OFF_CT + ((kind) * 64 + (k)) * 4))
#define RAW8(p, row, kc) (*(const LAS h16x4*)(L + OFF_RAW + (p) * RAW_PLANE + (row) * 128 + ((((kc) >> 3) ^ ((row) & 7)) << 4) + ((kc) & 7) * 2))
#define RAWW8(row, hc) (*(const LAS h16x4*)(L + OFF_RAW + RAW_W + (row) * 256 + (((((hc) >> 3) & 8) | ((((hc) >> 3) & 7) ^ ((row) & 7))) << 4) + ((hc) & 7) * 2))
    f32x4 S[4];
#pragma unroll
    for (int kt = 0; kt < 4; ++kt) { S[kt] = (f32x4){0.f, 0.f, 0.f, 0.f};
        if (samp && wave < 4) S[kt] = *(const f32x4*)(F.in[IN_ST_WKV] + ((size_t)(b * 16 + h) * 64 + 16 * wave + c15) * 64 + 16 * kt + 4 * g); }
    asm volatile("s_waitcnt vmcnt(0)" ::: "memory");
    SBAR();
    if (tid < 96) { const int kind = tid >> 4, c4 = (tid & 15) * 4;
        const int ctk = kind < 3 ? 13 + kind : kind == 3 ? 16 : 13 + kind; const h16x4 v = cvt4(CT4(ctk, c4));
        if (kind < 4) *(LAS h16x4*)(L + OFF_RAW + kind * RAW_PLANE + (((c4 >> 3) ^ 0) << 4) + (c4 & 7) * 2) = v;
        else { const int hc = (kind - 4) * 64 + c4; *(LAS h16x4*)(L + OFF_RAW + RAW_W + ((((hc >> 3) & 8) | (((hc >> 3) & 7) ^ 0)) << 4) + (hc & 7) * 2) = v; } }
    SBAR();
    for (int t0 = 0; t0 < T; t0 += 64) {
        const int nb = (T - t0) < 64 ? (T - t0) : 64, nch = nb >> 4;
        const bool cact = cw < nch;
        const int tl = 16 * cw + c15;
        LAS unsigned char* CB = L + cw * CH_BYTES;
        h16x4 rm[2], km[2], kapm[2], rbm[2]; float n2 = 0.f;
#define MIX4(c, p, mu4) mix4_((c), (p) - (c), (mu4))
        if (cact) {
#pragma unroll
            for (int kt = 0; kt < 2; ++kt) {
                const int kc = 32 * hf + 16 * kt + 4 * g;
                const h16x4 rc = RAW8(0, tl + 1, kc), kc4 = RAW8(1, tl + 1, kc), vc = RAW8(2, tl + 1, kc), wlc = RAWW8(tl + 1, kc), alc = RAWW8(tl + 1, 64 + kc);
                const h16x4 rp = RAW8(0, tl, kc), kp = RAW8(1, tl, kc), vp = RAW8(2, tl, kc), wlp = RAWW8(tl, kc), alp = RAWW8(tl, 64 + kc);
                const h16x4 r16 = rc + CTH4(0, kc) * (rp - rc), k16 = kc4 + CTH4(1, kc) * (kp - kc4), v16 = vc + CTH4(2, kc) * (vp - vc);
                const h16x4 wl16 = wlc + CTH4(6, kc) * (wlp - wlc), al16 = alc + CTH4(7, kc) * (alp - alc);
                const h16x4 kap16 = k16 * CTH4(4, kc), rb16 = r16 * CTH4(5, kc);
                rm[kt] = r16; km[kt] = k16; kapm[kt] = kap16; rbm[kt] = rb16;
                n2 = __builtin_amdgcn_fdot2(__builtin_shufflevector(kap16, kap16, 0, 1), __builtin_shufflevector(kap16, kap16, 0, 1), n2, false);
                n2 = __builtin_amdgcn_fdot2(__builtin_shufflevector(kap16, kap16, 2, 3), __builtin_shufflevector(kap16, kap16, 2, 3), n2, false);
                f32x4 tw;
#pragma unroll
                for (int i = 0; i < 4; ++i) tw[i] = __builtin_fmaf(-2.0f, __builtin_amdgcn_rcpf(1.0f + __builtin_amdgcn_exp2f(HMUL(wl16, i, 2.0f * 1.4426950408889634f))), 1.0f);
                *(LAS h16x4*)(L + OFF_TW + (tl * RS + kc) * 2) = cvt4(tw); *(LAS h16x4*)(L + OFF_AL + (tl * RS + kc) * 2) = al16;
                *(LAS h16x4*)(CB + CH_VT + (c15 * RS + kc) * 2) = v16;
            }
            n2 += __shfl_xor(n2, 16); n2 += __shfl_xor(n2, 32);
            if (g == 0) *(LAS float*)(L + OFF_N2 + (hf * 64 + tl) * 4) = n2;
        }
        {
            const int t = tid >> 3, vg = tid & 7, v0 = 8 * vg;
            if (t < nb) {
                const h16x8 zc8 = *(const LAS h16x8*)(L + OFF_RAW + RAW_Z + (t + 1) * 128 + ((vg ^ ((t + 1) & 7)) << 4));
                const h16x8 zp8 = *(const LAS h16x8*)(L + OFF_RAW + RAW_Z + t * 128 + ((vg ^ (t & 7)) << 4));
                const h16x8 z8 = zc8 + CTH8(3, v0) * (zp8 - zc8);
                float sv[8];
#pragma unroll
                for (int j = 0; j < 8; ++j) sv[j] = HMUL(z8, j, __builtin_amdgcn_rcpf(1.0f + __builtin_amdgcn_exp2f(HMUL(z8, j, -1.4426950408889634f))));
                *(LAS h16x8*)(L + OFF_SZ + (t * 64 + v0) * 2) = cvt8((f32x4){sv[0], sv[1], sv[2], sv[3]}, (f32x4){sv[4], sv[5], sv[6], sv[7]});
            }
        }
        SBAR();
        if (t0 + 64 < T) scan_prefetch_fast(L, ws, wave, lane, h, row0 + t0 + 63);
        if (cact) {
            f32x4 dacc[2], aacc[2];
#pragma unroll
            for (int kt = 0; kt < 2; ++kt) { dacc[kt] = CT4(6, 32 * hf + 16 * kt + 4 * g); aacc[kt] = CT4(7, 32 * hf + 16 * kt + 4 * g); }
#pragma unroll
            for (int jp = 0; jp < 2; ++jp) {
                const h16x4 tw0 = *(const LAS h16x4*)(L + OFF_TW + (tl * RS + 32 * jp + 4 * g) * 2), tw1 = *(const LAS h16x4*)(L + OFF_TW + (tl * RS + 32 * jp + 16 + 4 * g) * 2);
                const h16x4 al0 = *(const LAS h16x4*)(L + OFF_AL + (tl * RS + 32 * jp + 4 * g) * 2), al1 = *(const LAS h16x4*)(L + OFF_AL + (tl * RS + 32 * jp + 16 + 4 * g) * 2);
                const h16x8 twf = __builtin_shufflevector(tw0, tw1, 0, 1, 2, 3, 4, 5, 6, 7), alf = __builtin_shufflevector(al0, al1, 0, 1, 2, 3, 4, 5, 6, 7);
#pragma unroll
                for (int kt = 0; kt < 2; ++kt) { const int o = ((32 * hf + 16 * kt + c15) * RS + 32 * jp + 4 * g) * 2;
                    const h16x8 wf = __builtin_shufflevector(*(const LAS h16x4*)(L + OFF_W2L + o), *(const LAS h16x4*)(L + OFF_W2L + o + 32), 0, 1, 2, 3, 4, 5, 6, 7);
                    const h16x8 jf = __builtin_shufflevector(*(const LAS h16x4*)(L + OFF_I2L + o), *(const LAS h16x4*)(L + OFF_I2L + o + 32), 0, 1, 2, 3, 4, 5, 6, 7);
                    dacc[kt] = __builtin_amdgcn_mfma_f32_16x16x32_f16(wf, twf, dacc[kt], 0, 0, 0); aacc[kt] = __builtin_amdgcn_mfma_f32_16x16x32_f16(jf, alf, aacc[kt], 0, 0, 0); }
            }
            const float rn = __builtin_amdgcn_rsqf(fmaxf(*(const LAS float*)(L + OFF_N2 + tl * 4) + *(const LAS float*)(L + OFF_N2 + (64 + tl) * 4), 1e-24f));
            float bs = 0.f;
#pragma unroll
            for (int kt = 0; kt < 2; ++kt) {
                const int kc = 32 * hf + 16 * kt + 4 * g;
                const f32x4 krep = CT4(5, kc), omk = CT4(19, kc);
                f32x4 qt, rt, bt, kt4, e8v, e16v, khv, ktvv, bbv, Lcv, Lpv, refv;
#pragma unroll
                for (int i = 0; i < 4; ++i) {
                    const float lam = __builtin_amdgcn_rcpf(__builtin_fmaf(__builtin_amdgcn_exp2f(dacc[kt][i]), -1.0f / (DECAY_SCALE * 1.4426950408889634f), -1.0f / (DECAY_SCALE * 1.4426950408889634f))), a = __builtin_amdgcn_rcpf(1.0f + __builtin_amdgcn_exp2f(aacc[kt][i]));
                    khv[i] = HMUL(kapm[kt], i, rn); ktvv[i] = HMUL(km[kt], i, __builtin_fmaf(a, krep[i], omk[i])); bbv[i] = a * khv[i];
                    bs = HFMA(rbm[kt], i, ktvv[i], bs);
                    Lcv[i] = rowscan16(lam); Lpv[i] = Lcv[i] - lam;
                }
#pragma unroll
                for (int i = 0; i < 4; ++i) { refv[i] = __shfl(Lcv[i], (lane & 48) | 7); e16v[i] = __shfl(Lcv[i], (lane & 48) | 15); }
#pragma unroll
                for (int i = 0; i < 4; ++i) {
                    const float ea = __builtin_amdgcn_exp2f(Lpv[i] - refv[i]), eb = __builtin_amdgcn_exp2f(Lcv[i] - refv[i]), ec = __builtin_amdgcn_rcpf(eb);
                    qt[i] = khv[i] * ea; rt[i] = HMUL(rm[kt], i, eb); bt[i] = bbv[i] * ec; kt4[i] = ktvv[i] * ec; e8v[i] = refv[i];
                }
                const int o = (c15 * RS + kc) * 2;
                *(LAS h16x4*)(CB + CH_QT + o) = cvt4(qt); *(LAS h16x4*)(CB + CH_RT + o) = cvt4(rt); *(LAS h16x4*)(CB + CH_BT + o) = cvt4(bt); *(LAS h16x4*)(CB + CH_KT + o) = cvt4(kt4);
                if (c15 == 0) { *(LAS f32x4*)(CB + CH_E8 + kc * 4) = e8v; *(LAS f32x4*)(CB + CH_E16 + kc * 4) = e16v; }
            }
            bs += __shfl_xor(bs, 16); bs += __shfl_xor(bs, 32);
            if (g == 0) *(LAS float*)(L + OFF_BON + (hf * 64 + tl) * 4) = bs;
        }
        SBAR();
        if (cact) {
            h16x8 qf[2], bf[2];
#pragma unroll
            for (int p = 0; p < 2; ++p) { qf[p] = __builtin_shufflevector(ldR(CB + CH_QT, c15, 32 * p + 4 * g), ldR(CB + CH_QT, c15, 32 * p + 16 + 4 * g), 0, 1, 2, 3, 4, 5, 6, 7);
                bf[p] = __builtin_shufflevector(ldR(CB + CH_BT, c15, 32 * p + 4 * g), ldR(CB + CH_BT, c15, 32 * p + 16 + 4 * g), 0, 1, 2, 3, 4, 5, 6, 7); }
            const f32x4 z4 = (f32x4){0.f, 0.f, 0.f, 0.f};
            if (hf == 0) {
                f32x4 Dr = z4, Dc = z4;
#pragma unroll
                for (int p = 0; p < 2; ++p) { Dr = __builtin_amdgcn_mfma_f32_16x16x32_f16(bf[p], qf[p], Dr, 0, 0, 0); Dc = __builtin_amdgcn_mfma_f32_16x16x32_f16(qf[p], bf[p], Dc, 0, 0, 0); }
                f32x4 Xr, Xc, Id;
#pragma unroll
                for (int i = 0; i < 4; ++i) { const int u = 4 * g + i; Xr[i] = u < c15 ? -Dr[i] : 0.f; Xc[i] = c15 < u ? -Dc[i] : 0.f; Id[i] = u == c15 ? 1.f : 0.f; }
                const h16x4 hXr = cvt4(Xr), hXc = cvt4(Xc);
                const f32x4 X2c = mm16(hXr, hXc, z4), X2r = mm16(hXc, hXr, z4);
                const f32x4 S1c = Id + Xc, S1r = Id + Xr;
                const h16x4 hX2r = cvt4(X2r), hX2c = cvt4(X2c), hS1c = cvt4(S1c);
                const f32x4 S2c = mm16(hX2r, hS1c, S1c), S2r = mm16(hS1c, hX2r, S1r);
                const f32x4 X4c = mm16(hX2r, hX2c, z4), X4r = mm16(hX2c, hX2r, z4);
                const h16x4 hX4r = cvt4(X4r), hX4c = cvt4(X4c), hS2c = cvt4(S2c);
                const f32x4 S4c = mm16(hX4r, hS2c, S2c), S4r = mm16(hS2c, hX4r, S2r);
                const f32x4 X8r = mm16(hX4c, hX4r, z4);
                const f32x4 TIr = mm16(cvt4(S4c), cvt4(X8r), S4r);
                *(LAS h16x4*)(CB + CH_TI + (c15 * 16 + 4 * g) * 2) = cvt4(TIr);
            } else {
                h16x8 kf[2], rf[2];
#pragma unroll
                for (int p = 0; p < 2; ++p) { kf[p] = __builtin_shufflevector(ldR(CB + CH_KT, c15, 32 * p + 4 * g), ldR(CB + CH_KT, c15, 32 * p + 16 + 4 * g), 0, 1, 2, 3, 4, 5, 6, 7);
                    rf[p] = __builtin_shufflevector(ldR(CB + CH_RT, c15, 32 * p + 4 * g), ldR(CB + CH_RT, c15, 32 * p + 16 + 4 * g), 0, 1, 2, 3, 4, 5, 6, 7); }
                f32x4 mk = z4, nk = z4, nbm = z4;
#pragma unroll
                for (int p = 0; p < 2; ++p) { mk = __builtin_amdgcn_mfma_f32_16x16x32_f16(kf[p], qf[p], mk, 0, 0, 0); nk = __builtin_amdgcn_mfma_f32_16x16x32_f16(kf[p], rf[p], nk, 0, 0, 0); nbm = __builtin_amdgcn_mfma_f32_16x16x32_f16(bf[p], rf[p], nbm, 0, 0, 0); }
#pragma unroll
                for (int i = 0; i < 4; ++i) { const int u = 4 * g + i; if (!(u < c15)) mk[i] = 0.f; if (!(u <= c15)) { nk[i] = 0.f; nbm[i] = 0.f; } }
                const int o = (c15 * 16 + 4 * g) * 2;
                *(LAS h16x4*)(CB + CH_MK + o) = cvt4(mk); *(LAS h16x4*)(CB + CH_NK + o) = cvt4(nk); *(LAS h16x4*)(CB + CH_NB + o) = cvt4(nbm);
                { LAS float* e8 = (LAS float*)(CB + CH_E8) + lane; LAS float* e16 = (LAS float*)(CB + CH_E16) + lane; const float rf = *e8; *e8 = __builtin_amdgcn_exp2f(rf); *e16 = __builtin_amdgcn_exp2f(*e16 - rf); }
            }
        }
        SBAR();
        if (wave < 4) {
            const int troff = ((4 * g + (c15 >> 2)) * RS + 4 * (c15 & 3)) * 2;
            for (int c = 0; c < nch; ++c) {
                const LAS unsigned char* B = L + c * CH_BYTES;
                f32x4 e8[4], e16[4]; h16x4 q[4], r[4], ktr[4], btr[4];
#pragma unroll
                for (int kt = 0; kt < 4; ++kt) { e8[kt] = *(const LAS f32x4*)(B + CH_E8 + (16 * kt + 4 * g) * 4); q[kt] = ldR(B + CH_QT, c15, 16 * kt + 4 * g); }
                const h16x4 vh = ldtr(B + CH_VT + troff + 16 * wave * 2), mk = ldS(B + CH_MK, c15, 4 * g), ti = ldS(B + CH_TI, c15, 4 * g), nk = ldS(B + CH_NK, c15, 4 * g), nbm = ldS(B + CH_NB, c15, 4 * g);
#pragma unroll
                for (int kt = 0; kt < 4; ++kt) { r[kt] = ldR(B + CH_RT, c15, 16 * kt + 4 * g); ktr[kt] = ldtr(B + CH_KT + troff + 16 * kt * 2); btr[kt] = ldtr(B + CH_BT + troff + 16 * kt * 2);
                    e16[kt] = *(const LAS f32x4*)(B + CH_E16 + (16 * kt + 4 * g) * 4); }
                f32x4 S8[4]; h16x4 s8h[4];
#pragma unroll
                for (int kt = 0; kt < 4; ++kt) { S8[kt] = S[kt] * e8[kt]; s8h[kt] = cvt4(S8[kt]); }
                const f32x4 z4 = (f32x4){0.f, 0.f, 0.f, 0.f};
                const h16x8 s01 = __builtin_shufflevector(s8h[0], s8h[1], 0, 1, 2, 3, 4, 5, 6, 7), s23 = __builtin_shufflevector(s8h[2], s8h[3], 0, 1, 2, 3, 4, 5, 6, 7);
                f32x4 Pa = mm16(mk, vh, z4);
                Pa = __builtin_amdgcn_mfma_f32_16x16x32_f16(__builtin_shufflevector(q[0], q[1], 0, 1, 2, 3, 4, 5, 6, 7), s01, Pa, 0, 0, 0);
                const f32x4 Pb = __builtin_amdgcn_mfma_f32_16x16x32_f16(__builtin_shufflevector(q[2], q[3], 0, 1, 2, 3, 4, 5, 6, 7), s23, z4, 0, 0, 0);
                const f32x4 sg = mm16(ti, cvt4(Pa + Pb), z4);
                const h16x4 sn = -cvt4(sg);
                f32x4 Ya = mm16(nk, vh, z4);
                Ya = __builtin_amdgcn_mfma_f32_16x16x32_f16(__builtin_shufflevector(r[0], r[1], 0, 1, 2, 3, 4, 5, 6, 7), s01, Ya, 0, 0, 0);
                f32x4 Yb = __builtin_amdgcn_mfma_f32_16x16x32_f16(__builtin_shufflevector(r[2], r[3], 0, 1, 2, 3, 4, 5, 6, 7), s23, z4, 0, 0, 0);
#pragma unroll
                for (int kt = 0; kt < 4; ++kt) S8[kt] = mm16(ktr[kt], vh, S8[kt]);
                Yb = mm16(nbm, sn, Yb);
#pragma unroll
                for (int kt = 0; kt < 4; ++kt) S[kt] = mm16(btr[kt], sn, S8[kt]) * e16[kt];
                const f32x4 Y = Ya + Yb;
#pragma unroll
                for (int i = 0; i < 4; ++i) *(LAS float*)(L + OFF_YY + ((16 * c + 4 * g + i) * 64 + 16 * wave + c15) * 4) = Y[i];
            }
        }
        asm volatile("s_waitcnt vmcnt(0)" ::: "memory");
        SBAR();
        {
            const int t = tid >> 3, vg = tid & 7, v0 = 8 * vg;
            if (t < nb) {
                const f32x4 y0 = *(const LAS f32x4*)(L + OFF_YY + (t * 64 + v0) * 4), y1 = *(const LAS f32x4*)(L + OFF_YY + (t * 64 + v0 + 4) * 4);
                float y[8] = {y0.x, y0.y, y0.z, y0.w, y1.x, y1.y, y1.z, y1.w};
                float s = 0.f;
#pragma unroll
                for (int j = 0; j < 8; ++j) s += y[j];
                s += dppf<0xB1>(s); s += dppf<0x4E>(s); s += dppf<0x141>(s);
                const float mean = s * (1.0f / 64.0f); float q = 0.f;
#pragma unroll
                for (int j = 0; j < 8; ++j) { y[j] -= mean; q += y[j] * y[j]; }
                q += dppf<0xB1>(q); q += dppf<0x4E>(q); q += dppf<0x141>(q);
                const float rstd = __builtin_amdgcn_rsqf(q * (1.0f / 64.0f) + GN_EPS);
                const float bonus = *(const LAS float*)(L + OFF_BON + t * 4) + *(const LAS float*)(L + OFF_BON + (64 + t) * 4);
                const h16x8 vv = *(const LAS h16x8*)(L + (t >> 4) * CH_BYTES + CH_VT + ((t & 15) * RS + v0) * 2);
                const h16x8 sz = *(const LAS h16x8*)(L + OFF_SZ + (t * 64 + v0) * 2);
                const f32x4 gw0 = CT4(9, v0), gw1 = CT4(9, v0 + 4), gb0 = CT4(10, v0), gb1 = CT4(10, v0 + 4);
                h16x8 o;
#pragma unroll
                for (int j = 0; j < 8; ++j) o[j] = (h16)((y[j] * rstd * (j < 4 ? gw0[j & 3] : gw1[j & 3]) + (j < 4 ? gb0[j & 3] : gb1[j & 3]) + bonus * (float)vv[j]) * (float)sz[j]);
                if (!dry) { char* zp = Zb + (size_t)(row0 + t0 + t) * 2048 + 128 * h + 16 * vg; const u32x4 ov = __builtin_bit_cast(u32x4, o);
                    asm volatile("global_store_dwordx4 %0, %1, off sc1\n\ts_nop 1" :: "v"(zp), "v"(ov) : "memory"); }
            }
        }
        if (!samp && (t0 & 255) == 192) {
            asm volatile("s_waitcnt vmcnt(0)" ::: "memory");
            SBAR();
            if (tid == 0 && !dry) __hip_atomic_fetch_add((unsigned*)(F.ctl + CW_RDY) + 64 * (b * 16 + (t0 >> 8)), 1u, __ATOMIC_RELAXED, __HIP_MEMORY_SCOPE_AGENT);
        } else SBAR();
    }
#undef CT4
#undef CT1
#undef RAW8
#undef RAWW8
    if (wave < 4 && !dry) {
#pragma unroll
        for (int kt = 0; kt < 4; ++kt) *(f32x4*)(out + (samp ? OFF_WKV_S : OFF_WKV_P) + ((size_t)(b * 16 + h) * 64 + 16 * wave + c15) * 64 + 16 * kt + 4 * g) = S[kt];
    }
    asm volatile("s_waitcnt vmcnt(0)" ::: "memory");
    __syncthreads();
}
__device__ __forceinline__ void conv_pass(Frame& F, int part, int nparts) {
    const int tid_ = fresh_tid_w(F.wave_s);
    float* out = F.out; unsigned char* ws = F.ws; const float* cw = F.in[IN_CONVW]; h16* AB = (h16*)(ws + WS_ACTB);
    for (int it = part * 512 + tid_; it < (NMT - 1) * 2 * 128; it += nparts * 512) {
        const int c8 = (it & 127) * 8, m = (it >> 7) & 1, pm = it >> 8;
        if ((pm & 15) == 0) continue;
        const float* sp = (const float*)(ws + WS_SIDEP) + (size_t)pm * 2048 + m * 1024 + c8; const float* sg = (const float*)(ws + WS_SIDEG) + (size_t)pm * 2048 + m * 1024 + c8;
        const float* su = (const float*)(ws + WS_SIDEU) + (size_t)(pm - 1) * 2048 + c8;
        h16x8 o;
#pragma unroll
        for (int j = 0; j < 8; ++j) { const float um2 = su[j], um1 = su[1024 + j];
            const float extra = m == 0 ? cw[c8 + j] * um2 + cw[D + c8 + j] * um1 : cw[c8 + j] * um1;
            o[j] = (h16)(sp[j] + sg[j] * extra); }
        *(h16x8*)(AB + ((size_t)pm * 256 + m) * D + c8) = o;
    }
    for (int it = part * 512 + tid_; it < NS * 128; it += nparts * 512) {
        const int row = NP + (it >> 7), c8 = (it & 127) * 8, rr = row - NP, t = rr & (DSEQ - 1), b = rr >> 4;
        const h16x8 u0 = *(const h16x8*)(rowptr16(out, ws, 0, row) + c8), gz = *(const h16x8*)(rowptr16(out, ws, 1, row) + c8);
        float um1[8], um2[8];
        if (t >= 1) { const h16x8 v = *(const h16x8*)(rowptr16(out, ws, 0, row - 1) + c8);
#pragma unroll
            for (int j = 0; j < 8; ++j) um1[j] = (float)v[j]; }
        else {
#pragma unroll
            for (int j = 0; j < 8; ++j) um1[j] = F.in[IN_ST_CONV][((size_t)b * 2 + 1) * D + c8 + j]; }
        if (t >= 2) { const h16x8 v = *(const h16x8*)(rowptr16(out, ws, 0, row - 2) + c8);
#pragma unroll
            for (int j = 0; j < 8; ++j) um2[j] = (float)v[j]; }
        else {
#pragma unroll
            for (int j = 0; j < 8; ++j) um2[j] = F.in[IN_ST_CONV][((size_t)b * 2 + t) * D + c8 + j]; }
        h16x8 o;
#pragma unroll
        for (int j = 0; j < 8; ++j) { const float cv = cw[c8 + j] * um2[j] + cw[D + c8 + j] * um1[j] + cw[2 * D + c8 + j] * (float)u0[j]; o[j] = (h16)((float)gz[j] * cv); }
        *(h16x8*)(AB + (size_t)row * D + c8) = o;
    }
    for (int i = part * 512 + tid_; i < (MP - MREAL) * 128; i += nparts * 512) { h16x8 z;
#pragma unroll
        for (int j = 0; j < 8; ++j) z[j] = (h16)0.f;
        *(h16x8*)(AB + (size_t)MREAL * D + (size_t)i * 8) = z; }
}

constexpr int N_PHASES = 6;
__device__ __forceinline__ void merge_queue(Frame& F, const float* rstd0, bool wait_helpers) {
    unsigned char* ws = F.ws;
    for (;;) {
        if (fresh_tid_w(F.wave_s) == 0) {
            unsigned sp = 0;
            if (wait_helpers) { unsigned* hd = (unsigned*)(F.ctl + CW_SUB); while (xb_ld(hd) < 2u * (unsigned)(F.G - 128)) { __builtin_amdgcn_s_sleep(8); if (++sp > (1u << 24)) break; } }
            const unsigned idx = xb_add((unsigned*)(F.ctl + CW_MQ), 1u);
            if (idx < 512u) {
                unsigned* rdy = (unsigned*)(F.ctl + CW_RDY) + 64 * (((idx >> 2) & 7) * 16 + (idx >> 5)); sp = 0;
                while (xb_ld(rdy) < 16u) { __builtin_amdgcn_s_sleep(8); if (++sp > (1u << 24)) break; }
                __builtin_amdgcn_fence(__ATOMIC_ACQUIRE, "agent");
                asm volatile("s_waitcnt vmcnt(0)" ::: "memory");
            }
            F.MISC[0] = idx;
        }
        __syncthreads();
        const unsigned idx = (unsigned)__builtin_amdgcn_readfirstlane((int)F.MISC[0]);
        if (idx >= 512u) break;
        const int pm = (int)(((idx >> 2) & 7) * 16 + (idx >> 5));
        SchedList3 S{ws, pm, (int)(idx & 3), 1, 0x2}; Epi3 E{F.out, ws, rstd0};
        pg::gemm_phase(F.lds, F.wave_s, D, S, E);
        if (fresh_tid_w(F.wave_s) == 0) { xb_add((unsigned*)(F.ctl + CW_MRG) + 64 * pm, 1u); xb_add((unsigned*)(F.ctl + CW_MALL), 1u); }
    }
}
__device__ __forceinline__ void p4_queue(Frame& F) {
    unsigned char* ws = F.ws;
    int qi = 0;
    for (;;) {
        if (fresh_tid_w(F.wave_s) == 0) {
            unsigned got = 0xFFFFFFFFu;
            while (qi < 8) { const unsigned x = (unsigned)((F.bx + qi) & 7); const unsigned idx = xb_add((unsigned*)(F.ctl + CW_P4Q) + 32 * x, 1u); if (idx < 64u) { got = x * 64u + idx; break; } ++qi; }
            if (got != 0xFFFFFFFFu) {
                unsigned* m = (unsigned*)(F.ctl + CW_MRG) + 64 * (16 * (got >> 6) + ((got & 63u) >> 2)); unsigned sp = 0;
                while (xb_ld(m) < 4u) { __builtin_amdgcn_s_sleep(8); if (++sp > (1u << 24)) break; }
                __builtin_amdgcn_fence(__ATOMIC_ACQUIRE, "agent");
                asm volatile("s_waitcnt vmcnt(0)" ::: "memory");
            }
            F.MISC[0] = got;
        }
        __syncthreads();
        const unsigned got = (unsigned)__builtin_amdgcn_readfirstlane((int)F.MISC[0]);
        if (got == 0xFFFFFFFFu) break;
        const int pm = (int)(16 * (got >> 6) + ((got & 63u) >> 2));
        SchedOne S{(const char*)ws + WS_R, (const char*)ws + WS_WOUT, pm, (int)(got & 3u), D}; Epi4 E{ws, F.in[IN_X_P], F.in[IN_X_S]};
        pg::gemm_phase(F.lds, F.wave_s, D, S, E);
        if (fresh_tid_w(F.wave_s) == 0) xb_add((unsigned*)(F.ctl + CW_P4D) + 64 * pm, 1u);
    }
}
__global__ void __launch_bounds__(NWAVES * 64, 2) mk_fwd(Args args) {
    extern __shared__ __attribute__((aligned(16))) unsigned char lds[];
    Frame F;
    F.lds = (LAS unsigned char*)lds; F.MISC = (volatile LAS unsigned*)(F.lds + MISC_OFF);
    F.wave_s = __builtin_amdgcn_readfirstlane((int)threadIdx.x >> 6);
    F.G = gridDim.x; F.bx = blockIdx.x; F.in = args.in; F.out = args.out; F.ws = args.ws;
    F.ctl = (gu32*)(args.ws + WS_CTL);
    for (int u = fresh_tid_w(F.wave_s); u < (LDS_BYTES - LDSCTL_OFF) / 4; u += NWAVES * 64) ((LAS unsigned*)(F.lds + LDSCTL_OFF))[u] = 0u;
    __syncthreads();
    XcdBarrier bar; bar.bar = (unsigned*)(F.ctl + CW_BAR); bar.x = 0; bar.st = nullptr;
    const int lo = args.ph_lo, hi = args.ph_hi;
    if (hi - lo > 1) bar = xcd_barrier_post((unsigned*)(F.ctl + CW_BAR), F.MISC + 8, F.wave_s);
#define IN(k) (lo <= (k) && (k) < hi)
#define SEAM(k) do { if (IN(k) && IN((k) + 1)) xcd_barrier(bar, F.wave_s); } while (0)
    unsigned char* ws = args.ws;
    const float* rstd0 = (const float*)(ws + WS_RSTD0);
#define REPS(k) _Pragma("unroll") for (int _r = (PROBE_PHASE == (k)) ? 0 : 1; _r < 2; ++_r)
    if (IN(0)) { REPS(0) { p0_prologue(F); asm volatile("s_waitcnt vmcnt(0)" ::: "memory"); __syncthreads(); } SEAM(0); }
    if (IN(1)) {
        REPS(1) {
        Sched1 S; S.o.init(NMT, 33, F.G, F.bx); S.A = (const char*)ws + WS_XH; S.B = (const char*)ws + WS_W1T;
        Epi1 E{F.out, ws, rstd0, F.in[IN_CONVW], F.lds + RING_BYTES};
        pg::gemm_phase<Sched1, Epi1, true>(F.lds, F.wave_s, D, S, E);
        { constexpr int NLAST = NMT * 33 - 16 * 256;
          if (_r == 1 && F.bx >= NLAST) p0_deferred(F, F.bx - NLAST, 256 - NLAST); } }
        SEAM(1);
    }
    if (IN(2)) {
        REPS(2) {
        scan_head_v2(F, F.bx, _r == 0);
        if (F.bx < 128 && _r == 1) merge_queue(F, rstd0, true);
        if (F.bx >= 128 && _r == 1) {
            const int c = F.bx - 128;
            conv_pass(F, c, F.G - 128);
            sub_barrier((unsigned*)(F.ctl + CW_SUB), (unsigned)(F.G - 128), F.wave_s);
            if (c < 4) {
                unsigned* c4 = (unsigned*)(F.ctl + CW_SUB + 64);
                { SchedList3 S{ws, NMT - 1, c, 4, 0x2310}; Epi3 E{F.out, ws, rstd0}; pg::gemm_phase(F.lds, F.wave_s, D, S, E); }
                sub_barrier(c4, 4u, F.wave_s);
                { SchedOne S{(const char*)ws + WS_R, (const char*)ws + WS_WOUT, NMT - 1, c, D}; Epi4 E{ws, F.in[IN_X_P], F.in[IN_X_S]}; pg::gemm_phase(F.lds, F.wave_s, D, S, E); }
                sub_barrier(c4, 8u, F.wave_s);
                { SchedOne S{(const char*)ws + WS_K, (const char*)ws + WS_WGATE, NMT - 1, c, D}; Epi5a E{ws}; pg::gemm_phase(F.lds, F.wave_s, D, S, E); }
                asm volatile("s_waitcnt vmcnt(0)" ::: "memory"); __syncthreads();
                { SchedOne S{(const char*)ws + WS_PH, (const char*)ws + WS_WPLE, NMT - 1, c, PLE}; Epi5b E{F.out, ws, F.in[IN_GFINAL], F.ctl, F.lds + RING_BYTES}; pg::gemm_phase(F.lds, F.wave_s, PLE, S, E); }
            }
            { SchedH S; S.o.init(NMT - 1, 4, 1, 0); S.ws = ws; S.c = c;
              Epi3 E{F.out, ws, rstd0};
              pg::gemm_phase(F.lds, F.wave_s, D, S, E); }
            sub_barrier((unsigned*)(F.ctl + CW_SUB), 2u * (unsigned)(F.G - 128), F.wave_s);
            merge_queue(F, rstd0, false);
        } }
        if (!(IN(4))) SEAM(2);
    }
    if (IN(4)) {
        p4_queue(F);
        if (!(IN(5))) SEAM(4);
    }
    if (IN(5)) {
        if (fresh_tid_w(F.wave_s) == 0) {
            const int pm0 = 16 * (F.bx & 7) + ((F.bx >> 3) & 7); unsigned sp = 0;
            unsigned* d0 = (unsigned*)(F.ctl + CW_P4D) + 64 * pm0; unsigned* d1 = (unsigned*)(F.ctl + CW_P4D) + 64 * (pm0 + 8);
            while (xb_ld(d0) < 4u || xb_ld(d1) < 4u) { __builtin_amdgcn_s_sleep(8); if (++sp > (1u << 24)) break; }
            __builtin_amdgcn_fence(__ATOMIC_ACQUIRE, "agent");
            asm volatile("s_waitcnt vmcnt(0)" ::: "memory");
        }
        __syncthreads();
        REPS(5) { Sched4 S; S.o.init(NMT - 1, 4, F.G, F.bx); S.A = (const char*)ws + WS_K; S.B = (const char*)ws + WS_WGATE;
          Epi5a E{ws}; pg::gemm_phase(F.lds, F.wave_s, D, S, E); }
        asm volatile("s_waitcnt vmcnt(0)" ::: "memory");
        if (fresh_tid_w(F.wave_s) == 0) { unsigned* ma = (unsigned*)(F.ctl + CW_MALL); unsigned sp = 0; while (xb_ld(ma) < 512u) { __builtin_amdgcn_s_sleep(8); if (++sp > (1u << 24)) break; } }
        __syncthreads();
        { Sched5b S; S.o.init(NMT - 1, 4, F.G, F.bx); S.A = (const char*)ws + WS_PH; S.B = (const char*)ws + WS_WPLE;
          Epi5b E{F.out, ws, F.in[IN_GFINAL], F.ctl, F.lds + RING_BYTES}; pg::gemm_phase(F.lds, F.wave_s, PLE, S, E); }
    }
#undef REPS
#undef IN
#undef SEAM
}

extern "C" void kernel_launch(void* const* d_in, const int* in_sizes, int n_in, void* d_out, int out_size, void* d_ws, size_t ws_size, hipStream_t stream) {
    static int grid = 0;
    if (grid == 0) {
        if (n_in != 27 || ws_size < WS_END) { fprintf(stderr, "kernel_launch: unexpected shapes (n_in %d, ws %zu)\n", n_in, ws_size); grid = -1; return; }
        int dev = 0, cus = 0;
        if (hipGetDevice(&dev) != hipSuccess || hipDeviceGetAttribute(&cus, hipDeviceAttributeMultiprocessorCount, dev) != hipSuccess) { grid = -1; return; }
        if (hipFuncSetAttribute((const void*)mk_fwd, hipFuncAttributeMaxDynamicSharedMemorySize, LDS_BYTES) != hipSuccess) { fprintf(stderr, "kernel_launch: hipFuncSetAttribute failed\n"); grid = -1; return; }
        int per_cu = 0;
        if (hipOccupancyMaxActiveBlocksPerMultiprocessor(&per_cu, (const void*)mk_fwd, NWAVES * 64, LDS_BYTES) != hipSuccess || per_cu < 1) { fprintf(stderr, "kernel_launch: occupancy query says %d\n", per_cu); }
        (void)hipGetLastError();
        if (cus < 256) { fprintf(stderr, "kernel_launch: needs 256 CUs, got %d\n", cus); grid = -1; return; }
        grid = 256;
    }
    if (grid < 0) return;
    (void)hipMemsetAsync((char*)d_ws + WS_CTL, 0, CTL_ZERO_BYTES, stream);
    Args a{};
    for (int i = 0; i < 27; ++i) a.in[i] = (const float*)d_in[i];
    a.out = (float*)d_out; a.ws = (unsigned char*)d_ws;
    if (MK_N_LAUNCHES == 1) { a.ph_lo = 0; a.ph_hi = N_PHASES; a.li = PROBE_PHASE; hipLaunchKernelGGL(mk_fwd, dim3(grid), dim3(NWAVES * 64), LDS_BYTES, stream, a); }
    else for (int li = 0; li < N_PHASES; ++li) { a.ph_lo = li; a.ph_hi = li + 1; a.li = PROBE_PHASE; hipLaunchKernelGGL(mk_fwd, dim3(grid), dim3(NWAVES * 64), LDS_BYTES, stream, a); }
}
```

```cpp
#include <hip/hip_runtime.h>
#include <cstdio>
#include <cstdint>

#ifndef MK_N_LAUNCHES
#define MK_N_LAUNCHES 1
#endif

#ifndef PROBE_PHASE
#define PROBE_PHASE -1
#endif
#define LAS __attribute__((address_space(3)))
#define GAS __attribute__((address_space(1)))
typedef _Float16 h16;
typedef _Float16 h16x8 __attribute__((ext_vector_type(8)));
typedef _Float16 h16x4 __attribute__((ext_vector_type(4)));
typedef float f32x4 __attribute__((ext_vector_type(4)));
typedef float f32x2 __attribute__((ext_vector_type(2)));
typedef unsigned u32x4 __attribute__((ext_vector_type(4)));
typedef GAS unsigned gu32;

constexpr int D = 1024, NP = 32768, NS = 128, MREAL = NP + NS, MP = 33024, NMT = MP / 256;
constexpr int SEQ = 4096, DSEQ = 16, NH = 16, HD = 64, PLE = 256;
constexpr int SHIFT_COLS = 4224, IN_COLS = 10368;
constexpr int W1_ROWS = 8448 + 2048;
constexpr float EPS = 1e-6f, GN_EPS = 64e-5f, DECAY_SCALE = 0.60653065971f;
constexpr size_t OFF_Y = 0, OFF_WKV_P = (size_t)MREAL * D, OFF_SHIFT_P = OFF_WKV_P + 8 * 16 * 64 * 64, OFF_CONV_P = OFF_SHIFT_P + 8 * SHIFT_COLS,
                 OFF_WKV_S = OFF_CONV_P + 8 * 2 * D, OFF_SHIFT_S = OFF_WKV_S + 8 * 16 * 64 * 64, OFF_CONV_S = OFF_SHIFT_S + 8 * SHIFT_COLS;
constexpr size_t MiB = 1u << 20;
constexpr size_t WS_CTL = 0, CTL_ZERO_BYTES = 163840;
static_assert((16384 + 128 * 64) * 4 <= 131072, "control words inside the per-call memset");
constexpr size_t WS_W1T = 1 * MiB, WS_WOA = 22 * MiB, WS_WOB = 24 * MiB, WS_WOUT = 26 * MiB, WS_WGATE = 28 * MiB, WS_WPLE = 30 * MiB;
constexpr size_t WS_W2T = 30 * MiB + 512 * 1024, WS_I2T = WS_W2T + 128 * 1024;
constexpr size_t WS_RSTD0 = 31 * MiB, WS_SIDE = 32 * MiB, WS_SSQ1 = 34 * MiB, WS_XCH = 37 * MiB;
constexpr size_t WS_XH = 40 * MiB, WS_PH = 105 * MiB, WS_R = 122 * MiB, WS_K = 187 * MiB, WS_V = 252 * MiB, WS_Z = 317 * MiB, WS_WA = 382 * MiB, WS_ACTB = 391 * MiB, WS_SIDEU = 456 * MiB, WS_SIDEP = 457 * MiB, WS_SIDEG = 458 * MiB, WS_END = 459 * MiB;
constexpr size_t SIDE_STRIDE = 256 * 1024;
constexpr int CW_BAR = 1024, CW_SUB = 512, CW_PANEL = 5120, CW_RDY = 16384, CW_MQ = 640, CW_P4Q = 768, CW_MRG = 24576, CW_P4D = 32768, CW_MALL = 704;

constexpr int NWAVES = 8;
constexpr int RING_BYTES = 131072, SCAN_LDS_BYTES = 163072, LDSCTL_OFF = SCAN_LDS_BYTES, MISC_OFF = LDSCTL_OFF + 320, LDS_BYTES = 163840;

__device__ __forceinline__ int fresh_tid_w(int wave_s) { int lane; asm volatile("v_mbcnt_lo_u32_b32 %0, -1, 0\n\tv_mbcnt_hi_u32_b32 %0, -1, %0" : "=v"(lane)); return (wave_s << 6) | lane; }
__device__ __forceinline__ float fsigmoid(float x) { return __builtin_amdgcn_rcpf(1.0f + __expf(-x)); }
__device__ __forceinline__ float fsilu(float x) { return x * fsigmoid(x); }
__device__ __forceinline__ float ftanh(float x) { return 1.0f - 2.0f * __builtin_amdgcn_rcpf(__expf(2.0f * x) + 1.0f); }
__device__ __forceinline__ h16x4 cvt4(f32x4 v) { return __builtin_convertvector(v, h16x4); }
__device__ __forceinline__ h16x8 cvt8(f32x4 a, f32x4 b) { h16x4 x = cvt4(a), y = cvt4(b); return __builtin_shufflevector(x, y, 0, 1, 2, 3, 4, 5, 6, 7); }
__device__ __forceinline__ f32x4 up4(h16x4 v) { return __builtin_convertvector(v, f32x4); }

namespace pg {
constexpr int BM = 256, BK = 64, HALF = 128, HTB = HALF * BK * 2, NXCD = 8, WGM = 8;
__host__ __device__ __forceinline__ int lds_byte(int r, int c) { const int st = (r >> 4) * 2 + (c >> 5), rr = r & 15, cc = c & 31, ob = rr * 64 + cc * 2; return st * 1024 + (ob ^ (((ob >> 9) & 1) << 5)); }
__host__ __device__ __forceinline__ void stage_rc(int b, int& R, int& C) { const int st = b / 1024, sb = b % 1024, swz = sb ^ (((sb >> 9) & 1) << 5); R = (st >> 1) * 16 + swz / 64; C = (st & 1) * 32 + (swz % 64) / 2; }
__host__ __device__ __forceinline__ int perm32(int rho) { const int n = rho >> 4, i = rho & 15; return 8 * (i >> 2) + 4 * n + (i & 3); }

struct Unit { int pm, pn, kind; const char* A; const char* B; };

struct TileOrder {
    int nM, nN, nwg, G, c;
    __device__ void init(int nM_, int nN_, int G_, int c_) { nM = nM_; nN = nN_; nwg = nM * nN; G = G_; c = c_; }
    __device__ bool get(int i, int& pm, int& pn) const { return get_linear((long)i * G + c, pm, pn); }
    __device__ bool get_linear(long L, int& pm, int& pn) const {
        if (L >= nwg) return false;
        int wgid = (int)L; { const int q = nwg / NXCD, r = nwg % NXCD, xcd = wgid % NXCD, off = wgid / NXCD; wgid = (xcd < r ? xcd * (q + 1) : r * (q + 1) + (xcd - r) * q) + off; }
        const int nig = WGM * nN, gid = wgid / nig, fm = gid * WGM, gsz = (nM - fm) < WGM ? (nM - fm) : WGM;
        pm = fm + ((wgid % nig) % gsz); pn = (wgid % nig) / gsz; return true;
    }
};

template <class Sched, class Epi, bool APERM = false>
__device__ __forceinline__ void gemm_phase(LAS unsigned char* lds, const int wave_s, const int K, const Sched& S, const Epi& E) {
    const int tid = fresh_tid_w(wave_s), wid = wave_s, lane = tid & 63, wr = wid >> 2, wc = wid & 3, fr = lane & 15, fq = lane >> 4;
    const int nt = K / BK;
    unsigned voffA[2], voffB[2];
#pragma unroll
    for (int i = 0; i < 2; ++i) { int R, C; stage_rc(tid * 16 + i * 8192, R, C); const int Rb = (R & ~31) + perm32(R & 31);
        const int Ra = APERM ? (R & ~63) + 4 * (R & 15) + ((R & 63) >> 4) : R;
        voffA[i] = (unsigned)(Ra * K + C) * 2u; voffB[i] = (unsigned)(Rb * K + C) * 2u; }
    const size_t kstep = (size_t)(BK * 2);
    const size_t hstep = (size_t)HALF * K * 2;
    const unsigned ldsw = (unsigned)wid * 1024u;
    const int aoff = lds_byte(wr * 64 + fr, fq * 8), boff = lds_byte(wc * 32 + fr, fq * 8);
#define PG_SA(b, h) (((b) * 2 + (h)) * HTB)
#define PG_SB(b, h) ((4 + (b) * 2 + (h)) * HTB)
#define PG_STAGE(bufoff, gbase, voff) do { _Pragma("unroll") for (int _i = 0; _i < 2; ++_i) \
        __builtin_amdgcn_global_load_lds((const unsigned*)((const char*)(gbase) + (voff)[_i]), (LAS unsigned*)(lds + (bufoff) + ldsw + _i * 8192), 16, 0, 0); } while (0)
#define PG_LDA(dst, b, h) do { _Pragma("unroll") for (int m = 0; m < 4; ++m) _Pragma("unroll") for (int k = 0; k < 2; ++k) dst[m][k] = *(const LAS h16x8*)(lds + PG_SA(b, h) + aoff + m * 2048 + k * 1024); } while (0)
#define PG_LDB(dst, b, h) do { _Pragma("unroll") for (int n = 0; n < 2; ++n) _Pragma("unroll") for (int k = 0; k < 2; ++k) dst[n][k] = *(const LAS h16x8*)(lds + PG_SB(b, h) + boff + n * 2048 + k * 1024); } while (0)
#define PG_MMA(ai, bj, At, Bt) do { __builtin_amdgcn_s_setprio(1); _Pragma("unroll") for (int m = 0; m < 4; ++m) _Pragma("unroll") for (int n = 0; n < 2; ++n) _Pragma("unroll") for (int k = 0; k < 2; ++k) \
        acc[ai][bj][m][n] = __builtin_amdgcn_mfma_f32_16x16x32_f16(Bt[n][k], At[m][k], acc[ai][bj][m][n], 0, 0, 0); __builtin_amdgcn_s_setprio(0); } while (0)
#define PG_WAIT_V(n) asm volatile("s_waitcnt vmcnt(" #n ")" ::: "memory")
#define PG_WAIT_L(n) asm volatile("s_waitcnt lgkmcnt(" #n ")" ::: "memory")
#define PG_BAR __builtin_amdgcn_s_barrier()
#define PG_SCHED __builtin_amdgcn_sched_barrier(0)
    Unit cur, nxt; int ui = 0;
    if (!S.next(0, cur)) return;
    f32x4 acc[2][2][4][2];
#pragma unroll
    for (int a = 0; a < 2; ++a)
#pragma unroll
        for (int b = 0; b < 2; ++b)
#pragma unroll
            for (int m = 0; m < 4; ++m)
#pragma unroll
                for (int n = 0; n < 2; ++n) acc[a][b][m][n] = (f32x4){0.f, 0.f, 0.f, 0.f};
    h16x8 At[4][2], B0[2][2], B1[2][2];
    const char* cA = cur.A; const char* cB = cur.B;
    PG_STAGE(PG_SB(0, 0), cB, voffB); PG_STAGE(PG_SB(0, 1), cB + hstep, voffB); PG_STAGE(PG_SA(0, 0), cA, voffA); PG_STAGE(PG_SA(0, 1), cA + hstep, voffA);
    PG_STAGE(PG_SB(1, 0), cB + kstep, voffB); PG_STAGE(PG_SA(1, 0), cA + kstep, voffA); PG_STAGE(PG_SB(1, 1), cB + hstep + kstep, voffB);
    if (wr == 1) PG_BAR;
    PG_WAIT_V(8); PG_BAR;
    PG_WAIT_V(6); PG_BAR;
    for (;;) {
        const bool has_next = S.next(ui + 1, nxt);
        const char* nA = has_next ? nxt.A : cA; const char* nB = has_next ? nxt.B : cB;
        for (int t = 0; t < nt; t += 2) {
            const bool last = (t == nt - 2);
            const char* a1 = cA + (size_t)(t + 1) * kstep;
            const char* a2 = last ? nA : cA + (size_t)(t + 2) * kstep; const char* b2 = last ? nB : cB + (size_t)(t + 2) * kstep;
            const char* a3 = a2 + kstep; const char* b3 = b2 + kstep;
            PG_LDB(B0, 0, 0); PG_LDB(B1, 0, 1); PG_SCHED; PG_LDA(At, 0, 0); PG_STAGE(PG_SA(1, 1), a1 + hstep, voffA);
            PG_WAIT_V(8); PG_WAIT_L(0); PG_BAR; PG_MMA(0, 0, At, B0); PG_MMA(0, 1, At, B1); PG_BAR; PG_SCHED;
            PG_LDA(At, 0, 1); PG_STAGE(PG_SB(0, 0), b2, voffB); PG_STAGE(PG_SB(0, 1), b2 + hstep, voffB); PG_STAGE(PG_SA(0, 0), a2, voffA);
            PG_WAIT_V(8); PG_WAIT_L(0); PG_BAR; PG_MMA(1, 0, At, B0); PG_MMA(1, 1, At, B1); PG_BAR; PG_SCHED;
            PG_LDB(B0, 1, 0); PG_LDB(B1, 1, 1); PG_SCHED; PG_LDA(At, 1, 0); PG_STAGE(PG_SA(0, 1), a2 + hstep, voffA);
            PG_WAIT_V(8); PG_WAIT_L(0); PG_BAR; PG_MMA(0, 0, At, B0); PG_MMA(0, 1, At, B1); PG_BAR; PG_SCHED;
            PG_LDA(At, 1, 1); PG_STAGE(PG_SB(1, 0), b3, voffB); PG_STAGE(PG_SB(1, 1), b3 + hstep, voffB); PG_STAGE(PG_SA(1, 0), a3, voffA);
            PG_WAIT_V(8); PG_WAIT_L(0); PG_BAR; PG_MMA(1, 0, At, B0); PG_MMA(1, 1, At, B1); PG_BAR; PG_SCHED;
        }
        if (wr == 0) PG_BAR;
        E(acc, cur, wr, wc, fr, fq);
        if (!has_next) break;
#pragma unroll
        for (int a = 0; a < 2; ++a)
#pragma unroll
            for (int b = 0; b < 2; ++b)
#pragma unroll
                for (int m = 0; m < 4; ++m)
#pragma unroll
                    for (int n = 0; n < 2; ++n) acc[a][b][m][n] = (f32x4){0.f, 0.f, 0.f, 0.f};
        cur = nxt; cA = nA; cB = nB; ++ui;
        if (wr == 1) PG_BAR;
    }
    PG_WAIT_V(0);
    PG_BAR;
#undef PG_SA
#undef PG_SB
#undef PG_STAGE
#undef PG_LDA
#undef PG_LDB
#undef PG_MMA
#undef PG_WAIT_V
#undef PG_WAIT_L
#undef PG_BAR
#undef PG_SCHED
}
}

#define XB_TMO      128
#define XB_XCNT(j)  (256  + 64 * (j))
#define XB_XSUB(j)  (1280 + 64 * (j))
#define XB_XGEN(j)  (2304 + 64 * (j))
#define XB_TOP      3328
#define XB_TOPGEN   3392
#define XCD_BAR_WORDS 3456
#define XB_SPIN_CAP (1u << 22)
__device__ __forceinline__ unsigned xb_ld(unsigned* p)              { return __hip_atomic_load(p, __ATOMIC_RELAXED, __HIP_MEMORY_SCOPE_AGENT); }
__device__ __forceinline__ unsigned xb_add(unsigned* p, unsigned v) { return __hip_atomic_fetch_add(p, v, __ATOMIC_RELAXED, __HIP_MEMORY_SCOPE_AGENT); }
__device__ __forceinline__ unsigned xb_xcc_id() { return (unsigned)__builtin_amdgcn_s_getreg((3 << 11) | 20) & 0xFu; }
#define XB_SPIN(cond, bar) do { unsigned _sp = 0; while (cond) { __builtin_amdgcn_s_sleep(1); \
    if ((++_sp & 255u) == 0u) { if (xb_ld(&(bar)[XB_TMO])) break; if (_sp > XB_SPIN_CAP) { atomicAdd(&(bar)[XB_TMO], 1u); break; } } } } while (0)
struct XcdBarrier { unsigned* bar; unsigned x; volatile LAS unsigned* st; };
__device__ __forceinline__ XcdBarrier xcd_barrier_post(unsigned* bar, volatile LAS unsigned* st, int wave_s) {
    XcdBarrier b; b.bar = bar; b.x = xb_xcc_id(); b.st = st;
    if (fresh_tid_w(wave_s) == 0) (void)xb_add(&bar[XB_XCNT(b.x)], 1u);
    return b;
}
__device__ __forceinline__ void xcd_barrier_complete(unsigned* bar, unsigned x, unsigned& nloc, unsigned& nx) {
    const unsigned G = gridDim.x * gridDim.y * gridDim.z;
    unsigned sum, cnt, mine, sp = 0u;
    for (;;) {
        sum = 0u; cnt = 0u; mine = 0u;
#pragma unroll
        for (unsigned j = 0; j < 16; ++j) { const unsigned c = xb_ld(&bar[XB_XCNT(j)]); sum += c; cnt += (c > 0u) ? 1u : 0u; mine = (j == x) ? c : mine; }
        if (sum == G) break;
        __builtin_amdgcn_s_sleep(1);
        if ((++sp & 255u) == 0u) { if (xb_ld(&bar[XB_TMO])) break; if (sp > XB_SPIN_CAP) { atomicAdd(&bar[XB_TMO], 1u); break; } }
    }
    nloc = mine > 0u ? mine : 1u; nx = cnt > 0u ? cnt : 1u;
}
__device__ __forceinline__ void xcd_barrier(const XcdBarrier& b, int wave_s) {
    asm volatile("s_waitcnt vmcnt(0)" ::: "memory");
    __syncthreads();
    if (fresh_tid_w(wave_s) == 0) {
        unsigned* bar = b.bar;
        __builtin_amdgcn_s_waitcnt(0);
        unsigned nloc = b.st[0], nx = b.st[1];
        if (nloc == 0u) { xcd_barrier_complete(bar, b.x, nloc, nx); b.st[0] = nloc; b.st[1] = nx; }
        const unsigned old = xb_add(&bar[XB_XSUB(b.x)], 1u);
        const unsigned gen = old / nloc;
        if (old + 1u == (gen + 1u) * nloc) {
            __builtin_amdgcn_fence(__ATOMIC_RELEASE, "agent");
            asm volatile("s_waitcnt vmcnt(0)" ::: "memory");
            const unsigned og = xb_add(&bar[XB_TOP], 1u);
            const unsigned tg = og / nx;
            if (og + 1u == (tg + 1u) * nx) xb_add(&bar[XB_TOPGEN], 1u);
            else XB_SPIN(xb_ld(&bar[XB_TOPGEN]) == tg, bar);
            __builtin_amdgcn_fence(__ATOMIC_ACQUIRE, "agent");
            xb_add(&bar[XB_XGEN(b.x)], 1u);
            asm volatile("s_waitcnt vmcnt(0)" ::: "memory");
        } else {
            XB_SPIN(xb_ld(&bar[XB_XGEN(b.x)]) == gen, bar);
            __builtin_amdgcn_fence(__ATOMIC_ACQUIRE, "agent");
            asm volatile("s_waitcnt vmcnt(0)" ::: "memory");
        }
    }
    __syncthreads();
}

struct Args { const float* in[27]; float* out; unsigned char* ws; int ph_lo, ph_hi, li, pad; };
struct Frame {
    LAS unsigned char* lds; volatile LAS unsigned* MISC; gu32* ctl;
    int G, bx, wave_s;
    const float* const* in; float* out; unsigned char* ws;
};
#define IN_X_P 0
#define IN_X_S 1
#define IN_ST_WKV 2
#define IN_ST_SHIFT 3
#define IN_ST_CONV 4
#define IN_P_P 5
#define IN_P_S 6
#define IN_G_NORM 7
#define IN_W_IN 8
#define IN_MU 9
#define IN_WDEC0 10
#define IN_WDEC2 11
#define IN_WICL0 12
#define IN_WICL2 13
#define IN_KREM 14
#define IN_KREP 15
#define IN_RBONUS 16
#define IN_GNW 17
#define IN_GNB 18
#define IN_CONVW 19
#define IN_WOA 20
#define IN_WOB 21
#define IN_WOUT 22
#define IN_GPLE 23
#define IN_WPLEG 24
#define IN_WPLE 25
#define IN_GFINAL 26

__device__ __forceinline__ float wave_sum(float v) {
#pragma unroll
    for (int o = 1; o < 64; o <<= 1) v += __shfl_xor(v, o);
    return v;
}
__device__ __forceinline__ h16* rowptr16(float* out, unsigned char* ws, int slot, int row) {
    return row < NP ? (h16*)out + (size_t)slot * NP * D + (size_t)row * D : (h16*)(ws + WS_SIDE) + (size_t)slot * SIDE_STRIDE + (size_t)(row - NP) * D;
}

__device__ __forceinline__ int w1_src_col(int n) {
    const int tile = n >> 8, c = n & 255;
    if (tile < 16) { const int plane = tile >> 2; return (plane == 3 ? 3200 : plane * 1024) + (tile & 3) * 256 + c; }
    if (tile == 16) return c < 128 ? 3072 + c : -1;
    if (tile < 33) { const int tb = tile - 17, kind = 2 * (c >> 7) + ((c >> 2) & 1), ch = 64 * tb + 16 * ((c >> 5) & 3) + 4 * ((c >> 3) & 3) + (c & 3); return SHIFT_COLS + kind * 1024 + ch; }
    return SHIFT_COLS + 4096 + (n - 8448);
}
template <bool MAP>
__device__ __forceinline__ void p0_transpose_item(const float* W, int Nsrc, int K, h16* WT, const float* kscale, LAS float* scr, int kb, int nb, int lane) {
    const int k0 = 64 * kb, n0 = 32 * nb, n4 = (lane & 7) * 4;
    const int src = MAP ? w1_src_col(n0 + n4) : n0 + n4;
    f32x4 v[8];
#pragma unroll
    for (int i = 0; i < 8; ++i) { const int kk = 8 * i + (lane >> 3); v[i] = (f32x4){0.f, 0.f, 0.f, 0.f}; if (src >= 0) { v[i] = *(const f32x4*)(W + (size_t)(k0 + kk) * Nsrc + src); if (kscale) v[i] = v[i] * kscale[k0 + kk]; } }
#pragma unroll
    for (int i = 0; i < 8; ++i) { const int kk = 8 * i + (lane >> 3); LAS float* d = scr + kk * 33 + n4; d[0] = v[i].x; d[1] = v[i].y; d[2] = v[i].z; d[3] = v[i].w; }
    asm volatile("s_waitcnt lgkmcnt(0)" ::: "memory");
    const int c = lane & 7;
#pragma unroll
    for (int j = 0; j < 4; ++j) { const int nn = (lane >> 3) + 8 * j; const LAS float* s = scr + (8 * c) * 33 + nn;
        h16x8 o;
#pragma unroll
        for (int e = 0; e < 8; ++e) o[e] = (h16)s[e * 33];
        *(h16x8*)(WT + (size_t)(n0 + nn) * K + k0 + 8 * c) = o; }
    asm volatile("s_waitcnt lgkmcnt(0)" ::: "memory");
}
__device__ __forceinline__ void p0_prologue(Frame& F) {
    const int tid_ = fresh_tid_w(F.wave_s), lane_ = tid_ & 63, wave_ = F.wave_s;
    LAS float* scr = (LAS float*)(F.lds + wave_ * 16384);
    const int gw = F.bx * NWAVES + wave_, NGW = F.G * NWAVES;
    unsigned char* ws = F.ws;
    constexpr int I_W1 = (D / 64) * (W1_ROWS / 32), I_SQ = (D / 64) * (D / 32), I_PLE = (PLE / 64) * (D / 32);
    constexpr int NITEMS = I_W1 + 4 * I_SQ + I_PLE;
    for (int it = gw; it < I_W1; it += NGW)
        p0_transpose_item<true>(F.in[IN_W_IN], IN_COLS, D, (h16*)(ws + WS_W1T), F.in[IN_G_NORM], scr, it / (W1_ROWS / 32), it % (W1_ROWS / 32), lane_);
    (void)NITEMS;
    for (int i = F.bx * 512 + tid_; i < 65536; i += F.G * 512) { const int n = i >> 6, j = i & 63;
        ((h16*)(ws + WS_W2T))[i] = (h16)(-1.4426950408889634f * F.in[IN_WDEC2][(size_t)j * D + n]); ((h16*)(ws + WS_I2T))[i] = (h16)(-1.4426950408889634f * F.in[IN_WICL2][(size_t)j * D + n]); }
    h16* XH = (h16*)(ws + WS_XH); float* rstd0 = (float*)(ws + WS_RSTD0);
    for (int m0 = 4 * gw; m0 < MP; m0 += 4 * NGW) {
        f32x4 v[4][4]; float s[4];
#pragma unroll
        for (int r = 0; r < 4; ++r) { const int m = m0 + r;
            if (m < MREAL) {
                const float* xrow = m < NP ? F.in[IN_X_P] + (size_t)m * D : F.in[IN_X_S] + (size_t)(m - NP) * D;
#pragma unroll
                for (int j = 0; j < 4; ++j) v[r][j] = __builtin_nontemporal_load((const f32x4*)xrow + lane_ + 64 * j);
            } else {
#pragma unroll
                for (int j = 0; j < 4; ++j) v[r][j] = (f32x4){0.f, 0.f, 0.f, 0.f};
            } }
#pragma unroll
        for (int r = 0; r < 4; ++r) { float t = 0.f;
#pragma unroll
            for (int j = 0; j < 4; ++j) t += (v[r][j].x * v[r][j].x + v[r][j].y * v[r][j].y) + (v[r][j].z * v[r][j].z + v[r][j].w * v[r][j].w);
            s[r] = wave_sum(t); }
#pragma unroll
        for (int r = 0; r < 4; ++r) { const int m = m0 + r;
            const float ms = s[r] * (1.0f / D) + EPS, rstd = __builtin_amdgcn_rsqf(ms);
            if (lane_ == 0) rstd0[m] = m < MREAL ? ms * rstd : 0.f;
            h16x4* o = (h16x4*)(XH + (size_t)m * D) + lane_;
#pragma unroll
            for (int j = 0; j < 4; ++j) o[64 * j] = cvt4(v[r][j] * rstd); }
    }
}
__device__ __forceinline__ void p0_deferred(Frame& F, int c, int nw) {
    const int tid_ = fresh_tid_w(F.wave_s), lane_ = tid_ & 63, wave_ = F.wave_s;
    LAS float* scr = (LAS float*)(F.lds + wave_ * 16384);
    const int gw = c * NWAVES + wave_, NGW = nw * NWAVES;
    unsigned char* ws = F.ws;
    constexpr int I_SQ = (D / 64) * (D / 32), I_PLE = (PLE / 64) * (D / 32);
    for (int it = gw; it < 4 * I_SQ + I_PLE; it += NGW) {
        int r = it;
        if (r < I_SQ) { p0_transpose_item<false>(F.in[IN_WOA], D, D, (h16*)(ws + WS_WOA), nullptr, scr, r / 32, r % 32, lane_); continue; } r -= I_SQ;
        if (r < I_SQ) { p0_transpose_item<false>(F.in[IN_WOB], D, D, (h16*)(ws + WS_WOB), nullptr, scr, r / 32, r % 32, lane_); continue; } r -= I_SQ;
        if (r < I_SQ) { p0_transpose_item<false>(F.in[IN_WOUT], D, D, (h16*)(ws + WS_WOUT), nullptr, scr, r / 32, r % 32, lane_); continue; } r -= I_SQ;
        if (r < I_SQ) { p0_transpose_item<false>(F.in[IN_WPLEG], D, D, (h16*)(ws + WS_WGATE), F.in[IN_GPLE], scr, r / 32, r % 32, lane_); continue; } r -= I_SQ;
        p0_transpose_item<false>(F.in[IN_WPLE], D, PLE, (h16*)(ws + WS_WPLE), nullptr, scr, r / 32, r % 32, lane_);
    }
    h16* PH = (h16*)(ws + WS_PH);
    for (int m0 = 8 * gw; m0 < MP; m0 += 8 * NGW) {
        f32x4 pv[8];
#pragma unroll
        for (int r = 0; r < 8; ++r) { const int m = m0 + r; pv[r] = (f32x4){0.f, 0.f, 0.f, 0.f};
            if (m < MREAL) pv[r] = __builtin_nontemporal_load((const f32x4*)(m < NP ? F.in[IN_P_P] + (size_t)m * PLE : F.in[IN_P_S] + (size_t)(m - NP) * PLE) + lane_); }
#pragma unroll
        for (int r = 0; r < 8; ++r) ((h16x4*)(PH + (size_t)(m0 + r) * PLE))[lane_] = cvt4(pv[r]);
    }
    asm volatile("s_waitcnt vmcnt(0)" ::: "memory");
    __syncthreads();
}

__device__ __forceinline__ char* slotbase(float* out, unsigned char* ws, int slot, bool prompt_tile) {
    return prompt_tile ? (char*)out + (size_t)slot * NP * D * 2 : (char*)(ws + WS_SIDE) + (size_t)slot * SIDE_STRIDE * 2 - (size_t)NP * D * 2;
}
__device__ __forceinline__ float dpp_row_shr1(float x) { return __builtin_bit_cast(float, __builtin_amdgcn_update_dpp(0, __builtin_bit_cast(int, x), 0x111, 0xf, 0xf, true)); }
struct Epi1 {
    float* out; unsigned char* ws; const float* rstd0; const float* cw; LAS unsigned char* lx;
    __device__ __forceinline__ void conv_tile(const f32x4 (&acc)[2][2][4][2], const pg::Unit& u, int wr, int wc, int fr, int fq) const {
        const int ch = 64 * (u.pn - 17) + 16 * wc + 4 * fq;
        f32x4 uu[2][4], gz[2][4];
#pragma unroll
        for (int ai = 0; ai < 2; ++ai)
#pragma unroll
            for (int m = 0; m < 4; ++m) {
                const int row = u.pm * 256 + ai * 128 + wr * 64 + fr * 4 + m;
                const f32x4 gb = acc[ai][0][m][0], gc = acc[ai][0][m][1], xb = acc[ai][1][m][0], zb = acc[ai][1][m][1];
                uu[ai][m] = gc * xb;
#pragma unroll
                for (int j = 0; j < 4; ++j) gz[ai][m][j] = gb[j] * fsilu(zb[j]);
                const int t = row & (SEQ - 1);
                if (t >= SEQ - 2) *(f32x4*)(out + OFF_CONV_P + ((size_t)(row >> 12) * 2 + (t - (SEQ - 2))) * D + ch) = uu[ai][m];
            }
        LAS float* X = (LAS float*)lx;
        if (fr == 15) {
#pragma unroll
            for (int ai = 0; ai < 2; ++ai) { *(LAS f32x4*)(X + ((2 * ai + wr) * 2 + 0) * 64 + 16 * wc + 4 * fq) = uu[ai][2]; *(LAS f32x4*)(X + ((2 * ai + wr) * 2 + 1) * 64 + 16 * wc + 4 * fq) = uu[ai][3]; }
            if (wr == 1) { float* su = (float*)(ws + WS_SIDEU) + (size_t)u.pm * 2048 + ch; *(f32x4*)su = uu[1][2]; *(f32x4*)(su + 1024) = uu[1][3]; }
        }
        asm volatile("s_waitcnt lgkmcnt(0)" ::: "memory"); __builtin_amdgcn_s_barrier(); asm volatile("" ::: "memory");
        const f32x4 c0 = *(const f32x4*)(cw + ch), c1 = *(const f32x4*)(cw + D + ch), c2 = *(const f32x4*)(cw + 2 * D + ch);
        const bool first = (u.pm & 15) == 0;
#pragma unroll
        for (int ai = 0; ai < 2; ++ai) {
            f32x4 q1, q2;
#pragma unroll
            for (int j = 0; j < 4; ++j) { q1[j] = dpp_row_shr1(uu[ai][3][j]); q2[j] = dpp_row_shr1(uu[ai][2][j]); }
            const int blk = 2 * ai + wr;
            if (fr == 0) {
                if (blk > 0) { q2 = *(const LAS f32x4*)(X + ((blk - 1) * 2 + 0) * 64 + 16 * wc + 4 * fq); q1 = *(const LAS f32x4*)(X + ((blk - 1) * 2 + 1) * 64 + 16 * wc + 4 * fq); }
                else { q2 = (f32x4){0.f, 0.f, 0.f, 0.f}; q1 = q2; }
            }
#pragma unroll
            for (int m = 0; m < 4; ++m) {
                const int row = u.pm * 256 + ai * 128 + wr * 64 + fr * 4 + m;
                const f32x4 p1 = m >= 1 ? uu[ai][m - 1] : q1, p2 = m >= 2 ? uu[ai][m - 2] : (m == 1 ? q1 : q2);
                const f32x4 cv = c2 * uu[ai][m] + c1 * p1 + c0 * p2;
                if (blk == 0 && fr == 0 && m < 2 && !first) {
                    float* sp = (float*)(ws + WS_SIDEP) + (size_t)u.pm * 2048 + m * 1024 + ch; float* sg = (float*)(ws + WS_SIDEG) + (size_t)u.pm * 2048 + m * 1024 + ch;
                    *(f32x4*)sp = gz[ai][m] * cv; *(f32x4*)sg = gz[ai][m];
                } else *(h16x4*)((char*)ws + WS_ACTB + (unsigned)(row * D + ch) * 2u) = cvt4(gz[ai][m] * cv);
            }
        }
    }
    __device__ __forceinline__ void operator()(const f32x4 (&acc)[2][2][4][2], const pg::Unit& u, int wr, int wc, int fr, int fq) const {
        const int tile = u.pn; const bool ptile = u.pm < NMT - 1;
        if (tile >= 17 && ptile) { conv_tile(acc, u, wr, wc, fr, fq); return; }
        const int plane = tile >> 2;
        char* pbase = (char*)ws + (plane == 0 ? WS_R : plane == 1 ? WS_K : plane == 2 ? WS_V : WS_Z);
        char* ub = slotbase(out, ws, 0, ptile); char* gzb = slotbase(out, ws, 1, ptile);
#pragma unroll
        for (int ai = 0; ai < 2; ++ai)
#pragma unroll
            for (int m = 0; m < 4; ++m) {
                const int row = u.pm * 256 + ai * 128 + wr * 64 + fr * 4 + m;
                int endj = -1, bidx = 0; bool samp = false;
                if (row < NP) { const int t = row & (SEQ - 1); if (t >= SEQ - 2) { endj = t - (SEQ - 2); bidx = row >> 12; } }
                else if (row < MREAL) { const int rr = row - NP, t = rr & (DSEQ - 1); if (t >= DSEQ - 2) { endj = t - (DSEQ - 2); bidx = rr >> 4; samp = true; } }
                if (tile < 17) {
#pragma unroll
                    for (int bj = 0; bj < 2; ++bj) {
                        const int cl = bj * 128 + wc * 32 + 8 * fq;
                        const f32x4 v0 = acc[ai][bj][m][0], v1 = acc[ai][bj][m][1];
                        int scol;
                        if (tile < 16) { *(h16x8*)(pbase + (unsigned)(row * D + (tile & 3) * 256 + cl) * 2u) = cvt8(v0, v1); scol = (plane == 3 ? 3200 : plane * 1024) + (tile & 3) * 256 + cl; }
                        else { if (bj == 1) continue; *(h16x8*)((char*)ws + WS_WA + (unsigned)(row * 128 + cl) * 2u) = cvt8(v0, v1); scol = 3072 + cl; }
                        if (endj == 1) { float* o = out + (samp ? OFF_SHIFT_S : OFF_SHIFT_P) + (size_t)bidx * SHIFT_COLS + scol; *(f32x4*)o = v0; *(f32x4*)(o + 4) = v1; }
                    }
                } else {
                    const int ch = 64 * (tile - 17) + 16 * wc + 4 * fq;
                    const f32x4 gb = acc[ai][0][m][0], gc = acc[ai][0][m][1], xb = acc[ai][1][m][0], zb = acc[ai][1][m][1];
                    f32x4 uu = gc * xb, gz;
#pragma unroll
                    for (int j = 0; j < 4; ++j) gz[j] = gb[j] * fsilu(zb[j]);
                    const unsigned o = (unsigned)(row * D + ch) * 2u;
                    *(h16x4*)(ub + o) = cvt4(uu);
                    *(h16x4*)(gzb + o) = cvt4(gz);
                    if (endj >= 0) *(f32x4*)(out + (samp ? OFF_CONV_S : OFF_CONV_P) + ((size_t)bidx * 2 + endj) * D + ch) = uu;
                }
            }
    }
};
struct Sched1 {
    pg::TileOrder o; const char* A; const char* B;
    __device__ bool next(int i, pg::Unit& u) const { int pm, pn; if (!o.get(i, pm, pn)) return false; u.pm = pm; u.pn = pn; u.kind = 0;
        u.A = A + (size_t)pm * 256 * D * 2; u.B = B + (size_t)pn * 256 * D * 2; return true; }
};

struct Epi3 {
    float* out; unsigned char* ws; const float* rstd0;
    __device__ __forceinline__ void operator()(const f32x4 (&acc)[2][2][4][2], const pg::Unit& u, int wr, int wc, int fr, int fq) const {
        const bool ptile = u.pm < NMT - 1;
        char* ga = slotbase(out, ws, 0, ptile); char* gb = slotbase(out, ws, 1, ptile); char* mb = (char*)ws + WS_R;
#pragma unroll
        for (int ai = 0; ai < 2; ++ai)
#pragma unroll
            for (int m = 0; m < 4; ++m) {
                const int row = u.pm * 256 + ai * 128 + wr * 64 + m * 16 + fr;
#pragma unroll
                for (int bj = 0; bj < 2; ++bj) {
                    const unsigned o = (unsigned)(row * D + u.pn * 256 + bj * 128 + wc * 32 + 8 * fq) * 2u;
                    const f32x4 a0 = acc[ai][bj][m][0], a1 = acc[ai][bj][m][1];
                    if (u.kind < 2) {
                        const float rs = -1.4426950408889634f; f32x4 g0, g1;
#pragma unroll
                        for (int j = 0; j < 4; ++j) { g0[j] = __builtin_amdgcn_rcpf(1.0f + __builtin_amdgcn_exp2f(a0[j] * rs)); g1[j] = __builtin_amdgcn_rcpf(1.0f + __builtin_amdgcn_exp2f(a1[j] * rs)); }
                        *(h16x8*)((u.kind == 0 ? ga : gb) + o) = cvt8(g0, g1);
                    } else if (u.kind == 3) {
                        const h16x8 g = *(const h16x8*)(gb + o);
                        const f32x4 g0 = up4(__builtin_shufflevector(g, g, 0, 1, 2, 3)), g1 = up4(__builtin_shufflevector(g, g, 4, 5, 6, 7));
                        *(h16x8*)(gb + o) = cvt8(g0 * a0, g1 * a1);
                    } else {
                        const h16x8 g = *(const h16x8*)(ga + o), t = *(const h16x8*)(gb + o);
                        const f32x4 t0 = up4(__builtin_shufflevector(t, t, 0, 1, 2, 3)), t1 = up4(__builtin_shufflevector(t, t, 4, 5, 6, 7));
                        const f32x4 g0 = up4(__builtin_shufflevector(g, g, 0, 1, 2, 3)), g1 = up4(__builtin_shufflevector(g, g, 4, 5, 6, 7));
                        { const u32x4 mv = __builtin_bit_cast(u32x4, cvt8(t0 + g0 * a0, t1 + g1 * a1)); char* mp = mb + o;
                          asm volatile("global_store_dwordx4 %0, %1, off sc1\n\ts_nop 1" :: "v"(mp), "v"(mv) : "memory"); }
                    }
                }
            }
    }
};
struct Sched3 {
    pg::TileOrder o; unsigned char* ws; int nk; int kinds;
    __device__ bool next(int i, pg::Unit& u) const { int pm, pn; const int q = i / nk, kind = (kinds >> (4 * (i - q * nk))) & 15; if (!o.get(q, pm, pn)) return false; u.pm = pm; u.pn = pn; u.kind = kind;
        const size_t aoff = kind < 2 ? WS_XH : kind == 2 ? WS_Z : WS_ACTB;
        const size_t boff = kind == 0 ? WS_W1T + (size_t)8448 * D * 2 : kind == 1 ? WS_W1T + (size_t)(8448 + 1024) * D * 2 : kind == 2 ? WS_WOA : WS_WOB;
        u.A = (const char*)ws + aoff + (size_t)pm * 256 * D * 2; u.B = (const char*)ws + boff + (size_t)pn * 256 * D * 2; return true; }
};
__device__ __forceinline__ void unit3(pg::Unit& u, unsigned char* ws, int pm, int pn, int kind) {
    u.pm = pm; u.pn = pn; u.kind = kind;
    const size_t aoff = kind < 2 ? WS_XH : kind == 2 ? WS_Z : WS_ACTB;
    const size_t boff = kind == 0 ? WS_W1T + (size_t)8448 * D * 2 : kind == 1 ? WS_W1T + (size_t)(8448 + 1024) * D * 2 : kind == 2 ? WS_WOA : WS_WOB;
    u.A = (const char*)ws + aoff + (size_t)pm * 256 * D * 2; u.B = (const char*)ws + boff + (size_t)pn * 256 * D * 2;
}
struct SchedH {
    pg::TileOrder o; unsigned char* ws; int c;
    __device__ bool next(int i, pg::Unit& u) const {
        const int nreg = c < 4 ? 2 : 4; int q, kind;
        if (i < 3 * nreg) { const int r = i / 3, kk = i - 3 * r; q = c + 128 * r; kind = kk == 2 ? 3 : kk; }
        else { const int e = i - 3 * nreg;
            if (c >= 4 && c < 12 && e == 0) { const int ob = c - 4; q = (ob & 3) + 128 * (2 + (ob >> 2)); kind = 0; }
            else if (c >= 12 && c < 20 && e < 2) { const int ob = c - 12; q = (ob & 3) + 128 * (2 + (ob >> 2)); kind = e == 0 ? 1 : 3; }
            else return false; }
        int pm, pn; if (!o.get_linear(q, pm, pn)) return false;
        unit3(u, ws, pm, pn, kind); return true; }
};
struct SchedList3 { unsigned char* ws; int pm, pn, n, kinds;
    __device__ bool next(int i, pg::Unit& u) const { if (i >= n) return false; unit3(u, ws, pm, pn, (kinds >> (4 * i)) & 15); return true; } };
struct SchedOne { const char* A; const char* B; int pm, pn, K;
    __device__ bool next(int i, pg::Unit& u) const { if (i >= 1) return false; u.pm = pm; u.pn = pn; u.kind = 0; u.A = A + (size_t)pm * 256 * K * 2; u.B = B + (size_t)pn * 256 * K * 2; return true; } };
__device__ __forceinline__ void sub_barrier(unsigned* cnt, unsigned n, int wave_s) {
    asm volatile("s_waitcnt vmcnt(0)" ::: "memory");
    __syncthreads();
    if (fresh_tid_w(wave_s) == 0) {
        __builtin_amdgcn_fence(__ATOMIC_RELEASE, "agent");
        asm volatile("s_waitcnt vmcnt(0)" ::: "memory");
        xb_add(cnt, 1u);
        unsigned sp = 0; while (xb_ld(cnt) < n) {     __builtin_amdgcn_s_sleep(2); if (++sp > (1u << 24)) break; }
        __builtin_amdgcn_fence(__ATOMIC_ACQUIRE, "agent");
        asm volatile("s_waitcnt vmcnt(0)" ::: "memory");
    }
    __syncthreads();
}

__device__ __forceinline__ float ssq_total(const float* ssq, int row, int fq) {
    const f32x4 v = *(const f32x4*)(ssq + (size_t)row * 16 + 4 * fq); float s = (v.x + v.y) + (v.z + v.w);
    s += __shfl_xor(s, 16); s += __shfl_xor(s, 32); return s;
}
__device__ __forceinline__ void st16_wt(char* p, h16x8 v) { const u32x4 d = __builtin_bit_cast(u32x4, v); asm volatile("global_store_dwordx4 %0, %1, off sc1\n\ts_nop 1" :: "v"(p), "v"(d) : "memory"); }
struct Epi4 {
    unsigned char* ws; const float* xp; const float* xs;
    __device__ __forceinline__ void operator()(const f32x4 (&acc)[2][2][4][2], const pg::Unit& u, int wr, int wc, int fr, int fq) const {
        float* ssq = (float*)(ws + WS_SSQ1);
        const char* xb = (const char*)ws + WS_XH; char* hb = (char*)ws + WS_K;
#pragma unroll
        for (int ai = 0; ai < 2; ++ai)
#pragma unroll
            for (int m = 0; m < 4; ++m) {
                const int row = u.pm * 256 + ai * 128 + wr * 64 + m * 16 + fr;
                const bool ok = row < MREAL; float s = 0.f;
                const float rms = ((const float*)(ws + WS_RSTD0))[ok ? row : 0];
#pragma unroll
                for (int bj = 0; bj < 2; ++bj) {
                    const unsigned e = (unsigned)(row * D + u.pn * 256 + bj * 128 + wc * 32 + 8 * fq);
                    if (ok) {
                        const h16x8 xh = *(const h16x8*)(xb + e * 2u);
                        const f32x4 x0 = up4(__builtin_shufflevector(xh, xh, 0, 1, 2, 3)) * rms + acc[ai][bj][m][0], x1 = up4(__builtin_shufflevector(xh, xh, 4, 5, 6, 7)) * rms + acc[ai][bj][m][1];
                        st16_wt(hb + e * 2u, cvt8(x0, x1));
                        s += (x0.x * x0.x + x0.y * x0.y) + (x0.z * x0.z + x0.w * x0.w) + (x1.x * x1.x + x1.y * x1.y) + (x1.z * x1.z + x1.w * x1.w);
                    }
                }
                s += __shfl_xor(s, 16); s += __shfl_xor(s, 32);
                if (ok && fq == 0) __hip_atomic_store(ssq + (unsigned)(row * 16 + u.pn * 4 + wc), s, __ATOMIC_RELAXED, __HIP_MEMORY_SCOPE_AGENT);
            }
    }
};
struct Sched4 { pg::TileOrder o; const char* A; const char* B;
    __device__ bool next(int i, pg::Unit& u) const { int pm, pn; if (!o.get(i, pm, pn)) return false; u.pm = pm; u.pn = pn; u.kind = 0;
        u.A = A + (size_t)pm * 256 * D * 2; u.B = B + (size_t)pn * 256 * D * 2; return true; } };
struct Epi5a {
    unsigned char* ws;
    __device__ __forceinline__ void operator()(const f32x4 (&acc)[2][2][4][2], const pg::Unit& u, int wr, int wc, int fr, int fq) const {
        const float* ssq = (const float*)(ws + WS_SSQ1); char* gbp = (char*)ws + WS_V;
#pragma unroll
        for (int ai = 0; ai < 2; ++ai)
#pragma unroll
            for (int m = 0; m < 4; ++m) {
                const int row = u.pm * 256 + ai * 128 + wr * 64 + m * 16 + fr;
                const int rowc = row < MREAL ? row : MREAL - 1;
                const float rs = -1.4426950408889634f * __builtin_amdgcn_rsqf(ssq_total(ssq, rowc, fq) * (1.0f / D) + EPS);
#pragma unroll
                for (int bj = 0; bj < 2; ++bj) {
                    const unsigned e = (unsigned)(row * D + u.pn * 256 + bj * 128 + wc * 32 + 8 * fq); f32x4 g0, g1;
#pragma unroll
                    for (int j = 0; j < 4; ++j) { g0[j] = __builtin_amdgcn_rcpf(1.0f + __builtin_amdgcn_exp2f(acc[ai][bj][m][0][j] * rs)); g1[j] = __builtin_amdgcn_rcpf(1.0f + __builtin_amdgcn_exp2f(acc[ai][bj][m][1][j] * rs)); }
                    *(h16x8*)(gbp + e * 2u) = cvt8(g0, g1);
                }
            }
    }
};
struct Epi5b {
    float* out; unsigned char* ws; const float* gfinal; gu32* ctl; LAS unsigned char* lx;
    __device__ __forceinline__ void operator()(f32x4 (&acc)[2][2][4][2], const pg::Unit& u, int wr, int wc, int fr_in, int fq_in) const {
        int fr = fr_in, fq = fq_in; asm volatile("" : "+v"(fr), "+v"(fq));
        const char* gbp = (const char*)ws + WS_V; const char* xhp = (const char*)ws + WS_K; char* ob = (char*)out;
        LAS float* P = (LAS float*)lx; LAS float* S = (LAS float*)(lx + 4096);
        const int wid = wr * 4 + wc, lane = fq * 16 + fr;
        LAS float* Pb = P + (wr * 64 + fr) * 4 + wc; const LAS float* Sb = S + wr * 64 + fr;
#pragma unroll
        for (int ai = 0; ai < 2; ++ai)
#pragma unroll
            for (int m = 0; m < 4; ++m) {
                const int rl = ai * 128 + wr * 64 + m * 16 + fr, row = u.pm * 256 + rl;
                const bool ok = row < MREAL; float s = 0.f;
#pragma unroll
                for (int bj = 0; bj < 2; ++bj) {
                    const unsigned e = (unsigned)(row * D + u.pn * 256 + bj * 128 + wc * 32 + 8 * fq);
                    if (ok) {
                        const h16x8 g = *(const h16x8*)(gbp + e * 2u), xh = *(const h16x8*)(xhp + e * 2u);
                        const f32x4 g0 = up4(__builtin_shufflevector(g, g, 0, 1, 2, 3)), g1 = up4(__builtin_shufflevector(g, g, 4, 5, 6, 7));
                        const f32x4 x0 = up4(__builtin_shufflevector(xh, xh, 0, 1, 2, 3)) + g0 * acc[ai][bj][m][0], x1 = up4(__builtin_shufflevector(xh, xh, 4, 5, 6, 7)) + g1 * acc[ai][bj][m][1];
                        acc[ai][bj][m][0] = x0; acc[ai][bj][m][1] = x1;
                        s += (x0.x * x0.x + x0.y * x0.y) + (x0.z * x0.z + x0.w * x0.w) + (x1.x * x1.x + x1.y * x1.y) + (x1.z * x1.z + x1.w * x1.w);
                    }
                }
                s += __shfl_xor(s, 16); s += __shfl_xor(s, 32);
                if (fq == 0) Pb[(ai * 128 + m * 16) * 4] = s;
                if (m & 1) asm volatile("" ::: "memory");
            }
        asm volatile("s_waitcnt lgkmcnt(0)" ::: "memory"); __builtin_amdgcn_s_barrier(); asm volatile("" ::: "memory");
        const int rrow = wid * 32 + (lane & 31);
        float* slots = (float*)(ws + WS_XCH) + ((size_t)u.pm * 256 + rrow) * 4;
        if (lane < 32) { const f32x4 p4 = *(const LAS f32x4*)(P + rrow * 4); __hip_atomic_store(slots + u.pn, (p4.x + p4.y) + (p4.z + p4.w), __ATOMIC_RELAXED, __HIP_MEMORY_SCOPE_AGENT); }
        asm volatile("s_waitcnt vmcnt(0)" ::: "memory");
        unsigned* cnt = (unsigned*)(ctl + CW_PANEL + 64 * u.pm);
        if (lane == 0) __hip_atomic_fetch_add(cnt, 1u, __ATOMIC_RELAXED, __HIP_MEMORY_SCOPE_AGENT);
        if (wid == 0) {
            unsigned sp = 0;
            while ((unsigned)__builtin_amdgcn_readfirstlane((int)__hip_atomic_load(cnt, __ATOMIC_RELAXED, __HIP_MEMORY_SCOPE_AGENT)) < 32u) { __builtin_amdgcn_s_sleep(2); if (++sp > (1u << 22)) break; }
            __builtin_amdgcn_fence(__ATOMIC_ACQUIRE, "agent");
        }
        asm volatile("s_waitcnt vmcnt(0) lgkmcnt(0)" ::: "memory"); __builtin_amdgcn_s_barrier(); asm volatile("" ::: "memory");
        if (lane < 32) { float t = 0.f;
#pragma unroll
            for (int q = 0; q < 4; ++q) t += __hip_atomic_load(slots + q, __ATOMIC_RELAXED, __HIP_MEMORY_SCOPE_AGENT);
            S[rrow] = __builtin_amdgcn_rsqf(t * (1.0f / D) + EPS); }
        asm volatile("s_waitcnt vmcnt(0) lgkmcnt(0)" ::: "memory"); __builtin_amdgcn_s_barrier(); asm volatile("" ::: "memory");
#pragma unroll
        for (int ai = 0; ai < 2; ++ai)
#pragma unroll
            for (int m = 0; m < 4; ++m) {
                const int rl = ai * 128 + wr * 64 + m * 16 + fr, row = u.pm * 256 + rl;
                const float rs = Sb[ai * 128 + m * 16];
                if (row < MREAL) {
#pragma unroll
                    for (int bj = 0; bj < 2; ++bj) {
                        const int col = u.pn * 256 + bj * 128 + wc * 32 + 8 * fq; const unsigned e = (unsigned)(row * D + col);
                        *(f32x4*)(ob + e * 4u) = acc[ai][bj][m][0] * rs * *(const f32x4*)(gfinal + col); *(f32x4*)(ob + e * 4u + 16) = acc[ai][bj][m][1] * rs * *(const f32x4*)(gfinal + col + 4);
                    }
                }
            }
        asm volatile("s_waitcnt lgkmcnt(0)" ::: "memory"); __builtin_amdgcn_s_barrier(); asm volatile("" ::: "memory");
    }
};
struct Sched5b { pg::TileOrder o; const char* A; const char* B;
    __device__ bool next(int i, pg::Unit& u) const { int pm, pn; if (!o.get(i, pm, pn)) return false; u.pm = pm; u.pn = pn; u.kind = 0;
        u.A = A + (size_t)pm * 256 * PLE * 2; u.B = B + (size_t)pn * 256 * PLE * 2; return true; } };

namespace s2 {
constexpr int RS = 72, MAT_B = 16 * RS * 2;
constexpr int CH_QT = 0, CH_RT = MAT_B, CH_BT = 2 * MAT_B, CH_KT = 3 * MAT_B, CH_VT = 4 * MAT_B, CH_MK = 5 * MAT_B, CH_NK = CH_MK + 512, CH_NB = CH_NK + 512, CH_TI = CH_NB + 512,
              CH_E8 = CH_TI + 512, CH_E16 = CH_E8 + 256, CH_BYTES = CH_E16 + 256;
constexpr int OFF_TW = 4 * CH_BYTES, OFF_AL = OFF_TW + 64 * RS * 2, OFF_YY = OFF_TW  , OFF_BON = OFF_AL + 64 * RS * 2, OFF_N2 = OFF_BON + 512, OFF_SZ = OFF_N2 + 512,
              OFF_CT = OFF_SZ + 8192, OFF_W2L = OFF_CT + 25 * 256, OFF_I2L = OFF_W2L + 64 * RS * 2, OFF_RAW = OFF_I2L + 64 * RS * 2;
constexpr int RAW_PLANE = 9216, RAW_R = 0, RAW_K = RAW_PLANE, RAW_V = 2 * RAW_PLANE, RAW_Z = 3 * RAW_PLANE, RAW_W = 4 * RAW_PLANE, RAW_BYTES = 4 * RAW_PLANE + 17408, OFF_END = OFF_RAW + RAW_BYTES;
static_assert(OFF_END <= SCAN_LDS_BYTES && 16384 <= 2 * 64 * RS * 2 && (OFF_RAW % 16) == 0, "scan LDS");
typedef short v4i16_t __attribute__((ext_vector_type(4)));
__device__ __forceinline__ f32x4 mm16(h16x4 a, h16x4 b, f32x4 c) {
    const h16x4 z = (h16x4){(h16)0.f, (h16)0.f, (h16)0.f, (h16)0.f};
    return __builtin_amdgcn_mfma_f32_16x16x32_f16(__builtin_shufflevector(a, z, 0, 1, 2, 3, 4, 5, 6, 7), __builtin_shufflevector(b, z, 0, 1, 2, 3, 4, 5, 6, 7), c, 0, 0, 0); }
__device__ __forceinline__ h16x4 ldtr(const LAS unsigned char* p) { return __builtin_bit_cast(h16x4, __builtin_amdgcn_ds_read_tr16_b64_v4i16((LAS v4i16_t*)p)); }
__device__ __forceinline__ h16x4 ldR(const LAS unsigned char* m, int row, int col) { return *(const LAS h16x4*)(m + (row * RS + col) * 2); }
__device__ __forceinline__ h16x4 ldS(const LAS unsigned char* m, int row, int col) { return *(const LAS h16x4*)(m + (row * 16 + col) * 2); }
template <int CTRL> __device__ __forceinline__ float dppf(float x) { return __builtin_bit_cast(float, __builtin_amdgcn_update_dpp(0, __builtin_bit_cast(int, x), CTRL, 0xf, 0xf, true)); }
__device__ __forceinline__ f32x4 mix4_(h16x4 c, h16x4 d, f32x4 mu) {
    return (f32x4){ __builtin_fmaf((float)d[0], mu[0], (float)c[0]), __builtin_fmaf((float)d[1], mu[1], (float)c[1]), __builtin_fmaf((float)d[2], mu[2], (float)c[2]), __builtin_fmaf((float)d[3], mu[3], (float)c[3]) }; }
typedef _Float16 h16x2 __attribute__((ext_vector_type(2)));
typedef unsigned u32x2 __attribute__((ext_vector_type(2)));
typedef _Float16 h16x2 __attribute__((ext_vector_type(2)));
#define HMUL(hv, i, b) __builtin_fmaf((float)(hv)[i], (b), 0.0f)
#define HFMA(hv, i, b, c) __builtin_fmaf((float)(hv)[i], (b), (c))
__device__ __forceinline__ float rowscan16(float x) { x += dppf<0x111>(x); x += dppf<0x112>(x); x += dppf<0x114>(x); x += dppf<0x118>(x); return x; }
}
__device__ __forceinline__ void scan_prefetch(LAS unsigned char* L, const unsigned char* ws, int wave, int lane, int h, int rr, bool skip0) {
    using namespace s2;
    for (int q = wave; q < 53; q += NWAVES) {
        if (q < 36) { const int p = q / 9, qq = q - 9 * p, r0 = 8 * qq + (lane >> 3), c = (lane & 7) ^ (r0 & 7);
            int r = r0 > 64 ? 64 : r0; if (skip0 && r == 0) r = 1;
            const size_t pb = p == 0 ? WS_R : p == 1 ? WS_K : p == 2 ? WS_V : WS_Z;
            __builtin_amdgcn_global_load_lds((const unsigned*)(ws + pb + (size_t)(rr + r) * 2048 + 128 * h + 16 * c), (LAS unsigned*)(L + OFF_RAW + p * RAW_PLANE + qq * 1024), 16, 0, 0);
        } else { const int qq = q - 36, r0 = 4 * qq + (lane >> 4), c = lane & 15, cs = (c & 8) | ((c & 7) ^ (r0 & 7));
            int r = r0 > 64 ? 64 : r0; if (skip0 && r == 0) r = 1;
            __builtin_amdgcn_global_load_lds((const unsigned*)(ws + WS_WA + (size_t)(rr + r) * 256 + 16 * cs), (LAS unsigned*)(L + OFF_RAW + RAW_W + qq * 1024), 16, 0, 0);
        }
    }
}
__device__ __forceinline__ void scan_prefetch_fast(LAS unsigned char* L, const unsigned char* ws, int wave, int lane, int h, int rr) {
    using namespace s2;
    if (wave < 4) {
        const int r_l = lane >> 3, cx = (lane & 7) ^ r_l;
        const size_t pb = wave == 0 ? WS_R : wave == 1 ? WS_K : wave == 2 ? WS_V : WS_Z;
        const unsigned char* base = ws + pb + 128 * h + 16 * cx;
        const unsigned char* a = base + (size_t)(rr + r_l) * 2048;
        LAS unsigned char* d = L + OFF_RAW + wave * RAW_PLANE;
#pragma unroll
        for (int qq = 0; qq < 8; ++qq) __builtin_amdgcn_global_load_lds((const unsigned*)(a + qq * 16384), (LAS unsigned*)(d + qq * 1024), 16, 0, 0);
        __builtin_amdgcn_global_load_lds((const unsigned*)(base + (size_t)(rr + 64) * 2048), (LAS unsigned*)(d + 8 * 1024), 16, 0, 0);
    } else {
        const int w4 = wave - 4, r_l = lane >> 4, c = lane & 15;
#pragma unroll
        for (int i = 0; i < 5; ++i) { const int qq = w4 + 4 * i;
            if (qq < 17) { const int r0 = 4 * qq + r_l, r = qq == 16 ? 64 : r0, cs = (c & 8) | ((c & 7) ^ (r0 & 7));
                __builtin_amdgcn_global_load_lds((const unsigned*)(ws + WS_WA + (size_t)(rr + r) * 256 + 16 * cs), (LAS unsigned*)(L + OFF_RAW + RAW_W + qq * 1024), 16, 0, 0); } }
    }
}
#define SBAR() do { asm volatile("s_waitcnt lgkmcnt(0)" ::: "memory"); __builtin_amdgcn_s_barrier(); asm volatile("" ::: "memory"); } while (0)
__device__ __forceinline__ void scan_head_v2(Frame& F, int bh, bool dry) {
    using namespace s2;
    const bool samp = bh >= 128; const int b = (bh & 127) >> 4, h = bh & 15;
    const int T = samp ? DSEQ : SEQ, row0 = samp ? NP + DSEQ * b : SEQ * b;
    unsigned char* ws = F.ws; float* out = F.out;
    char* Zb = (char*)(ws + WS_Z);
    LAS unsigned char* L = F.lds;
    const int tid = fresh_tid_w(F.wave_s), lane = tid & 63, wave = F.wave_s, c15 = lane & 15, g = lane >> 4;
    const int cw = wave & 3, hf = wave >> 2;
    scan_prefetch(L, ws, wave, lane, h, row0 - 1, true);
    for (int i = tid; i < 25 * 64; i += NWAVES * 64) { const int kind = i >> 6, k = i & 63, hk = 64 * h + k; float v;
        const float* mu = F.in[IN_MU]; const float* sh = F.in[IN_ST_SHIFT] + (size_t)b * SHIFT_COLS;
        switch (kind) { case 0: v = mu[hk]; break; case 1: v = mu[1024 + hk]; break; case 2: v = mu[2048 + hk]; break; case 3: v = mu[3200 + hk]; break;
            case 4: v = F.in[IN_KREM][hk]; break; case 5: v = F.in[IN_KREP][hk]; break; case 6: v = -1.4426950408889634f * F.in[IN_WDEC0][hk]; break; case 7: v = -1.4426950408889634f * F.in[IN_WICL0][hk]; break;
            case 8: v = F.in[IN_RBONUS][hk]; break; case 9: v = F.in[IN_GNW][hk]; break; case 10: v = F.in[IN_GNB][hk]; break; case 11: v = mu[3072 + k]; break; case 12: v = mu[3136 + k]; break;
            case 13: v = samp ? sh[hk] : 0.f; break; case 14: v = samp ? sh[1024 + hk] : 0.f; break; case 15: v = samp ? sh[2048 + hk] : 0.f; break; case 16: v = samp ? sh[3200 + hk] : 0.f; break;
            case 17: v = samp ? sh[3072 + k] : 0.f; break; case 18: v = samp ? sh[3136 + k] : 0.f; break;
            case 19: v = 1.f - F.in[IN_KREP][hk]; break; case 20: v = 1.f - mu[1024 + hk]; break; case 21: v = 1.f - mu[2048 + hk]; break; case 22: v = 1.f - mu[3200 + hk]; break;
            case 23: v = 1.f - mu[3072 + k]; break; default: v = 1.f - mu[3136 + k]; break; }
        *(LAS float*)(L + OFF_CT + i * 4) = v; }
    __syncthreads();
    for (int i = tid; i < 8 * 64; i += NWAVES * 64) { const int kind = i >> 6, k = i & 63;
        const int src = kind == 0 ? 0 : kind == 1 ? 1 : kind == 2 ? 2 : kind == 3 ? 3 : kind == 4 ? 4 : kind == 5 ? 8 : kind == 6 ? 11 : 12;
        const float v = *(const LAS float*)(L + OFF_CT + (src * 64 + k) * 4);
        asm volatile("" ::: "memory");
        *(LAS h16*)(L + OFF_CT + 20 * 256 + i * 2) = (h16)v; }
    { const int k = tid >> 3, ch = tid & 7;
      *(LAS h16x8*)(L + OFF_W2L + (k * RS + 8 * ch) * 2) = *(const h16x8*)((const h16*)(ws + WS_W2T) + (size_t)(64 * h + k) * 64 + 8 * ch);
      *(LAS h16x8*)(L + OFF_I2L + (k * RS + 8 * ch) * 2) = *(const h16x8*)((const h16*)(ws + WS_I2T) + (size_t)(64 * h + k) * 64 + 8 * ch); }
#define CT4(kind, k) (*(const LAS f32x4*)(L + OFF_CT + ((kind) * 64 + (k)) * 4))
#define CTH4(kind, k) (*(const LAS h16x4*)(L + OFF_CT + 20 * 256 + ((kind) * 64 + (k)) * 2))
#define CTH8(kind, k) (*(const LAS h16x8*)(L + OFF_CT + 20 * 256 + ((kind) * 64 + (k)) * 2))
#define CT1(kind, k) (*(const LAS float*)(L + OFF_CT + ((kind) * 64 + (k)) * 4))
#define RAW8(p, row, kc) (*(const LAS h16x4*)(L + OFF_RAW + (p) * RAW_PLANE + (row) * 128 + ((((kc) >> 3) ^ ((row) & 7)) << 4) + ((kc) & 7) * 2))
#define RAWW8(row, hc) (*(const LAS h16x4*)(L + OFF_RAW + RAW_W + (row) * 256 + (((((hc) >> 3) & 8) | ((((hc) >> 3) & 7) ^ ((row) & 7))) << 4) + ((hc) & 7) * 2))
    f32x4 S[4];
#pragma unroll
    for (int kt = 0; kt < 4; ++kt) { S[kt] = (f32x4){0.f, 0.f, 0.f, 0.f};
        if (samp && wave < 4) S[kt] = *(const f32x4*)(F.in[IN_ST_WKV] + ((size_t)(b * 16 + h) * 64 + 16 * wave + c15) * 64 + 16 * kt + 4 * g); }
    asm volatile("s_waitcnt vmcnt(0)" ::: "memory");
    SBAR();
    if (tid < 96) { const int kind = tid >> 4, c4 = (tid & 15) * 4;
        const int ctk = kind < 3 ? 13 + kind : kind == 3 ? 16 : 13 + kind; const h16x4 v = cvt4(CT4(ctk, c4));
        if (kind < 4) *(LAS h16x4*)(L + OFF_RAW + kind * RAW_PLANE + (((c4 >> 3) ^ 0) << 4) + (c4 & 7) * 2) = v;
        else { const int hc = (kind - 4) * 64 + c4; *(LAS h16x4*)(L + OFF_RAW + RAW_W + ((((hc >> 3) & 8) | (((hc >> 3) & 7) ^ 0)) << 4) + (hc & 7) * 2) = v; } }
    SBAR();
    for (int t0 = 0; t0 < T; t0 += 64) {
        const int nb = (T - t0) < 64 ? (T - t0) : 64, nch = nb >> 4;
        const bool cact = cw < nch;
        const int tl = 16 * cw + c15;
        LAS unsigned char* CB = L + cw * CH_BYTES;
        h16x4 rm[2], km[2], kapm[2], rbm[2]; float n2 = 0.f;
#define MIX4(c, p, mu4) mix4_((c), (p) - (c), (mu4))
        if (cact) {
#pragma unroll
            for (int kt = 0; kt < 2; ++kt) {
                const int kc = 32 * hf + 16 * kt + 4 * g;
                const h16x4 rc = RAW8(0, tl + 1, kc), kc4 = RAW8(1, tl + 1, kc), vc = RAW8(2, tl + 1, kc), wlc = RAWW8(tl + 1, kc), alc = RAWW8(tl + 1, 64 + kc);
                const h16x4 rp = RAW8(0, tl, kc), kp = RAW8(1, tl, kc), vp = RAW8(2, tl, kc), wlp = RAWW8(tl, kc), alp = RAWW8(tl, 64 + kc);
                const h16x4 r16 = rc + CTH4(0, kc) * (rp - rc), k16 = kc4 + CTH4(1, kc) * (kp - kc4), v16 = vc + CTH4(2, kc) * (vp - vc);
                const h16x4 wl16 = wlc + CTH4(6, kc) * (wlp - wlc), al16 = alc + CTH4(7, kc) * (alp - alc);
                const h16x4 kap16 = k16 * CTH4(4, kc), rb16 = r16 * CTH4(5, kc);
                rm[kt] = r16; km[kt] = k16; kapm[kt] = kap16; rbm[kt] = rb16;
                n2 = __builtin_amdgcn_fdot2(__builtin_shufflevector(kap16, kap16, 0, 1), __builtin_shufflevector(kap16, kap16, 0, 1), n2, false);
                n2 = __builtin_amdgcn_fdot2(__builtin_shufflevector(kap16, kap16, 2, 3), __builtin_shufflevector(kap16, kap16, 2, 3), n2, false);
                f32x4 tw;
#pragma unroll
                for (int i = 0; i < 4; ++i) tw[i] = __builtin_fmaf(-2.0f, __builtin_amdgcn_rcpf(1.0f + __builtin_amdgcn_exp2f(HMUL(wl16, i, 2.0f * 1.4426950408889634f))), 1.0f);
                *(LAS h16x4*)(L + OFF_TW + (tl * RS + kc) * 2) = cvt4(tw); *(LAS h16x4*)(L + OFF_AL + (tl * RS + kc) * 2) = al16;
                *(LAS h16x4*)(CB + CH_VT + (c15 * RS + kc) * 2) = v16;
            }
            n2 += __shfl_xor(n2, 16); n2 += __shfl_xor(n2, 32);
            if (g == 0) *(LAS float*)(L + OFF_N2 + (hf * 64 + tl) * 4) = n2;
        }
        {
            const int t = tid >> 3, vg = tid & 7, v0 = 8 * vg;
            if (t < nb) {
                const h16x8 zc8 = *(const LAS h16x8*)(L + OFF_RAW + RAW_Z + (t + 1) * 128 + ((vg ^ ((t + 1) & 7)) << 4));
                const h16x8 zp8 = *(const LAS h16x8*)(L + OFF_RAW + RAW_Z + t * 128 + ((vg ^ (t & 7)) << 4));
                const h16x8 z8 = zc8 + CTH8(3, v0) * (zp8 - zc8);
                float sv[8];
#pragma unroll
                for (int j = 0; j < 8; ++j) sv[j] = HMUL(z8, j, __builtin_amdgcn_rcpf(1.0f + __builtin_amdgcn_exp2f(HMUL(z8, j, -1.4426950408889634f))));
                *(LAS h16x8*)(L + OFF_SZ + (t * 64 + v0) * 2) = cvt8((f32x4){sv[0], sv[1], sv[2], sv[3]}, (f32x4){sv[4], sv[5], sv[6], sv[7]});
            }
        }
        SBAR();
        if (t0 + 64 < T) scan_prefetch_fast(L, ws, wave, lane, h, row0 + t0 + 63);
        if (cact) {
            f32x4 dacc[2], aacc[2];
#pragma unroll
            for (int kt = 0; kt < 2; ++kt) { dacc[kt] = CT4(6, 32 * hf + 16 * kt + 4 * g); aacc[kt] = CT4(7, 32 * hf + 16 * kt + 4 * g); }
#pragma unroll
            for (int jp = 0; jp < 2; ++jp) {
                const h16x4 tw0 = *(const LAS h16x4*)(L + OFF_TW + (tl * RS + 32 * jp + 4 * g) * 2), tw1 = *(const LAS h16x4*)(L + OFF_TW + (tl * RS + 32 * jp + 16 + 4 * g) * 2);
                const h16x4 al0 = *(const LAS h16x4*)(L + OFF_AL + (tl * RS + 32 * jp + 4 * g) * 2), al1 = *(const LAS h16x4*)(L + OFF_AL + (tl * RS + 32 * jp + 16 + 4 * g) * 2);
                const h16x8 twf = __builtin_shufflevector(tw0, tw1, 0, 1, 2, 3, 4, 5, 6, 7), alf = __builtin_shufflevector(al0, al1, 0, 1, 2, 3, 4, 5, 6, 7);
#pragma unroll
                for (int kt = 0; kt < 2; ++kt) { const int o = ((32 * hf + 16 * kt + c15) * RS + 32 * jp + 4 * g) * 2;
                    const h16x8 wf = __builtin_shufflevector(*(const LAS h16x4*)(L + OFF_W2L + o), *(const LAS h16x4*)(L + OFF_W2L + o + 32), 0, 1, 2, 3, 4, 5, 6, 7);
                    const h16x8 jf = __builtin_shufflevector(*(const LAS h16x4*)(L + OFF_I2L + o), *(const LAS h16x4*)(L + OFF_I2L + o + 32), 0, 1, 2, 3, 4, 5, 6, 7);
                    dacc[kt] = __builtin_amdgcn_mfma_f32_16x16x32_f16(wf, twf, dacc[kt], 0, 0, 0); aacc[kt] = __builtin_amdgcn_mfma_f32_16x16x32_f16(jf, alf, aacc[kt], 0, 0, 0); }
            }
            const float rn = __builtin_amdgcn_rsqf(fmaxf(*(const LAS float*)(L + OFF_N2 + tl * 4) + *(const LAS float*)(L + OFF_N2 + (64 + tl) * 4), 1e-24f));
            float bs = 0.f;
#pragma unroll
            for (int kt = 0; kt < 2; ++kt) {
                const int kc = 32 * hf + 16 * kt + 4 * g;
                const f32x4 krep = CT4(5, kc), omk = CT4(19, kc);
                f32x4 qt, rt, bt, kt4, e8v, e16v, khv, ktvv, bbv, Lcv, Lpv, refv;
#pragma unroll
                for (int i = 0; i < 4; ++i) {
                    const float lam = __builtin_amdgcn_rcpf(__builtin_fmaf(__builtin_amdgcn_exp2f(dacc[kt][i]), -1.0f / (DECAY_SCALE * 1.4426950408889634f), -1.0f / (DECAY_SCALE * 1.4426950408889634f))), a = __builtin_amdgcn_rcpf(1.0f + __builtin_amdgcn_exp2f(aacc[kt][i]));
                    khv[i] = HMUL(kapm[kt], i, rn); ktvv[i] = HMUL(km[kt], i, __builtin_fmaf(a, krep[i], omk[i])); bbv[i] = a * khv[i];
                    bs = HFMA(rbm[kt], i, ktvv[i], bs);
                    Lcv[i] = rowscan16(lam); Lpv[i] = Lcv[i] - lam;
                }
#pragma unroll
                for (int i = 0; i < 4; ++i) { refv[i] = __shfl(Lcv[i], (lane & 48) | 7); e16v[i] = __shfl(Lcv[i], (lane & 48) | 15); }
#pragma unroll
                for (int i = 0; i < 4; ++i) {
                    const float ea = __builtin_amdgcn_exp2f(Lpv[i] - refv[i]), eb = __builtin_amdgcn_exp2f(Lcv[i] - refv[i]), ec = __builtin_amdgcn_rcpf(eb);
                    qt[i] = khv[i] * ea; rt[i] = HMUL(rm[kt], i, eb); bt[i] = bbv[i] * ec; kt4[i] = ktvv[i] * ec; e8v[i] = refv[i];
                }
                const int o = (c15 * RS + kc) * 2;
                *(LAS h16x4*)(CB + CH_QT + o) = cvt4(qt); *(LAS h16x4*)(CB + CH_RT + o) = cvt4(rt); *(LAS h16x4*)(CB + CH_BT + o) = cvt4(bt); *(LAS h16x4*)(CB + CH_KT + o) = cvt4(kt4);
                if (c15 == 0) { *(LAS f32x4*)(CB + CH_E8 + kc * 4) = e8v; *(LAS f32x4*)(CB + CH_E16 + kc * 4) = e16v; }
            }
            bs += __shfl_xor(bs, 16); bs += __shfl_xor(bs, 32);
            if (g == 0) *(LAS float*)(L + OFF_BON + (hf * 64 + tl) * 4) = bs;
        }
        SBAR();
        if (cact) {
            h16x8 qf[2], bf[2];
#pragma unroll
            for (int p = 0; p < 2; ++p) { qf[p] = __builtin_shufflevector(ldR(CB + CH_QT, c15, 32 * p + 4 * g), ldR(CB + CH_QT, c15, 32 * p + 16 + 4 * g), 0, 1, 2, 3, 4, 5, 6, 7);
                bf[p] = __builtin_shufflevector(ldR(CB + CH_BT, c15, 32 * p + 4 * g), ldR(CB + CH_BT, c15, 32 * p + 16 + 4 * g), 0, 1, 2, 3, 4, 5, 6, 7); }
            const f32x4 z4 = (f32x4){0.f, 0.f, 0.f, 0.f};
            if (hf == 0) {
                f32x4 Dr = z4, Dc = z4;
#pragma unroll
                for (int p = 0; p < 2; ++p) { Dr = __builtin_amdgcn_mfma_f32_16x16x32_f16(bf[p], qf[p], Dr, 0, 0, 0); Dc = __builtin_amdgcn_mfma_f32_16x16x32_f16(qf[p], bf[p], Dc, 0, 0, 0); }
                f32x4 Xr, Xc, Id;
#pragma unroll
                for (int i = 0; i < 4; ++i) { const int u = 4 * g + i; Xr[i] = u < c15 ? -Dr[i] : 0.f; Xc[i] = c15 < u ? -Dc[i] : 0.f; Id[i] = u == c15 ? 1.f : 0.f; }
                const h16x4 hXr = cvt4(Xr), hXc = cvt4(Xc);
                const f32x4 X2c = mm16(hXr, hXc, z4), X2r = mm16(hXc, hXr, z4);
                const f32x4 S1c = Id + Xc, S1r = Id + Xr;
                const h16x4 hX2r = cvt4(X2r), hX2c = cvt4(X2c), hS1c = cvt4(S1c);
                const f32x4 S2c = mm16(hX2r, hS1c, S1c), S2r = mm16(hS1c, hX2r, S1r);
                const f32x4 X4c = mm16(hX2r, hX2c, z4), X4r = mm16(hX2c, hX2r, z4);
                const h16x4 hX4r = cvt4(X4r), hX4c = cvt4(X4c), hS2c = cvt4(S2c);
                const f32x4 S4c = mm16(hX4r, hS2c, S2c), S4r = mm16(hS2c, hX4r, S2r);
                const f32x4 X8r = mm16(hX4c, hX4r, z4);
                const f32x4 TIr = mm16(cvt4(S4c), cvt4(X8r), S4r);
                *(LAS h16x4*)(CB + CH_TI + (c15 * 16 + 4 * g) * 2) = cvt4(TIr);
            } else {
                h16x8 kf[2], rf[2];
#pragma unroll
                for (int p = 0; p < 2; ++p) { kf[p] = __builtin_shufflevector(ldR(CB + CH_KT, c15, 32 * p + 4 * g), ldR(CB + CH_KT, c15, 32 * p + 16 + 4 * g), 0, 1, 2, 3, 4, 5, 6, 7);
                    rf[p] = __builtin_shufflevector(ldR(CB + CH_RT, c15, 32 * p + 4 * g), ldR(CB + CH_RT, c15, 32 * p + 16 + 4 * g), 0, 1, 2, 3, 4, 5, 6, 7); }
                f32x4 mk = z4, nk = z4, nbm = z4;
#pragma unroll
                for (int p = 0; p < 2; ++p) { mk = __builtin_amdgcn_mfma_f32_16x16x32_f16(kf[p], qf[p], mk, 0, 0, 0); nk = __builtin_amdgcn_mfma_f32_16x16x32_f16(kf[p], rf[p], nk, 0, 0, 0); nbm = __builtin_amdgcn_mfma_f32_16x16x32_f16(bf[p], rf[p], nbm, 0, 0, 0); }
#pragma unroll
                for (int i = 0; i < 4; ++i) { const int u = 4 * g + i; if (!(u < c15)) mk[i] = 0.f; if (!(u <= c15)) { nk[i] = 0.f; nbm[i] = 0.f; } }
                const int o = (c15 * 16 + 4 * g) * 2;
                *(LAS h16x4*)(CB + CH_MK + o) = cvt4(mk); *(LAS h16x4*)(CB + CH_NK + o) = cvt4(nk); *(LAS h16x4*)(CB + CH_NB + o) = cvt4(nbm);
                { LAS float* e8 = (LAS float*)(CB + CH_E8) + lane; LAS float* e16 = (LAS float*)(CB + CH_E16) + lane; const float rf = *e8; *e8 = __builtin_amdgcn_exp2f(rf); *e16 = __builtin_amdgcn_exp2f(*e16 - rf); }
            }
        }
        SBAR();
        if (wave < 4) {
            const int troff = ((4 * g + (c15 >> 2)) * RS + 4 * (c15 & 3)) * 2;
            for (int c = 0; c < nch; ++c) {
                const LAS unsigned char* B = L + c * CH_BYTES;
                f32x4 e8[4], e16[4]; h16x4 q[4], r[4], ktr[4], btr[4];
#pragma unroll
                for (int kt = 0; kt < 4; ++kt) { e8[kt] = *(const LAS f32x4*)(B + CH_E8 + (16 * kt + 4 * g) * 4); q[kt] = ldR(B + CH_QT, c15, 16 * kt + 4 * g); }
                const h16x4 vh = ldtr(B + CH_VT + troff + 16 * wave * 2), mk = ldS(B + CH_MK, c15, 4 * g), ti = ldS(B + CH_TI, c15, 4 * g), nk = ldS(B + CH_NK, c15, 4 * g), nbm = ldS(B + CH_NB, c15, 4 * g);
#pragma unroll
                for (int kt = 0; kt < 4; ++kt) { r[kt] = ldR(B + CH_RT, c15, 16 * kt + 4 * g); ktr[kt] = ldtr(B + CH_KT + troff + 16 * kt * 2); btr[kt] = ldtr(B + CH_BT + troff + 16 * kt * 2);
                    e16[kt] = *(const LAS f32x4*)(B + CH_E16 + (16 * kt + 4 * g) * 4); }
                f32x4 S8[4]; h16x4 s8h[4];
#pragma unroll
                for (int kt = 0; kt < 4; ++kt) { S8[kt] = S[kt] * e8[kt]; s8h[kt] = cvt4(S8[kt]); }
                const f32x4 z4 = (f32x4){0.f, 0.f, 0.f, 0.f};
                const h16x8 s01 = __builtin_shufflevector(s8h[0], s8h[1], 0, 1, 2, 3, 4, 5, 6, 7), s23 = __builtin_shufflevector(s8h[2], s8h[3], 0, 1, 2, 3, 4, 5, 6, 7);
                f32x4 Pa = mm16(mk, vh, z4);
                Pa = __builtin_amdgcn_mfma_f32_16x16x32_f16(__builtin_shufflevector(q[0], q[1], 0, 1, 2, 3, 4, 5, 6, 7), s01, Pa, 0, 0, 0);
                const f32x4 Pb = __builtin_amdgcn_mfma_f32_16x16x32_f16(__builtin_shufflevector(q[2], q[3], 0, 1, 2, 3, 4, 5, 6, 7), s23, z4, 0, 0, 0);
                const f32x4 sg = mm16(ti, cvt4(Pa + Pb), z4);
                const h16x4 sn = -cvt4(sg);
                f32x4 Ya = mm16(nk, vh, z4);
                Ya = __builtin_amdgcn_mfma_f32_16x16x32_f16(__builtin_shufflevector(r[0], r[1], 0, 1, 2, 3, 4, 5, 6, 7), s01, Ya, 0, 0, 0);
                f32x4 Yb = __builtin_amdgcn_mfma_f32_16x16x32_f16(__builtin_shufflevector(r[2], r[3], 0, 1, 2, 3, 4, 5, 6, 7), s23, z4, 0, 0, 0);
#pragma unroll
                for (int kt = 0; kt < 4; ++kt) S8[kt] = mm16(ktr[kt], vh, S8[kt]);
                Yb = mm16(nbm, sn, Yb);
#pragma unroll
                for (int kt = 0; kt < 4; ++kt) S[kt] = mm16(btr[kt], sn, S8[kt]) * e16[kt];
                const f32x4 Y = Ya + Yb;
#pragma unroll
                for (int i = 0; i < 4; ++i) *(LAS float*)(L + OFF_YY + ((16 * c + 4 * g + i) * 64 + 16 * wave + c15) * 4) = Y[i];
            }
        }
        asm volatile("s_waitcnt vmcnt(0)" ::: "memory");
        SBAR();
        {
            const int t = tid >> 3, vg = tid & 7, v0 = 8 * vg;
            if (t < nb) {
                const f32x4 y0 = *(const LAS f32x4*)(L + OFF_YY + (t * 64 + v0) * 4), y1 = *(const LAS f32x4*)(L + OFF_YY + (t * 64 + v0 + 4) * 4);
                float y[8] = {y0.x, y0.y, y0.z, y0.w, y1.x, y1.y, y1.z, y1.w};
                float s = 0.f;
#pragma unroll
                for (int j = 0; j < 8; ++j) s += y[j];
                s += dppf<0xB1>(s); s += dppf<0x4E>(s); s += dppf<0x141>(s);
                const float mean = s * (1.0f / 64.0f); float q = 0.f;
#pragma unroll
                for (int j = 0; j < 8; ++j) { y[j] -= mean; q += y[j] * y[j]; }
                q += dppf<0xB1>(q); q += dppf<0x4E>(q); q += dppf<0x141>(q);
                const float rstd = __builtin_amdgcn_rsqf(q * (1.0f / 64.0f) + GN_EPS);
                const float bonus = *(const LAS float*)(L + OFF_BON + t * 4) + *(const LAS float*)(L + OFF_BON + (64 + t) * 4);
                const h16x8 vv = *(const LAS h16x8*)(L + (t >> 4) * CH_BYTES + CH_VT + ((t & 15) * RS + v0) * 2);
                const h16x8 sz = *(const LAS h16x8*)(L + OFF_SZ + (t * 64 + v0) * 2);
                const f32x4 gw0 = CT4(9, v0), gw1 = CT4(9, v0 + 4), gb0 = CT4(10, v0), gb1 = CT4(10, v0 + 4);
                h16x8 o;
#pragma unroll
                for (int j = 0; j < 8; ++j) o[j] = (h16)((y[j] * rstd * (j < 4 ? gw0[j & 3] : gw1[j & 3]) + (j < 4 ? gb0[j & 3] : gb1[j & 3]) + bonus * (float)vv[j]) * (float)sz[j]);
                if (!dry) { char* zp = Zb + (size_t)(row0 + t0 + t) * 2048 + 128 * h + 16 * vg; const u32x4 ov = __builtin_bit_cast(u32x4, o);
                    asm volatile("global_store_dwordx4 %0, %1, off sc1\n\ts_nop 1" :: "v"(zp), "v"(ov) : "memory"); }
            }
        }
        if (!samp && (t0 & 255) == 192) {
            asm volatile("s_waitcnt vmcnt(0)" ::: "memory");
            SBAR();
            if (tid == 0 && !dry) __hip_atomic_fetch_add((unsigned*)(F.ctl + CW_RDY) + 64 * (b * 16 + (t0 >> 8)), 1u, __ATOMIC_RELAXED, __HIP_MEMORY_SCOPE_AGENT);
        } else SBAR();
    }
#undef CT4
#undef CT1
#undef RAW8
#undef RAWW8
    if (wave < 4 && !dry) {
#pragma unroll
        for (int kt = 0; kt < 4; ++kt) *(f32x4*)(out + (samp ? OFF_WKV_S : OFF_WKV_P) + ((size_t)(b * 16 + h) * 64 + 16 * wave + c15) * 64 + 16 * kt + 4 * g) = S[kt];
    }
    asm volatile("s_waitcnt vmcnt(0)" ::: "memory");
    __syncthreads();
}
__device__ __forceinline__ void conv_pass(Frame& F, int part, int nparts) {
    const int tid_ = fresh_tid_w(F.wave_s);
    float* out = F.out; unsigned char* ws = F.ws; const float* cw = F.in[IN_CONVW]; h16* AB = (h16*)(ws + WS_ACTB);
    for (int it = part * 512 + tid_; it < (NMT - 1) * 2 * 128; it += nparts * 512) {
        const int c8 = (it & 127) * 8, m = (it >> 7) & 1, pm = it >> 8;
        if ((pm & 15) == 0) continue;
        const float* sp = (const float*)(ws + WS_SIDEP) + (size_t)pm * 2048 + m * 1024 + c8; const float* sg = (const float*)(ws + WS_SIDEG) + (size_t)pm * 2048 + m * 1024 + c8;
        const float* su = (const float*)(ws + WS_SIDEU) + (size_t)(pm - 1) * 2048 + c8;
        h16x8 o;
#pragma unroll
        for (int j = 0; j < 8; ++j) { const float um2 = su[j], um1 = su[1024 + j];
            const float extra = m == 0 ? cw[c8 + j] * um2 + cw[D + c8 + j] * um1 : cw[c8 + j] * um1;
            o[j] = (h16)(sp[j] + sg[j] * extra); }
        *(h16x8*)(AB + ((size_t)pm * 256 + m) * D + c8) = o;
    }
    for (int it = part * 512 + tid_; it < NS * 128; it += nparts * 512) {
        const int row = NP + (it >> 7), c8 = (it & 127) * 8, rr = row - NP, t = rr & (DSEQ - 1), b = rr >> 4;
        const h16x8 u0 = *(const h16x8*)(rowptr16(out, ws, 0, row) + c8), gz = *(const h16x8*)(rowptr16(out, ws, 1, row) + c8);
        float um1[8], um2[8];
        if (t >= 1) { const h16x8 v = *(const h16x8*)(rowptr16(out, ws, 0, row - 1) + c8);
#pragma unroll
            for (int j = 0; j < 8; ++j) um1[j] = (float)v[j]; }
        else {
#pragma unroll
            for (int j = 0; j < 8; ++j) um1[j] = F.in[IN_ST_CONV][((size_t)b * 2 + 1) * D + c8 + j]; }
        if (t >= 2) { const h16x8 v = *(const h16x8*)(rowptr16(out, ws, 0, row - 2) + c8);
#pragma unroll
            for (int j = 0; j < 8; ++j) um2[j] = (float)v[j]; }
        else {
#pragma unroll
            for (int j = 0; j < 8; ++j) um2[j] = F.in[IN_ST_CONV][((size_t)b * 2 + t) * D + c8 + j]; }
        h16x8 o;
#pragma unroll
        for (int j = 0; j < 8; ++j) { const float cv = cw[c8 + j] * um2[j] + cw[D + c8 + j] * um1[j] + cw[2 * D + c8 + j] * (float)u0[j]; o[j] = (h16)((float)gz[j] * cv); }
        *(h16x8*)(AB + (size_t)row * D + c8) = o;
    }
    for (int i = part * 512 + tid_; i < (MP - MREAL) * 128; i += nparts * 512) { h16x8 z;
#pragma unroll
        for (int j = 0; j < 8; ++j) z[j] = (h16)0.f;
        *(h16x8*)(AB + (size_t)MREAL * D + (size_t)i * 8) = z; }
}

constexpr int N_PHASES = 6;
__device__ __forceinline__ void merge_queue(Frame& F, const float* rstd0, bool wait_helpers) {
    unsigned char* ws = F.ws;
    for (;;) {
        if (fresh_tid_w(F.wave_s) == 0) {
            unsigned sp = 0;
            if (wait_helpers) { unsigned* hd = (unsigned*)(F.ctl + CW_SUB); while (xb_ld(hd) < 2u * (unsigned)(F.G - 128)) { __builtin_amdgcn_s_sleep(8); if (++sp > (1u << 24)) break; } }
            const unsigned idx = xb_add((unsigned*)(F.ctl + CW_MQ), 1u);
            if (idx < 512u) {
                unsigned* rdy = (unsigned*)(F.ctl + CW_RDY) + 64 * (((idx >> 2) & 7) * 16 + (idx >> 5)); sp = 0;
                while (xb_ld(rdy) < 16u) { __builtin_amdgcn_s_sleep(8); if (++sp > (1u << 24)) break; }
                __builtin_amdgcn_fence(__ATOMIC_ACQUIRE, "agent");
                asm volatile("s_waitcnt vmcnt(0)" ::: "memory");
            }
            F.MISC[0] = idx;
        }
        __syncthreads();
        const unsigned idx = (unsigned)__builtin_amdgcn_readfirstlane((int)F.MISC[0]);
        if (idx >= 512u) break;
        const int pm = (int)(((idx >> 2) & 7) * 16 + (idx >> 5));
        SchedList3 S{ws, pm, (int)(idx & 3), 1, 0x2}; Epi3 E{F.out, ws, rstd0};
        pg::gemm_phase(F.lds, F.wave_s, D, S, E);
        if (fresh_tid_w(F.wave_s) == 0) { xb_add((unsigned*)(F.ctl + CW_MRG) + 64 * pm, 1u); xb_add((unsigned*)(F.ctl + CW_MALL), 1u); }
    }
}
__device__ __forceinline__ void p4_queue(Frame& F) {
    unsigned char* ws = F.ws;
    int qi = 0;
    for (;;) {
        if (fresh_tid_w(F.wave_s) == 0) {
            unsigned got = 0xFFFFFFFFu;
            while (qi < 8) { const unsigned x = (unsigned)((F.bx + qi) & 7); const unsigned idx = xb_add((unsigned*)(F.ctl + CW_P4Q) + 32 * x, 1u); if (idx < 64u) { got = x * 64u + idx; break; } ++qi; }
            if (got != 0xFFFFFFFFu) {
                unsigned* m = (unsigned*)(F.ctl + CW_MRG) + 64 * (16 * (got >> 6) + ((got & 63u) >> 2)); unsigned sp = 0;
                while (xb_ld(m) < 4u) { __builtin_amdgcn_s_sleep(8); if (++sp > (1u << 24)) break; }
                __builtin_amdgcn_fence(__ATOMIC_ACQUIRE, "agent");
                asm volatile("s_waitcnt vmcnt(0)" ::: "memory");
            }
            F.MISC[0] = got;
        }
        __syncthreads();
        const unsigned got = (unsigned)__builtin_amdgcn_readfirstlane((int)F.MISC[0]);
        if (got == 0xFFFFFFFFu) break;
        const int pm = (int)(16 * (got >> 6) + ((got & 63u) >> 2));
        SchedOne S{(const char*)ws + WS_R, (const char*)ws + WS_WOUT, pm, (int)(got & 3u), D}; Epi4 E{ws, F.in[IN_X_P], F.in[IN_X_S]};
        pg::gemm_phase(F.lds, F.wave_s, D, S, E);
        if (fresh_tid_w(F.wave_s) == 0) xb_add((unsigned*)(F.ctl + CW_P4D) + 64 * pm, 1u);
    }
}
__global__ void __launch_bounds__(NWAVES * 64, 2) mk_fwd(Args args) {
    extern __shared__ __attribute__((aligned(16))) unsigned char lds[];
    Frame F;
    F.lds = (LAS unsigned char*)lds; F.MISC = (volatile LAS unsigned*)(F.lds + MISC_OFF);
    F.wave_s = __builtin_amdgcn_readfirstlane((int)threadIdx.x >> 6);
    F.G = gridDim.x; F.bx = blockIdx.x; F.in = args.in; F.out = args.out; F.ws = args.ws;
    F.ctl = (gu32*)(args.ws + WS_CTL);
    for (int u = fresh_tid_w(F.wave_s); u < (LDS_BYTES - LDSCTL_OFF) / 4; u += NWAVES * 64) ((LAS unsigned*)(F.lds + LDSCTL_OFF))[u] = 0u;
    __syncthreads();
    XcdBarrier bar; bar.bar = (unsigned*)(F.ctl + CW_BAR); bar.x = 0; bar.st = nullptr;
    const int lo = args.ph_lo, hi = args.ph_hi;
    if (hi - lo > 1) bar = xcd_barrier_post((unsigned*)(F.ctl + CW_BAR), F.MISC + 8, F.wave_s);
#define IN(k) (lo <= (k) && (k) < hi)
#define SEAM(k) do { if (IN(k) && IN((k) + 1)) xcd_barrier(bar, F.wave_s); } while (0)
    unsigned char* ws = args.ws;
    const float* rstd0 = (const float*)(ws + WS_RSTD0);
#define REPS(k) _Pragma("unroll") for (int _r = (PROBE_PHASE == (k)) ? 0 : 1; _r < 2; ++_r)
    if (IN(0)) { REPS(0) { p0_prologue(F); asm volatile("s_waitcnt vmcnt(0)" ::: "memory"); __syncthreads(); } SEAM(0); }
    if (IN(1)) {
        REPS(1) {
        Sched1 S; S.o.init(NMT, 33, F.G, F.bx); S.A = (const char*)ws + WS_XH; S.B = (const char*)ws + WS_W1T;
        Epi1 E{F.out, ws, rstd0, F.in[IN_CONVW], F.lds + RING_BYTES};
        pg::gemm_phase<Sched1, Epi1, true>(F.lds, F.wave_s, D, S, E);
        { constexpr int NLAST = NMT * 33 - 16 * 256;
          if (_r == 1 && F.bx >= NLAST) p0_deferred(F, F.bx - NLAST, 256 - NLAST); } }
        SEAM(1);
    }
    if (IN(2)) {
        REPS(2) {
        scan_head_v2(F, F.bx, _r == 0);
        if (F.bx < 128 && _r == 1) merge_queue(F, rstd0, true);
        if (F.bx >= 128 && _r == 1) {
            const int c = F.bx - 128;
            conv_pass(F, c, F.G - 128);
            sub_barrier((unsigned*)(F.ctl + CW_SUB), (unsigned)(F.G - 128), F.wave_s);
            if (c < 4) {
                unsigned* c4 = (unsigned*)(F.ctl + CW_SUB + 64);
                { SchedList3 S{ws, NMT - 1, c, 4, 0x2310}; Epi3 E{F.out, ws, rstd0}; pg::gemm_phase(F.lds, F.wave_s, D, S, E); }
                sub_barrier(c4, 4u, F.wave_s);
                { SchedOne S{(const char*)ws + WS_R, (const char*)ws + WS_WOUT, NMT - 1, c, D}; Epi4 E{ws, F.in[IN_X_P], F.in[IN_X_S]}; pg::gemm_phase(F.lds, F.wave_s, D, S, E); }
                sub_barrier(c4, 8u, F.wave_s);
                { SchedOne S{(const char*)ws + WS_K, (const char*)ws + WS_WGATE, NMT - 1, c, D}; Epi5a E{ws}; pg::gemm_phase(F.lds, F.wave_s, D, S, E); }
                asm volatile("s_waitcnt vmcnt(0)" ::: "memory"); __syncthreads();
                { SchedOne S{(const char*)ws + WS_PH, (const char*)ws + WS_WPLE, NMT - 1, c, PLE}; Epi5b E{F.out, ws, F.in[IN_GFINAL], F.ctl, F.lds + RING_BYTES}; pg::gemm_phase(F.lds, F.wave_s, PLE, S, E); }
            }
            { SchedH S; S.o.init(NMT - 1, 4, 1, 0); S.ws = ws; S.c = c;
              Epi3 E{F.out, ws, rstd0};
              pg::gemm_phase(F.lds, F.wave_s, D, S, E); }
            sub_barrier((unsigned*)(F.ctl + CW_SUB), 2u * (unsigned)(F.G - 128), F.wave_s);
            merge_queue(F, rstd0, false);
        } }
        if (!(IN(4))) SEAM(2);
    }
    if (IN(4)) {
        p4_queue(F);
        if (!(IN(5))) SEAM(4);
    }
    if (IN(5)) {
        const int p5v = (F.bx & 31) | ((1 - (F.bx >> 7)) << 5) | (((F.bx & 127) >> 5) << 6);
        if (fresh_tid_w(F.wave_s) == 0) {
            const int pm0 = 16 * (p5v & 7) + ((p5v >> 3) & 7); unsigned sp = 0;
            unsigned* d0 = (unsigned*)(F.ctl + CW_P4D) + 64 * pm0; unsigned* d1 = (unsigned*)(F.ctl + CW_P4D) + 64 * (pm0 + 8);
            while (xb_ld(d0) < 4u || xb_ld(d1) < 4u) { __builtin_amdgcn_s_sleep(8); if (++sp > (1u << 24)) break; }
            __builtin_amdgcn_fence(__ATOMIC_ACQUIRE, "agent");
            asm volatile("s_waitcnt vmcnt(0)" ::: "memory");
        }
        __syncthreads();
        REPS(5) { Sched4 S; S.o.init(NMT - 1, 4, F.G, p5v); S.A = (const char*)ws + WS_K; S.B = (const char*)ws + WS_WGATE;
          Epi5a E{ws}; pg::gemm_phase(F.lds, F.wave_s, D, S, E); }
        asm volatile("s_waitcnt vmcnt(0)" ::: "memory");
        if (fresh_tid_w(F.wave_s) == 0) { unsigned* ma = (unsigned*)(F.ctl + CW_MALL); unsigned sp = 0; while (xb_ld(ma) < 512u) { __builtin_amdgcn_s_sleep(8); if (++sp > (1u << 24)) break; } }
        __syncthreads();
        { Sched5b S; S.o.init(NMT - 1, 4, F.G, p5v); S.A = (const char*)ws + WS_PH; S.B = (const char*)ws + WS_WPLE;
          Epi5b E{F.out, ws, F.in[IN_GFINAL], F.ctl, F.lds + RING_BYTES}; pg::gemm_phase(F.lds, F.wave_s, PLE, S, E); }
    }
#undef REPS
#undef IN
#undef SEAM
}

extern "C" void kernel_launch(void* const* d_in, const int* in_sizes, int n_in, void* d_out, int out_size, void* d_ws, size_t ws_size, hipStream_t stream) {
    static int grid = 0;
    if (grid == 0) {
        if (n_in != 27 || ws_size < WS_END) { fprintf(stderr, "kernel_launch: unexpected shapes (n_in %d, ws %zu)\n", n_in, ws_size); grid = -1; return; }
        int dev = 0, cus = 0;
        if (hipGetDevice(&dev) != hipSuccess || hipDeviceGetAttribute(&cus, hipDeviceAttributeMultiprocessorCount, dev) != hipSuccess) { grid = -1; return; }
        if (hipFuncSetAttribute((const void*)mk_fwd, hipFuncAttributeMaxDynamicSharedMemorySize, LDS_BYTES) != hipSuccess) { fprintf(stderr, "kernel_launch: hipFuncSetAttribute failed\n"); grid = -1; return; }
        int per_cu = 0;
        if (hipOccupancyMaxActiveBlocksPerMultiprocessor(&per_cu, (const void*)mk_fwd, NWAVES * 64, LDS_BYTES) != hipSuccess || per_cu < 1) { fprintf(stderr, "kernel_launch: occupancy query says %d\n", per_cu); }
        (void)hipGetLastError();
        if (cus < 256) { fprintf(stderr, "kernel_launch: needs 256 CUs, got %d\n", cus); grid = -1; return; }
        grid = 256;
    }
    if (grid < 0) return;
    (void)hipMemsetAsync((char*)d_ws + WS_CTL, 0, CTL_ZERO_BYTES, stream);
    Args a{};
    for (int i = 0; i < 27; ++i) a.in[i] = (const float*)d_in[i];
    a.out = (float*)d_out; a.ws = (unsigned char*)d_ws;
    if (MK_N_LAUNCHES == 1) { a.ph_lo = 0; a.ph_hi = N_PHASES; a.li = PROBE_PHASE; hipLaunchKernelGGL(mk_fwd, dim3(grid), dim3(NWAVES * 64), LDS_BYTES, stream, a); }
    else for (int li = 0; li < N_PHASES; ++li) { a.ph_lo = li; a.ph_hi = li + 1; a.li = PROBE_PHASE; hipLaunchKernelGGL(mk_fwd, dim3(grid), dim3(NWAVES * 64), LDS_BYTES, stream, a); }
}
```
